# Optimizing an MI355X kernel written in HIP

```python
import jax, jax.numpy as jnp
from jax import lax
import numpy as np

D_MODEL = 1024
BATCH = 8
SEQ = 4096
DEPTH = 2

GRID_W = 64
NA_HEADS = 8
NA_HEAD_DIM = 64
NA_WIN_ROWS = 8
NA_WIN_COLS = 16
NA_WIDTH = NA_HEADS * NA_HEAD_DIM
MLA_HEADS = 8
MLA_Q_RANK = 384
MLA_KV_RANK = 256
MLA_NOPE_DIM = 64
MLA_ROPE_DIM = 32
MLA_V_DIM = 64
MLA_WIDTH = MLA_HEADS * MLA_V_DIM
ROPE_BASE = 10000.0
Q_BLOCK = 128
N_EXPERTS = 16
EC_CAPACITY = 2
EXPERT_FF = 1024
PLE_DIM = 256
RMS_EPS = 1e-6
IN_SPLITS = [NA_WIDTH, NA_WIDTH, NA_WIDTH, MLA_Q_RANK, MLA_KV_RANK, MLA_ROPE_DIM, D_MODEL, D_MODEL]
IN_COLS = sum(IN_SPLITS)
IN_CUTS = [int(c) for c in np.cumsum(IN_SPLITS)[:-1]]

kernel_name = "hybrid_na_mla_ec_moe_encoder"


def rmsnorm(x, g):
    xf = x.astype(jnp.float32)
    y = xf * lax.rsqrt(jnp.mean(xf * xf, axis=-1, keepdims=True) + RMS_EPS)
    return (y * g.astype(jnp.float32)).astype(x.dtype)


def rope(x, pos):
    dim = x.shape[-1]
    half = dim // 2
    freqs = 1.0 / (ROPE_BASE ** (jnp.arange(0, dim, 2, dtype=jnp.float32) / dim))
    ang = pos.astype(jnp.float32)[:, None] * freqs[None, :]
    shape = (ang.shape[0],) + (1,) * (x.ndim - 3) + (half,)
    cos = jnp.cos(ang).reshape(shape).astype(x.dtype)
    sin = jnp.sin(ang).reshape(shape).astype(x.dtype)
    x1, x2 = x[..., :half], x[..., half:]
    return jnp.concatenate([x1 * cos - x2 * sin, x2 * cos + x1 * sin], axis=-1)


def rope2d(x, rows_pos, cols_pos):
    half = x.shape[-1] // 2
    return jnp.concatenate([rope(x[..., :half], rows_pos), rope(x[..., half:], cols_pos)], axis=-1)


def neighbourhood_attention(q, k, v, rpb):
    B, S, H, d = q.shape
    rows = S // GRID_W
    kh = min(NA_WIN_ROWS, rows)
    kw = NA_WIN_COLS
    scale = d ** -0.5
    qg = q.reshape(B, rows, GRID_W, H, d).transpose(1, 0, 2, 3, 4)
    kg = k.reshape(B, rows, GRID_W, H, d)
    vg = v.reshape(B, rows, GRID_W, H, d)
    col = jnp.arange(GRID_W)
    col_start = jnp.clip(col - kw // 2, 0, GRID_W - kw)
    col_idx = col_start[:, None] + jnp.arange(kw)[None, :]
    col_bias_idx = col_idx - col[:, None] + (NA_WIN_COLS - 1)

    def row_block(args):
        r, q_row = args
        r0 = jnp.clip(r - kh // 2, 0, rows - kh)
        k_rows = lax.dynamic_slice_in_dim(kg, r0, kh, axis=1)
        v_rows = lax.dynamic_slice_in_dim(vg, r0, kh, axis=1)
        k_win = k_rows[:, :, col_idx]
        v_win = v_rows[:, :, col_idx]
        row_bias_idx = r0 + jnp.arange(kh) - r + (NA_WIN_ROWS - 1)
        bias = rpb[:, row_bias_idx][:, :, col_bias_idx]
        bias = bias.transpose(0, 2, 1, 3).astype(jnp.float32)
        s = jnp.einsum('bqhd,bkqjhd->bhqkj', q_row, k_win).astype(jnp.float32) * scale + bias[None]
        pr = jax.nn.softmax(s.reshape(B, H, GRID_W, kh * kw), axis=-1)
        pr = pr.reshape(B, H, GRID_W, kh, kw).astype(v.dtype)
        return jnp.einsum('bhqkj,bkqjhd->bqhd', pr, v_win)

    out = lax.map(row_block, (jnp.arange(rows), qg))
    return out.transpose(1, 0, 2, 3, 4).reshape(B, S, H * d)


def latent_attention(q_lat, kv_lat, k_rope, q_norm, wq_up, kv_norm, wkv_up, rows_pos, cols_pos):
    B, S, _ = q_lat.shape
    H = MLA_HEADS
    q = (rmsnorm(q_lat, q_norm) @ wq_up).reshape(B, S, H, MLA_NOPE_DIM + MLA_ROPE_DIM)
    q_nope, q_pe = q[..., :MLA_NOPE_DIM], q[..., MLA_NOPE_DIM:]
    q_pe = rope2d(q_pe, rows_pos, cols_pos)
    kv = (rmsnorm(kv_lat, kv_norm) @ wkv_up).reshape(B, S, H, MLA_NOPE_DIM + MLA_V_DIM)
    k_nope, v = kv[..., :MLA_NOPE_DIM], kv[..., MLA_NOPE_DIM:]
    k_pe = rope2d(k_rope, rows_pos, cols_pos)
    k = jnp.concatenate([k_nope, jnp.broadcast_to(k_pe[:, :, None, :], (B, S, H, MLA_ROPE_DIM))], axis=-1)
    qf = jnp.concatenate([q_nope, q_pe], axis=-1)
    dqk = MLA_NOPE_DIM + MLA_ROPE_DIM
    scale = dqk ** -0.5
    nb = S // Q_BLOCK
    qb = qf.reshape(B, nb, Q_BLOCK, H, dqk).transpose(1, 0, 2, 3, 4)

    def block(qblk):
        s = jnp.einsum('bqhd,bkhd->bhqk', qblk, k).astype(jnp.float32) * scale
        pr = jax.nn.softmax(s, axis=-1).astype(v.dtype)
        return jnp.einsum('bhqk,bkhv->bqhv', pr, v)

    out = lax.map(block, qb)
    return out.transpose(1, 0, 2, 3, 4).reshape(B, S, H * MLA_V_DIM)


def expert_choice_moe(h, w_router, w1, w3, w2):
    B, S, D = h.shape
    cap = EC_CAPACITY * S // N_EXPERTS
    logits = jnp.einsum('bsd,de->bse', h, w_router).astype(jnp.float32)
    aff = jax.nn.softmax(logits, axis=-1)
    vals, idx = lax.top_k(aff.transpose(0, 2, 1), cap)
    bidx = jnp.arange(B)[:, None, None]
    xg = h[bidx, idx]
    h1 = jnp.einsum('becd,edf->becf', xg, w1)
    h3 = jnp.einsum('becd,edf->becf', xg, w3)
    out = jnp.einsum('becf,efd->becd', jax.nn.silu(h1) * h3, w2)
    out = out * vals.astype(h.dtype)[..., None]
    return jnp.zeros_like(h).at[bidx, idx].add(out)


def setup_inputs(seed: int = 0) -> dict:
    key = jax.random.key(seed)
    ks = jax.random.split(key, 24)

    def nrm(k, shape, scale):
        return jax.random.normal(k, shape, jnp.float32) * scale

    def gain(k, shape):
        return 1.0 + 0.01 * jax.random.normal(k, shape, jnp.float32)

    L, D = DEPTH, D_MODEL
    return {
        "x": nrm(ks[0], (BATCH, SEQ, D), 1.0),
        "p": nrm(ks[1], (DEPTH, BATCH, SEQ, PLE_DIM), 1.0),
        "norm_mix": gain(ks[2], (L, D)),
        "w_in": nrm(ks[3], (L, D, IN_COLS), D ** -0.5),
        "na_rpb": nrm(ks[4], (L, NA_HEADS, 2 * NA_WIN_ROWS - 1, 2 * NA_WIN_COLS - 1), 0.02),
        "mla_q_norm": gain(ks[5], (L, MLA_Q_RANK)),
        "mla_wq_up": nrm(ks[6], (L, MLA_Q_RANK, MLA_HEADS * (MLA_NOPE_DIM + MLA_ROPE_DIM)), MLA_Q_RANK ** -0.5),
        "mla_kv_norm": gain(ks[7], (L, MLA_KV_RANK)),
        "mla_wkv_up": nrm(ks[8], (L, MLA_KV_RANK, MLA_HEADS * (MLA_NOPE_DIM + MLA_V_DIM)), MLA_KV_RANK ** -0.5),
        "w_na_o": nrm(ks[9], (L, NA_WIDTH, D), NA_WIDTH ** -0.5),
        "w_mla_o": nrm(ks[10], (L, MLA_WIDTH, D), MLA_WIDTH ** -0.5),
        "w_out": nrm(ks[11], (L, D, D), D ** -0.5),
        "norm_moe": gain(ks[12], (L, D)),
        "w_router": nrm(ks[13], (L, D, N_EXPERTS), D ** -0.5),
        "moe_w1": nrm(ks[14], (L, N_EXPERTS, D, EXPERT_FF), D ** -0.5),
        "moe_w3": nrm(ks[15], (L, N_EXPERTS, D, EXPERT_FF), D ** -0.5),
        "moe_w2": nrm(ks[16], (L, N_EXPERTS, EXPERT_FF, D), EXPERT_FF ** -0.5),
        "norm_ple": gain(ks[17], (L, D)),
        "ple_gate_w": nrm(ks[18], (L, D, D), D ** -0.5),
        "ple_w": nrm(ks[19], (L, PLE_DIM, D), PLE_DIM ** -0.5),
        "norm_final": gain(ks[20], (D,)),
    }


def reference(x, p, norm_mix, w_in, na_rpb, mla_q_norm, mla_wq_up, mla_kv_norm, mla_wkv_up,
              w_na_o, w_mla_o, w_out, norm_moe, w_router, moe_w1, moe_w3, moe_w2,
              norm_ple, ple_gate_w, ple_w, norm_final):
    B, S, D = x.shape
    t = jnp.arange(S)
    rows_pos = t // GRID_W
    cols_pos = t % GRID_W
    for i in range(DEPTH):
        h = rmsnorm(x, norm_mix[i])
        proj = h @ w_in[i]
        na_q, na_k, na_v, q_lat, kv_lat, k_rope, gate_a, gate_b = jnp.split(proj, IN_CUTS, axis=-1)
        y_a = neighbourhood_attention(na_q.reshape(B, S, NA_HEADS, NA_HEAD_DIM),
                                      na_k.reshape(B, S, NA_HEADS, NA_HEAD_DIM),
                                      na_v.reshape(B, S, NA_HEADS, NA_HEAD_DIM),
                                      na_rpb[i]) @ w_na_o[i]
        y_b = latent_attention(q_lat, kv_lat, k_rope, mla_q_norm[i], mla_wq_up[i],
                               mla_kv_norm[i], mla_wkv_up[i], rows_pos, cols_pos) @ w_mla_o[i]
        merged = jax.nn.sigmoid(gate_a) * y_a + jax.nn.sigmoid(gate_b) * y_b
        x = x + merged @ w_out[i]
        x = x + expert_choice_moe(rmsnorm(x, norm_moe[i]), w_router[i], moe_w1[i], moe_w3[i], moe_w2[i])
        ple_gate = jax.nn.sigmoid(rmsnorm(x, norm_ple[i]) @ ple_gate_w[i])
        x = x + ple_gate * (p[i] @ ple_w[i])
    return rmsnorm(x, norm_final)
```

```cpp
#include <hip/hip_runtime.h>
#include <cstdio>
#include <cstdint>

#ifndef MK_ONE_LAUNCH
#define MK_ONE_LAUNCH 0
#endif

#define GAS __attribute__((address_space(1)))
#define LAS __attribute__((address_space(3)))
typedef unsigned short bf16_t;
typedef short bf16x8 __attribute__((ext_vector_type(8)));
typedef short s16x4 __attribute__((ext_vector_type(4)));
typedef float f32x2 __attribute__((ext_vector_type(2)));
typedef float f32x4 __attribute__((ext_vector_type(4)));
typedef float f32x16 __attribute__((ext_vector_type(16)));
typedef unsigned u32x2 __attribute__((ext_vector_type(2)));
typedef unsigned u32x4 __attribute__((ext_vector_type(4)));
typedef __bf16 bf16x2_t __attribute__((ext_vector_type(2)));

constexpr int NB = 8, SEQ = 4096, DM = 1024, M = NB * SEQ, NLAYER = 2;
constexpr int IN_COLS = 4256, NPA = 1792, NGATE = 2048, NINP = 3840;
constexpr int NE = 16, CAP = 512, MR = NB * NE * CAP;
constexpr float RMS_EPS = 1e-6f;
constexpr int PROJ_QLAT = 1024, PROJ_KVLAT = 1408, PROJ_KROPE = 1664;

constexpr size_t MiB = 1u << 20;
constexpr size_t WS_CTL = 0, CTL_ZERO_BYTES = 64 * 1024;
constexpr size_t WS_TAB = 1 * MiB;
constexpr size_t WS_AFF = 2 * MiB;
constexpr size_t WS_SLOT = 4 * MiB;
constexpr size_t WS_IDXR = 6 * MiB;
constexpr size_t WS_VALR = 6 * MiB + 512 * 1024;
constexpr size_t WS_KPE = 7 * MiB;
constexpr size_t WS_WSM = 9 * MiB;
constexpr size_t WSM_STRIDE = 17 * MiB;
constexpr size_t WS_H = 44 * MiB;
constexpr size_t WS_R1 = 108 * MiB;
constexpr size_t R_PROJA = WS_R1 + 0, R_GATES = WS_R1 + 112 * MiB, R_VT = WS_R1 + 240 * MiB, R_Q = WS_R1 + 272 * MiB, R_KV = WS_R1 + 320 * MiB, R_ATT = WS_R1 + 384 * MiB;
constexpr size_t R_MERGED = WS_R1 + 0;
constexpr size_t R_XG = WS_R1 + 0, R_MOEOUT = WS_R1 + 0, R_ACT = WS_R1 + 128 * MiB, R_W13 = WS_R1 + 256 * MiB, R_W2T = WS_R1 + 320 * MiB, R_PBF = WS_R1 + 352 * MiB, R_PE = WS_R1 + 368 * MiB;
constexpr size_t WS_END = WS_R1 + 448 * MiB;
constexpr size_t OFF_WIN = 0, OFF_WV = 3932160, OFF_WQ = 4456448, OFF_WKV = 4751360, OFF_WNAO = 5013504, OFF_WMLAO = 5537792, OFF_WOUT = 6062080, OFF_WPG = 7110656, OFF_WPW = 8159232;
static_assert(8421376 * 2 <= WSM_STRIDE, "small weights fit");
constexpr int CW_BAR = 1024;

constexpr int RING_BYTES = 131072, LDSCTL_OFF = RING_BYTES, LDS_BYTES = 147456;

#define LDS_WAIT() asm volatile("s_waitcnt lgkmcnt(0)" ::: "memory")
__device__ __forceinline__ unsigned pkbf(float lo, float hi) { f32x2 v = {lo, hi}; bf16x2_t b = __builtin_convertvector(v, bf16x2_t); return __builtin_bit_cast(unsigned, b); }
__device__ __forceinline__ float bf_lo(unsigned w) { return __uint_as_float(w << 16); }
__device__ __forceinline__ float bf_hi(unsigned w) { return __uint_as_float(w & 0xffff0000u); }
__device__ __forceinline__ float bf1(bf16_t h) { return __uint_as_float(((unsigned)h) << 16); }
__device__ __forceinline__ float sigmoidf_(float x) { return __builtin_amdgcn_rcpf(1.f + __expf(-x)); }
__device__ __forceinline__ float wave_sum(float v) {
#pragma unroll
    for (int o = 1; o < 64; o <<= 1) v += __shfl_xor(v, o);
    return v;
}

namespace pg8 {
constexpr int BM = 256, BK = 64, HALF = 128, HTB = HALF * BK * 2, STAGE_BYTES = 8 * HTB, NXCD = 8, WGM = 8;
__host__ __device__ __forceinline__ int lds_byte(int r, int c) { const int st = (r >> 4) * 2 + (c >> 5), rr = r & 15, cc = c & 31, ob = rr * 64 + cc * 2; return st * 1024 + (ob ^ (((ob >> 9) & 1) << 5)); }
__host__ __device__ __forceinline__ void stage_rc(int b, int& R, int& C) { const int st = b / 1024, sb = b % 1024, swz = sb ^ (((sb >> 9) & 1) << 5); R = (st >> 1) * 16 + swz / 64; C = (st & 1) * 32 + (swz % 64) / 2; }
__host__ __device__ __forceinline__ int perm32(int rho) { const int n = rho >> 4, i = rho & 15; return 8 * (i >> 2) + 4 * n + (i & 3); }

struct Unit { int pm, pn; };
struct Gemm { const bf16_t* A; const bf16_t* Bt; int lda, ldb, K; };

struct StaticOrder {
    int nM, nN, nwg, G, c;
    __host__ __device__ void init(int M_, int N_, int G_, int c_) { nM = M_ / BM; nN = N_ / BM; nwg = nM * nN; G = G_; c = c_; }
    __host__ __device__ bool next(int i, Unit& u) const {
        const long L = (long)i * G + c; if (L >= nwg) return false;
        int wgid = (int)L; { const int q = nwg / NXCD, r = nwg % NXCD, xcd = wgid % NXCD, off = wgid / NXCD; wgid = (xcd < r ? xcd * (q + 1) : r * (q + 1) + (xcd - r) * q) + off; }
        const int nig = WGM * nN, gid = wgid / nig, fm = gid * WGM, gsz = (nM - fm) < WGM ? (nM - fm) : WGM;
        u.pm = fm + ((wgid % nig) % gsz); u.pn = (wgid % nig) / gsz; return true;
    }
};
struct MoeOrder {
    StaticOrder S; int shift;
    __device__ void init(int M_, int N_, int G_, int c_, int shift_) { S.init(M_, N_, G_, c_); shift = shift_; }
    __device__ bool next(int i, Unit& u) const { if (!S.next(i, u)) return false; u.pn += (u.pm >> 4) << shift; return true; }
};

typedef f32x4 Acc[2][2][4][2];

struct EpiPlain {
    bf16_t* O; int ldc; int pn_mod;
    __device__ __forceinline__ void operator()(const Acc& acc, const Unit& u, int wr, int wc, int fr, int fq) const {
        const int col0 = (u.pn % pn_mod) * BM + wc * 32 + 8 * fq, row0 = u.pm * BM + wr * 64 + fr;
#pragma unroll
        for (int ai = 0; ai < 2; ++ai)
#pragma unroll
            for (int m = 0; m < 4; ++m) { bf16_t* rowp = O + (size_t)(row0 + ai * HALF + m * 16) * ldc + col0;
#pragma unroll
                for (int bj = 0; bj < 2; ++bj) { const f32x4 v0 = acc[ai][bj][m][0], v1 = acc[ai][bj][m][1];
                    u32x4 w; w.x = pkbf(v0[0], v0[1]); w.y = pkbf(v0[2], v0[3]); w.z = pkbf(v1[0], v1[1]); w.w = pkbf(v1[2], v1[3]);
                    *(u32x4*)(rowp + bj * HALF) = w; } }
    }
};
struct EpiInProj {
    bf16_t* PA; bf16_t* GT;
    __device__ __forceinline__ void operator()(const Acc& acc, const Unit& u, int wr, int wc, int fr, int fq) const {
        const bool gate = u.pn >= 7; bf16_t* O = gate ? GT : PA; const int ldc = gate ? NGATE : NPA;
        const int col0 = (gate ? (u.pn - 7) : u.pn) * BM + wc * 32 + 8 * fq, row0 = u.pm * BM + wr * 64 + fr;
#pragma unroll
        for (int ai = 0; ai < 2; ++ai)
#pragma unroll
            for (int m = 0; m < 4; ++m) { bf16_t* rowp = O + (size_t)(row0 + ai * HALF + m * 16) * ldc + col0;
#pragma unroll
                for (int bj = 0; bj < 2; ++bj) { f32x4 v0 = acc[ai][bj][m][0], v1 = acc[ai][bj][m][1];
                    if (gate) {
#pragma unroll
                        for (int q = 0; q < 4; ++q) { v0[q] = sigmoidf_(v0[q]); v1[q] = sigmoidf_(v1[q]); } }
                    u32x4 w; w.x = pkbf(v0[0], v0[1]); w.y = pkbf(v0[2], v0[3]); w.z = pkbf(v1[0], v1[1]); w.w = pkbf(v1[2], v1[3]);
                    *(u32x4*)(rowp + bj * HALF) = w; } }
    }
};
struct EpiQRope {
    bf16_t* O; const float* tab;
    __device__ __forceinline__ void operator()(const Acc& acc, const Unit& u, int wr, int wc, int fr, int fq) const {
        const int row0 = u.pm * BM + wr * 64 + fr;
#pragma unroll
        for (int bj = 0; bj < 2; ++bj) {
            const int col = u.pn * BM + bj * HALF + wc * 32 + 8 * fq;
            const int dl = col % 96;
            const bool pe = dl >= 64; const int grp = (dl - 64) >> 4;
#pragma unroll
            for (int ai = 0; ai < 2; ++ai)
#pragma unroll
                for (int m = 0; m < 4; ++m) { const int row = row0 + ai * HALF + m * 16;
                    f32x4 v0 = acc[ai][bj][m][0], v1 = acc[ai][bj][m][1];
                    float x[8] = {v0[0], v0[1], v0[2], v0[3], v1[0], v1[1], v1[2], v1[3]}, y[8];
#pragma unroll
                    for (int q = 0; q < 8; ++q) y[q] = __shfl_xor(x[q], 16);
                    if (pe) { const int s = row & (SEQ - 1); const int pos = grp ? (s & 63) : (s >> 6);
                        const f32x4* tp = (const f32x4*)(tab + pos * 16);
                        const f32x4 t0 = tp[0], t1 = tp[1], t2 = tp[2], t3 = tp[3];
                        const float cs[8] = {t0[0], t0[2], t1[0], t1[2], t2[0], t2[2], t3[0], t3[2]}, sn[8] = {t0[1], t0[3], t1[1], t1[3], t2[1], t2[3], t3[1], t3[3]};
                        const float sg = (fq & 1) ? 1.f : -1.f;
#pragma unroll
                        for (int q = 0; q < 8; ++q) x[q] = x[q] * cs[q] + sg * y[q] * sn[q]; }
                    u32x4 w; w.x = pkbf(x[0], x[1]); w.y = pkbf(x[2], x[3]); w.z = pkbf(x[4], x[5]); w.w = pkbf(x[6], x[7]);
                    *(u32x4*)(O + (size_t)row * 768 + col) = w; __builtin_amdgcn_sched_barrier(0); } }
    }
};
struct EpiGate {
    const bf16_t* Gt; bf16_t* O; int add;
    __device__ __forceinline__ void operator()(const Acc& acc, const Unit& u, int wr, int wc, int fr, int fq) const {
        const int col0 = u.pn * BM + wc * 32 + 8 * fq, row0 = u.pm * BM + wr * 64 + fr;
#pragma unroll
        for (int ai = 0; ai < 2; ++ai)
#pragma unroll
            for (int m = 0; m < 4; ++m) { const size_t row = (size_t)(row0 + ai * HALF + m * 16);
#pragma unroll
                for (int bj = 0; bj < 2; ++bj) { const f32x4 v0 = acc[ai][bj][m][0], v1 = acc[ai][bj][m][1];
                    const u32x4 g = *(const u32x4*)(Gt + row * NGATE + col0 + bj * HALF);
                    u32x4 p = {0u, 0u, 0u, 0u}; if (add) p = *(const u32x4*)(O + row * DM + col0 + bj * HALF);
                    u32x4 w;
                    w.x = pkbf(bf_lo(p.x) + bf_lo(g.x) * v0[0], bf_hi(p.x) + bf_hi(g.x) * v0[1]);
                    w.y = pkbf(bf_lo(p.y) + bf_lo(g.y) * v0[2], bf_hi(p.y) + bf_hi(g.y) * v0[3]);
                    w.z = pkbf(bf_lo(p.z) + bf_lo(g.z) * v1[0], bf_hi(p.z) + bf_hi(g.z) * v1[1]);
                    w.w = pkbf(bf_lo(p.w) + bf_lo(g.w) * v1[2], bf_hi(p.w) + bf_hi(g.w) * v1[3]);
                    *(u32x4*)(O + row * DM + col0 + bj * HALF) = w; } }
    }
};
struct EpiResid {
    const float* Xin; float* Xout;
    __device__ __forceinline__ void operator()(const Acc& acc, const Unit& u, int wr, int wc, int fr, int fq) const {
        const int col0 = u.pn * BM + wc * 32 + 8 * fq, row0 = u.pm * BM + wr * 64 + fr;
#pragma unroll
        for (int ai = 0; ai < 2; ++ai)
#pragma unroll
            for (int m = 0; m < 4; ++m) { const size_t off = (size_t)(row0 + ai * HALF + m * 16) * DM + col0;
#pragma unroll
                for (int bj = 0; bj < 2; ++bj) { const f32x4 a0 = *(const f32x4*)(Xin + off + bj * HALF), a1 = *(const f32x4*)(Xin + off + bj * HALF + 4);
                    *(f32x4*)(Xout + off + bj * HALF) = a0 + acc[ai][bj][m][0]; *(f32x4*)(Xout + off + bj * HALF + 4) = a1 + acc[ai][bj][m][1]; } }
    }
};
struct EpiSwiGLU {
    bf16_t* O;
    __device__ __forceinline__ void operator()(const Acc& acc, const Unit& u, int wr, int wc, int fr, int fq) const {
        const int col0 = (u.pn & 7) * HALF + wc * 32 + 8 * fq, row0 = u.pm * BM + wr * 64 + fr;
#pragma unroll
        for (int ai = 0; ai < 2; ++ai)
#pragma unroll
            for (int m = 0; m < 4; ++m) { float r[8];
#pragma unroll
                for (int n = 0; n < 2; ++n)
#pragma unroll
                    for (int q = 0; q < 4; ++q) { const float a = acc[ai][0][m][n][q], b = acc[ai][1][m][n][q]; r[n * 4 + q] = a * sigmoidf_(a) * b; }
                u32x4 w; w.x = pkbf(r[0], r[1]); w.y = pkbf(r[2], r[3]); w.z = pkbf(r[4], r[5]); w.w = pkbf(r[6], r[7]);
                *(u32x4*)(O + (size_t)(row0 + ai * HALF + m * 16) * 1024 + col0) = w; }
    }
};
struct EpiMoeDown {
    bf16_t* O; const float* val;
    __device__ __forceinline__ void operator()(const Acc& acc, const Unit& u, int wr, int wc, int fr, int fq) const {
        const int col0 = (u.pn & 3) * BM + wc * 32 + 8 * fq, row0 = u.pm * BM + wr * 64 + fr;
#pragma unroll
        for (int ai = 0; ai < 2; ++ai)
#pragma unroll
            for (int m = 0; m < 4; ++m) { const int row = row0 + ai * HALF + m * 16; const float s = val[row]; bf16_t* rowp = O + (size_t)row * 1024 + col0;
#pragma unroll
                for (int bj = 0; bj < 2; ++bj) { const f32x4 v0 = acc[ai][bj][m][0] * s, v1 = acc[ai][bj][m][1] * s;
                    u32x4 w; w.x = pkbf(v0[0], v0[1]); w.y = pkbf(v0[2], v0[3]); w.z = pkbf(v1[0], v1[1]); w.w = pkbf(v1[2], v1[3]);
                    *(u32x4*)(rowp + bj * HALF) = w; } }
    }
};
struct EpiPle {
    float* X; const bf16_t* PE;
    __device__ __forceinline__ void operator()(const Acc& acc, const Unit& u, int wr, int wc, int fr, int fq) const {
        const int col0 = u.pn * BM + wc * 32 + 8 * fq, row0 = u.pm * BM + wr * 64 + fr;
#pragma unroll
        for (int ai = 0; ai < 2; ++ai)
#pragma unroll
            for (int m = 0; m < 4; ++m) { const size_t off = (size_t)(row0 + ai * HALF + m * 16) * DM + col0;
#pragma unroll
                for (int bj = 0; bj < 2; ++bj) { const f32x4 v0 = acc[ai][bj][m][0], v1 = acc[ai][bj][m][1];
                    const u32x4 p = *(const u32x4*)(PE + off + bj * HALF);
                    f32x4 a0 = *(const f32x4*)(X + off + bj * HALF), a1 = *(const f32x4*)(X + off + bj * HALF + 4);
                    a0[0] += sigmoidf_(v0[0]) * bf_lo(p.x); a0[1] += sigmoidf_(v0[1]) * bf_hi(p.x); a0[2] += sigmoidf_(v0[2]) * bf_lo(p.y); a0[3] += sigmoidf_(v0[3]) * bf_hi(p.y);
                    a1[0] += sigmoidf_(v1[0]) * bf_lo(p.z); a1[1] += sigmoidf_(v1[1]) * bf_hi(p.z); a1[2] += sigmoidf_(v1[2]) * bf_lo(p.w); a1[3] += sigmoidf_(v1[3]) * bf_hi(p.w);
                    *(f32x4*)(X + off + bj * HALF) = a0; *(f32x4*)(X + off + bj * HALF + 4) = a1; } }
    }
};

template <class Epi, class Sched>
__device__ __forceinline__ void gemm_phase(LAS unsigned char* lds, const Gemm g, const Sched& S, const Epi& E) {
    int tid = threadIdx.x; asm volatile("" : "+v"(tid));
    const int wid = __builtin_amdgcn_readfirstlane(tid >> 6), lane = tid & 63, wr = wid >> 2, wc = wid & 3, fr = lane & 15, fq = lane >> 4;
    const int K = g.K, nt = K / BK;
    unsigned voffA[2], voffB[2];
#pragma unroll
    for (int i = 0; i < 2; ++i) { int R, C; stage_rc(tid * 16 + i * 8192, R, C); const int Rb = (R & ~31) + perm32(R & 31);
        voffA[i] = (unsigned)(R * g.lda + C) * 2u; voffB[i] = (unsigned)(Rb * g.ldb + C) * 2u; }
    const size_t kstep = (size_t)(BK * 2);
    const size_t hstepA = (size_t)HALF * g.lda * 2, hstepB = (size_t)HALF * g.ldb * 2;
    const size_t tstepA = 2 * hstepA, tstepB = 2 * hstepB;
    const unsigned ldsw = (unsigned)wid * 1024u;
    const int aoff = lds_byte(wr * 64 + fr, fq * 8), boff = lds_byte(wc * 32 + fr, fq * 8);
#define PG8_SA(b, h) (((b) * 2 + (h)) * HTB)
#define PG8_SB(b, h) ((4 + (b) * 2 + (h)) * HTB)
#define PG8_STAGE(bufoff, gbase, voff) do { _Pragma("unroll") for (int _i = 0; _i < 2; ++_i) \
        __builtin_amdgcn_global_load_lds((const unsigned*)((const char*)(gbase) + (voff)[_i]), (LAS unsigned*)(lds + (bufoff) + ldsw + _i * 8192), 16, 0, 0); } while (0)
#define PG8_LDA(dst, b, h) do { _Pragma("unroll") for (int m = 0; m < 4; ++m) _Pragma("unroll") for (int k = 0; k < 2; ++k) dst[m][k] = *(const LAS bf16x8*)(lds + PG8_SA(b, h) + aoff + m * 2048 + k * 1024); } while (0)
#define PG8_LDB(dst, b, h) do { _Pragma("unroll") for (int n = 0; n < 2; ++n) _Pragma("unroll") for (int k = 0; k < 2; ++k) dst[n][k] = *(const LAS bf16x8*)(lds + PG8_SB(b, h) + boff + n * 2048 + k * 1024); } while (0)
#define PG8_MMA(ai, bj, At, Bt) do { __builtin_amdgcn_s_setprio(1); _Pragma("unroll") for (int m = 0; m < 4; ++m) _Pragma("unroll") for (int n = 0; n < 2; ++n) _Pragma("unroll") for (int k = 0; k < 2; ++k) \
        acc[ai][bj][m][n] = __builtin_amdgcn_mfma_f32_16x16x32_bf16(Bt[n][k], At[m][k], acc[ai][bj][m][n], 0, 0, 0); __builtin_amdgcn_s_setprio(0); } while (0)
#define PG8_WAIT_V(n) asm volatile("s_waitcnt vmcnt(" #n ")" ::: "memory")
#define PG8_WAIT_L(n) asm volatile("s_waitcnt lgkmcnt(" #n ")" ::: "memory")
#define PG8_BAR __builtin_amdgcn_s_barrier()
#define PG8_SCHED __builtin_amdgcn_sched_barrier(0)
    Unit cur, nxt; int ui = 0;
    if (!S.next(0, cur)) return;
    f32x4 acc[2][2][4][2];
#pragma unroll
    for (int a = 0; a < 2; ++a)
#pragma unroll
        for (int b = 0; b < 2; ++b)
#pragma unroll
            for (int m = 0; m < 4; ++m)
#pragma unroll
                for (int n = 0; n < 2; ++n) acc[a][b][m][n] = (f32x4){0.f, 0.f, 0.f, 0.f};
    bf16x8 At[4][2], B0[2][2], B1[2][2];
    const char* cA = (const char*)g.A + (size_t)cur.pm * tstepA; const char* cB = (const char*)g.Bt + (size_t)cur.pn * tstepB;
    PG8_STAGE(PG8_SB(0, 0), cB, voffB); PG8_STAGE(PG8_SB(0, 1), cB + hstepB, voffB); PG8_STAGE(PG8_SA(0, 0), cA, voffA); PG8_STAGE(PG8_SA(0, 1), cA + hstepA, voffA);
    if (wr == 1) PG8_BAR;
    PG8_WAIT_V(2); PG8_BAR;
    PG8_STAGE(PG8_SB(1, 0), cB + kstep, voffB); PG8_STAGE(PG8_SA(1, 0), cA + kstep, voffA); PG8_STAGE(PG8_SB(1, 1), cB + hstepB + kstep, voffB);
    PG8_WAIT_V(6); PG8_BAR;
    for (;;) {
        const bool has_next = S.next(ui + 1, nxt);
        const char* nA = has_next ? (const char*)g.A + (size_t)nxt.pm * tstepA : cA; const char* nB = has_next ? (const char*)g.Bt + (size_t)nxt.pn * tstepB : cB;
#pragma unroll 1
        for (int t = 0; t < nt; t += 2) {
            const bool last = (t == nt - 2);
            const char* a1 = cA + (size_t)(t + 1) * kstep;
            const char* a2 = last ? nA : cA + (size_t)(t + 2) * kstep; const char* b2 = last ? nB : cB + (size_t)(t + 2) * kstep;
            const char* a3 = a2 + kstep; const char* b3 = b2 + kstep;
            PG8_LDB(B0, 0, 0); PG8_LDB(B1, 0, 1); PG8_SCHED; PG8_LDA(At, 0, 0); PG8_STAGE(PG8_SA(1, 1), a1 + hstepA, voffA);
            PG8_WAIT_V(8); PG8_WAIT_L(0); PG8_BAR; PG8_MMA(0, 0, At, B0); PG8_MMA(0, 1, At, B1); PG8_BAR; PG8_SCHED;
            PG8_LDA(At, 0, 1); PG8_STAGE(PG8_SB(0, 0), b2, voffB); PG8_STAGE(PG8_SB(0, 1), b2 + hstepB, voffB); PG8_STAGE(PG8_SA(0, 0), a2, voffA);
            PG8_WAIT_V(8); PG8_WAIT_L(0); PG8_BAR; PG8_MMA(1, 0, At, B0); PG8_MMA(1, 1, At, B1); PG8_BAR; PG8_SCHED;
            PG8_LDB(B0, 1, 0); PG8_LDB(B1, 1, 1); PG8_SCHED; PG8_LDA(At, 1, 0); PG8_STAGE(PG8_SA(0, 1), a2 + hstepA, voffA);
            PG8_WAIT_V(8); PG8_WAIT_L(0); PG8_BAR; PG8_MMA(0, 0, At, B0); PG8_MMA(0, 1, At, B1); PG8_BAR; PG8_SCHED;
            PG8_LDA(At, 1, 1); PG8_STAGE(PG8_SB(1, 0), b3, voffB); PG8_STAGE(PG8_SB(1, 1), b3 + hstepB, voffB); PG8_STAGE(PG8_SA(1, 0), a3, voffA);
            PG8_WAIT_V(8); PG8_WAIT_L(0); PG8_BAR; PG8_MMA(1, 0, At, B0); PG8_MMA(1, 1, At, B1); PG8_BAR; PG8_SCHED;
        }
        if (wr == 0) PG8_BAR;
        E(acc, cur, wr, wc, fr, fq);
        if (!has_next) break;
#pragma unroll
        for (int a = 0; a < 2; ++a)
#pragma unroll
            for (int b = 0; b < 2; ++b)
#pragma unroll
                for (int m = 0; m < 4; ++m)
#pragma unroll
                    for (int n = 0; n < 2; ++n) acc[a][b][m][n] = (f32x4){0.f, 0.f, 0.f, 0.f};
        cur = nxt; cA = nA; cB = nB; ++ui;
        if (wr == 1) PG8_BAR;
    }
    PG8_WAIT_V(0);
    PG8_BAR;
#undef PG8_SA
#undef PG8_SB
#undef PG8_STAGE
#undef PG8_LDA
#undef PG8_LDB
#undef PG8_MMA
#undef PG8_WAIT_V
#undef PG8_WAIT_L
#undef PG8_BAR
#undef PG8_SCHED
}
}

namespace mla {
constexpr int NW = 8, QBLK = 32, KVBLK = 64;
constexpr float SCALE = 0.10206207261596575f;
constexpr float THR = 8.f;
constexpr int SHM_V = KVBLK * 64 * 2, SHM_K = KVBLK * 256;
constexpr int OFF_V = 0, OFF_K = 2 * SHM_V, OFF_WS = OFF_K + 2 * SHM_K, LDS_NEED = OFF_WS + NW * 64 * 4;
#define KSWZ(row, colB) ((row) * 256 + ((colB) ^ (((row) & 7) << 4)))
#define SBAR() __builtin_amdgcn_sched_barrier(0)
__device__ __forceinline__ int crow(int r, int hi) { return (r & 3) + 8 * (r >> 2) + 4 * hi; }

__device__ __forceinline__ void partialSM(f32x16& p0, f32x16& p1, float& m_reg, float& mn, float& alpha) {
  constexpr float C = SCALE * 1.4426950408889634f;
  float pmax = p0[0];
#pragma unroll
  for (int r = 1; r < 16; ++r) pmax = fmaxf(pmax, p0[r]);
#pragma unroll
  for (int r = 0; r < 16; ++r) pmax = fmaxf(pmax, p1[r]);
  { auto rr = __builtin_amdgcn_permlane32_swap(__float_as_uint(pmax), __float_as_uint(pmax), false, false);
    pmax = fmaxf(__uint_as_float(rr[0]), __uint_as_float(rr[1])); }
  if (__builtin_expect(__all(pmax - m_reg <= THR / SCALE), 1)) { mn = m_reg; alpha = 1.f; }
  else { mn = fmaxf(m_reg, pmax); alpha = __builtin_amdgcn_exp2f((m_reg - mn) * C); m_reg = mn; }
  const float mnC = -mn * C;
#pragma unroll
  for (int r = 0; r < 16; ++r) p0[r] = fmaf(p0[r], C, mnC);
#pragma unroll
  for (int r = 0; r < 16; ++r) p1[r] = fmaf(p1[r], C, mnC);
#pragma unroll
  for (int r = 0; r < 16; ++r) p0[r] = __builtin_amdgcn_exp2f(p0[r]);
}
__device__ __forceinline__ void finishSM(f32x16& p0, f32x16& p1, float alpha, float& l_reg, bf16x8& pa0, bf16x8& pa1, bf16x8& pa2, bf16x8& pa3) {
#pragma unroll
  for (int r = 0; r < 16; ++r) p1[r] = __builtin_amdgcn_exp2f(p1[r]);
  float ps = 0;
#pragma unroll
  for (int r = 0; r < 16; ++r) ps += p0[r];
#pragma unroll
  for (int r = 0; r < 16; ++r) ps += p1[r];
  { auto rr = __builtin_amdgcn_permlane32_swap(__float_as_uint(ps), __float_as_uint(ps), false, false);
    ps = __uint_as_float(rr[0]) + __uint_as_float(rr[1]); }
  l_reg = l_reg * alpha + ps;
#define PK4(P, BASE, OUT) do { unsigned a0 = pkbf(P[BASE + 0], P[BASE + 1]), a1 = pkbf(P[BASE + 2], P[BASE + 3]);   \
    unsigned b0 = pkbf(P[BASE + 4], P[BASE + 5]), b1 = pkbf(P[BASE + 6], P[BASE + 7]);                              \
    auto r0 = __builtin_amdgcn_permlane32_swap(a0, b0, false, false); auto r1 = __builtin_amdgcn_permlane32_swap(a1, b1, false, false); \
    u32x4 w = {r0[0], r1[0], r0[1], r1[1]}; OUT = __builtin_bit_cast(bf16x8, w); } while (0)
  PK4(p0, 0, pa0); PK4(p0, 8, pa1); PK4(p1, 0, pa2); PK4(p1, 8, pa3);
#undef PK4
}
__device__ __forceinline__ void qkt(f32x16& p0, f32x16& p1, const LAS unsigned char* Ks, const bf16x8* qr, int r32, int hi) {
  p0 = f32x16{}; p1 = f32x16{};
#pragma unroll
  for (int d0 = 0; d0 < 6; ++d0) { const int cb = (d0 * 16 + hi * 8) * 2;
    const bf16x8 b0 = *(const LAS bf16x8*)(Ks + KSWZ(r32, cb));
    const bf16x8 b1 = *(const LAS bf16x8*)(Ks + KSWZ(32 + r32, cb));
    p0 = __builtin_amdgcn_mfma_f32_32x32x16_bf16(b0, qr[d0], p0, 0, 0, 0);
    p1 = __builtin_amdgcn_mfma_f32_32x32x16_bf16(b1, qr[d0], p1, 0, 0, 0); }
}
__device__ __forceinline__ int v_st(int k, int c) { const int kk = (k & ~0xC) | ((k & 4) << 1) | ((k & 8) >> 1); return ((kk >> 3) * 2 + (c >> 5)) * 512 + ((kk & 7) * 32 + (c & 31)) * 2; }
__device__ __forceinline__ int v_rd_base(int lane) { return ((lane & 3) << 3) | (((lane >> 2) & 3) << 6) | (((lane >> 4) & 1) << 5) | (((lane >> 5) & 1) << 8); }
constexpr int v_rd_off(int d0, int ks, int half) { return d0 * 512 + ks * 2048 + half * 1024; }
template <int OFF> __device__ __forceinline__ s16x4 tr_read(int vb) {
  s16x4 r; asm volatile("ds_read_b64_tr_b16 %0, %1 offset:%2" : "=&v"(r) : "v"(vb), "i"(OFF) : "memory"); return r;
}
template <int D0> __device__ __forceinline__ void pv_one(f32x16& od, int vb, bf16x8 pa0, bf16x8 pa1, bf16x8 pa2, bf16x8 pa3) {
  const s16x4 l0 = tr_read<v_rd_off(D0, 0, 0)>(vb), h0 = tr_read<v_rd_off(D0, 0, 1)>(vb), l1 = tr_read<v_rd_off(D0, 1, 0)>(vb), h1 = tr_read<v_rd_off(D0, 1, 1)>(vb);
  const s16x4 l2 = tr_read<v_rd_off(D0, 2, 0)>(vb), h2 = tr_read<v_rd_off(D0, 2, 1)>(vb), l3 = tr_read<v_rd_off(D0, 3, 0)>(vb), h3 = tr_read<v_rd_off(D0, 3, 1)>(vb);
  asm volatile("s_waitcnt lgkmcnt(0)" ::: "memory"); SBAR();
#define PK(L, H) (bf16x8){L[0], L[1], L[2], L[3], H[0], H[1], H[2], H[3]}
  od = __builtin_amdgcn_mfma_f32_32x32x16_bf16(pa0, PK(l0, h0), od, 0, 0, 0);
  od = __builtin_amdgcn_mfma_f32_32x32x16_bf16(pa1, PK(l1, h1), od, 0, 0, 0);
  od = __builtin_amdgcn_mfma_f32_32x32x16_bf16(pa2, PK(l2, h2), od, 0, 0, 0);
  od = __builtin_amdgcn_mfma_f32_32x32x16_bf16(pa3, PK(l3, h3), od, 0, 0, 0);
#undef PK
}
__device__ __forceinline__ void pv_d0(f32x16* o, int vb, bf16x8 pa0, bf16x8 pa1, bf16x8 pa2, bf16x8 pa3) {
  pv_one<0>(o[0], vb, pa0, pa1, pa2, pa3); pv_one<1>(o[1], vb, pa0, pa1, pa2, pa3);
}
__device__ __forceinline__ void unit(int b, int h, int qb, const bf16_t* __restrict__ Qg, const bf16_t* __restrict__ KVg, const bf16_t* __restrict__ KPE, bf16_t* __restrict__ ATT, LAS unsigned char* lds) {
  int tid = threadIdx.x; asm volatile("" : "+v"(tid));
  const int wid = tid >> 6, lane = tid & 63, r32 = lane & 31, hi = lane >> 5;
  LAS unsigned char* V_lds = lds + OFF_V; LAS unsigned char* K_lds = lds + OFF_K;
  LAS float* ws = (LAS float*)(lds + OFF_WS) + wid * 64; LAS float* li_l = ws; LAS float* al_l = ws + 32;
  float m_reg = -1e30f, l_reg = 0; f32x16 o[2] = {}; bf16x8 qr[6];
  const size_t tok0 = (size_t)b * SEQ;
  const bf16_t* Qw = Qg + (tok0 + qb * 256 + wid * QBLK + r32) * 768 + h * 96 + hi * 8;
#pragma unroll
  for (int d0 = 0; d0 < 6; ++d0) qr[d0] = *(const bf16x8*)(Qw + d0 * 16);
  const int sk = tid >> 3, sc8 = tid & 7, skp = (tid & 255) >> 2, scp = tid & 3;
  const bf16_t* vsrc = KVg + (tok0 + sk) * 1024 + h * 128 + 64 + sc8 * 8;
  const bf16_t* ksrc = KVg + (tok0 + sk) * 1024 + h * 128 + sc8 * 8;
  const bf16_t* psrc = KPE + (tok0 + skp) * 32 + scp * 8;
  const int vst = v_st(sk, sc8 * 8), kst = KSWZ(sk, sc8 * 16), pst = KSWZ(skp, 128 + scp * 16);
  const int vb0 = (int)(unsigned)(uintptr_t)V_lds + v_rd_base(lane);
  struct { bf16x8 v, k, p; } sr_[2];
#define SLOAD(i, k0) do { sr_[i].v = *(const bf16x8*)(vsrc + (size_t)(k0) * 1024); sr_[i].k = *(const bf16x8*)(ksrc + (size_t)(k0) * 1024); sr_[i].p = *(const bf16x8*)(psrc + (size_t)(k0) * 32); } while (0)
#define SWRITE(bb, i) do { *(LAS bf16x8*)(V_lds + (bb) * SHM_V + vst) = sr_[i].v; *(LAS bf16x8*)(K_lds + (bb) * SHM_K + kst) = sr_[i].k; *(LAS bf16x8*)(K_lds + (bb) * SHM_K + pst) = sr_[i].p; } while (0)
#define SWAIT() asm volatile("s_waitcnt vmcnt(3)" ::: "memory")
#define RESC(a) do { if (__any((a) < 1.f)) { if (hi == 0) al_l[r32] = (a); asm volatile("s_waitcnt lgkmcnt(0)" ::: "memory"); \
    _Pragma("unroll") for (int d = 0; d < 2; ++d) _Pragma("unroll") for (int r = 0; r < 16; ++r) o[d][r] *= al_l[crow(r, hi)]; } } while (0)
  f32x16 pA0, pA1, pB0, pB1; float mnA, mnB, alA, alB; bf16x8 pa0, pa1, pa2, pa3; constexpr int NT = SEQ / KVBLK;
  constexpr int SE = 0, SO = 1;
  SLOAD(SE, 0); asm volatile("s_waitcnt vmcnt(0)" ::: "memory"); SWRITE(0, SE); __syncthreads();
  qkt(pA0, pA1, K_lds, qr, r32, hi); partialSM(pA0, pA1, m_reg, mnA, alA);
  SLOAD(SO, KVBLK); SLOAD(SE, 2 * KVBLK);
  SWAIT(); SWRITE(1, SO); __syncthreads();
  for (int j = 1; j + 1 < NT; j += 2) {
    SBAR(); qkt(pB0, pB1, K_lds + SHM_K, qr, r32, hi);
    finishSM(pA0, pA1, alA, l_reg, pa0, pa1, pa2, pa3); SBAR();
    SLOAD(SO, (j + 2) * KVBLK); SBAR();
    pv_d0(o, vb0, pa0, pa1, pa2, pa3); partialSM(pB0, pB1, m_reg, mnB, alB);
    __syncthreads(); SWAIT(); SWRITE(0, SE);
    RESC(alB); __syncthreads();
    SBAR(); qkt(pA0, pA1, K_lds, qr, r32, hi);
    finishSM(pB0, pB1, alB, l_reg, pa0, pa1, pa2, pa3); SBAR();
    if (j + 3 < NT) SLOAD(SE, (j + 3) * KVBLK); SBAR();
    pv_d0(o, vb0 + SHM_V, pa0, pa1, pa2, pa3); partialSM(pA0, pA1, m_reg, mnA, alA);
    __syncthreads(); SWAIT(); SWRITE(1, SO);
    RESC(alA); __syncthreads();
  }
  SBAR(); qkt(pB0, pB1, K_lds + SHM_K, qr, r32, hi);
  finishSM(pA0, pA1, alA, l_reg, pa0, pa1, pa2, pa3); SBAR();
  pv_d0(o, vb0, pa0, pa1, pa2, pa3); partialSM(pB0, pB1, m_reg, mnB, alB);
  __syncthreads(); RESC(alB);
  finishSM(pB0, pB1, alB, l_reg, pa0, pa1, pa2, pa3); SBAR();
  pv_d0(o, vb0 + SHM_V, pa0, pa1, pa2, pa3);
  if (hi == 0) li_l[r32] = l_reg; asm volatile("s_waitcnt lgkmcnt(0)" ::: "memory");
  float rli[16];
#pragma unroll
  for (int r = 0; r < 16; ++r) rli[r] = __builtin_amdgcn_rcpf(li_l[crow(r, hi)]);
  bf16_t* Ow = ATT + (tok0 + qb * 256 + wid * QBLK) * 1024 + 512 + h * 64;
#pragma unroll
  for (int r = 0; r < 16; ++r) { const int orow = crow(r, hi);
#pragma unroll
    for (int d0 = 0; d0 < 2; ++d0) Ow[(size_t)orow * 1024 + d0 * 32 + r32] = (bf16_t)(pkbf(o[d0][r] * rli[r], 0.f) & 0xffffu); }
  asm volatile("s_waitcnt lgkmcnt(0)" ::: "memory");
  __syncthreads();
#undef SLOAD
#undef SWRITE
#undef SWAIT
#undef RESC
}
#undef KSWZ
#undef SBAR
}

namespace na {
__device__ __forceinline__ void unit(int b, int hp, int r, const bf16_t* __restrict__ PA, const bf16_t* __restrict__ VT, bf16_t* __restrict__ ATT, const LAS float* rpb) {
  int tid = threadIdx.x; asm volatile("" : "+v"(tid));
  const int wid = tid >> 6, lane = tid & 63, l15 = lane & 15, g = lane >> 4;
  const int h = hp * 2 + (wid >> 2), w4 = wid & 3;
  const int bs = (w4 == 0) ? 0 : (w4 == 1) ? 8 : (w4 == 2) ? 24 : 32;
  const int r0 = min(max(r - 4, 0), 56);
  const int c = 16 * w4 + l15, cs = min(max(c - 8, 0), 48);
  const size_t tokq = (size_t)b * SEQ + r * 64 + c;
  bf16x8 qf[2];
#pragma unroll
  for (int ks = 0; ks < 2; ++ks) qf[ks] = *(const bf16x8*)(PA + tokq * NPA + h * 64 + ks * 32 + g * 8);
  f32x4 s[16];
#pragma unroll
  for (int j = 0; j < 8; ++j)
#pragma unroll
    for (int hf = 0; hf < 2; ++hf) {
      const size_t tokk = (size_t)b * SEQ + (r0 + j) * 64 + bs + 16 * hf + l15;
      const bf16x8 k0 = *(const bf16x8*)(PA + tokk * NPA + 512 + h * 64 + g * 8), k1 = *(const bf16x8*)(PA + tokk * NPA + 512 + h * 64 + 32 + g * 8);
      f32x4 a = {0.f, 0.f, 0.f, 0.f};
      a = __builtin_amdgcn_mfma_f32_16x16x32_bf16(k0, qf[0], a, 0, 0, 0);
      a = __builtin_amdgcn_mfma_f32_16x16x32_bf16(k1, qf[1], a, 0, 0, 0);
      s[j * 2 + hf] = a; }
  const LAS float* rb = rpb + h * 465;
  float mx = -1e30f;
#pragma unroll
  for (int j = 0; j < 8; ++j)
#pragma unroll
    for (int hf = 0; hf < 2; ++hf)
#pragma unroll
      for (int i = 0; i < 4; ++i) {
        const int cp = bs + 16 * hf + 4 * g + i; const bool ok = (cp >= cs) && (cp < cs + 16);
        const int bi = (r0 + j - r + 7) * 31 + (ok ? (cp - c + 15) : 15);
        const float v = ok ? s[j * 2 + hf][i] * 0.125f + rb[bi] : -1e30f;
        s[j * 2 + hf][i] = v; mx = fmaxf(mx, v); }
  mx = fmaxf(mx, __shfl_xor(mx, 16)); mx = fmaxf(mx, __shfl_xor(mx, 32));
  float sum = 0.f;
#pragma unroll
  for (int q = 0; q < 16; ++q)
#pragma unroll
    for (int i = 0; i < 4; ++i) { const float p = __expf(s[q][i] - mx); s[q][i] = p; sum += p; }
  sum += __shfl_xor(sum, 16); sum += __shfl_xor(sum, 32);
  const float rl = __builtin_amdgcn_rcpf(sum);
  f32x4 o[4];
#pragma unroll
  for (int db = 0; db < 4; ++db) o[db] = (f32x4){0.f, 0.f, 0.f, 0.f};
#pragma unroll
  for (int j = 0; j < 8; ++j) {
    u32x4 pw; pw.x = pkbf(s[2 * j][0], s[2 * j][1]); pw.y = pkbf(s[2 * j][2], s[2 * j][3]); pw.z = pkbf(s[2 * j + 1][0], s[2 * j + 1][1]); pw.w = pkbf(s[2 * j + 1][2], s[2 * j + 1][3]);
    const bf16x8 pb = __builtin_bit_cast(bf16x8, pw);
    const size_t tk = (size_t)b * SEQ + (r0 + j) * 64 + bs + 4 * g;
#pragma unroll
    for (int db = 0; db < 4; ++db) {
      const bf16_t* vp = VT + (size_t)(h * 64 + db * 16 + l15) * M + tk;
      const u32x2 lo = *(const u32x2*)vp, hi2 = *(const u32x2*)(vp + 16);
      const u32x4 vw = {lo.x, lo.y, hi2.x, hi2.y};
      o[db] = __builtin_amdgcn_mfma_f32_16x16x32_bf16(__builtin_bit_cast(bf16x8, vw), pb, o[db], 0, 0, 0); } }
  bf16_t* op = ATT + tokq * 1024 + h * 64 + 4 * g;
#pragma unroll
  for (int db = 0; db < 4; ++db) { u32x2 w; w.x = pkbf(o[db][0] * rl, o[db][1] * rl); w.y = pkbf(o[db][2] * rl, o[db][3] * rl); *(u32x2*)(op + db * 16) = w; }
}
}

#define XB_TMO      128
#define XB_XCNT(j)  (256  + 64 * (j))
#define XB_XSUB(j)  (1280 + 64 * (j))
#define XB_XGEN(j)  (2304 + 64 * (j))
#define XB_TOP      3328
#define XB_TOPGEN   3392
#define XCD_BAR_WORDS 3456
#define XB_SPIN_CAP (1u << 22)
__device__ __forceinline__ unsigned xb_ld(unsigned* p)              { return __hip_atomic_load(p, __ATOMIC_RELAXED, __HIP_MEMORY_SCOPE_AGENT); }
__device__ __forceinline__ unsigned xb_add(unsigned* p, unsigned v) { return __hip_atomic_fetch_add(p, v, __ATOMIC_RELAXED, __HIP_MEMORY_SCOPE_AGENT); }
__device__ __forceinline__ unsigned xb_xcc_id() { return (unsigned)__builtin_amdgcn_s_getreg((3 << 11) | 20) & 0xFu; }
#define XB_SPIN(cond, bar) do { unsigned _sp = 0; while (cond) { __builtin_amdgcn_s_sleep(1); \
    if ((++_sp & 255u) == 0u) { if (xb_ld(&(bar)[XB_TMO])) break; if (_sp > XB_SPIN_CAP) { atomicAdd(&(bar)[XB_TMO], 1u); break; } } } } while (0)
struct XcdBarrier { unsigned* bar; unsigned x; volatile LAS unsigned* st; };
__device__ __forceinline__ XcdBarrier xcd_barrier_post(unsigned* bar, volatile LAS unsigned* st) {
    XcdBarrier b; b.bar = bar; b.x = xb_xcc_id(); b.st = st;
    if (threadIdx.x == 0) (void)xb_add(&bar[XB_XCNT(b.x)], 1u);
    return b;
}
__device__ __forceinline__ void xcd_barrier_complete(unsigned* bar, unsigned x, unsigned& nloc, unsigned& nx) {
    const unsigned G = gridDim.x * gridDim.y * gridDim.z;
    unsigned sum, cnt, mine, sp = 0u;
    for (;;) {
        sum = 0u; cnt = 0u; mine = 0u;
#pragma unroll
        for (unsigned j = 0; j < 16; ++j) { const unsigned c = xb_ld(&bar[XB_XCNT(j)]); sum += c; cnt += (c > 0u) ? 1u : 0u; mine = (j == x) ? c : mine; }
        if (sum == G) break;
        __builtin_amdgcn_s_sleep(1);
        if ((++sp & 255u) == 0u) { if (xb_ld(&bar[XB_TMO])) break; if (sp > XB_SPIN_CAP) { atomicAdd(&bar[XB_TMO], 1u); break; } }
    }
    nloc = mine > 0u ? mine : 1u; nx = cnt > 0u ? cnt : 1u;
}
__device__ __forceinline__ void xcd_barrier(const XcdBarrier& b) {
    asm volatile("s_waitcnt vmcnt(0)" ::: "memory");
    __syncthreads();
    if (threadIdx.x == 0) {
        unsigned* bar = b.bar;
        __builtin_amdgcn_s_waitcnt(0);
        unsigned nloc = b.st[0], nx = b.st[1];
        if (nloc == 0u) { xcd_barrier_complete(bar, b.x, nloc, nx); b.st[0] = nloc; b.st[1] = nx; }
        const unsigned old = xb_add(&bar[XB_XSUB(b.x)], 1u);
        const unsigned gen = old / nloc;
        if (old + 1u == (gen + 1u) * nloc) {
            __builtin_amdgcn_fence(__ATOMIC_RELEASE, "agent");
            asm volatile("s_waitcnt vmcnt(0)" ::: "memory");
            const unsigned og = xb_add(&bar[XB_TOP], 1u);
            const unsigned tg = og / nx;
            if (og + 1u == (tg + 1u) * nx) xb_add(&bar[XB_TOPGEN], 1u);
            else XB_SPIN(xb_ld(&bar[XB_TOPGEN]) == tg, bar);
            __builtin_amdgcn_fence(__ATOMIC_ACQUIRE, "agent");
            xb_add(&bar[XB_XGEN(b.x)], 1u);
            asm volatile("s_waitcnt vmcnt(0)" ::: "memory");
        } else {
            XB_SPIN(xb_ld(&bar[XB_XGEN(b.x)]) == gen, bar);
            __builtin_amdgcn_fence(__ATOMIC_ACQUIRE, "agent");
            asm volatile("s_waitcnt vmcnt(0)" ::: "memory");
        }
    }
    __syncthreads();
}

__device__ __forceinline__ void tr_item(const float* __restrict__ W, int ldw, int k0, int n0, bf16_t* __restrict__ WT, int ldt, int drow0, LAS float* scr, int lane) {
#pragma unroll 8
    for (int i = 0; i < 32; ++i) { const int kk = 2 * i + (lane >> 5); scr[kk * 33 + (lane & 31)] = W[(size_t)(k0 + kk) * ldw + n0 + (lane & 31)]; }
    LDS_WAIT(); asm volatile("" ::: "memory");
    const int c = lane & 7;
#pragma unroll
    for (int j = 0; j < 4; ++j) { const int n = (lane >> 3) + 8 * j; const LAS float* s = scr + (8 * c) * 33 + n;
        u32x4 o; o.x = pkbf(s[0 * 33], s[1 * 33]); o.y = pkbf(s[2 * 33], s[3 * 33]); o.z = pkbf(s[4 * 33], s[5 * 33]); o.w = pkbf(s[6 * 33], s[7 * 33]);
        *(u32x4*)(WT + (size_t)(drow0 + n) * ldt + k0 + 8 * c) = o; }
    LDS_WAIT(); asm volatile("" ::: "memory");
}
template <bool OUTF>
__device__ __forceinline__ void rms_row(const float* xrow, const float* gain, bf16_t* orow, float* orowf, int lane) {
    const f32x4* xr = (const f32x4*)xrow + lane; const f32x4* gr = (const f32x4*)gain + lane;
    f32x4 v[4]; float s = 0.f;
#pragma unroll
    for (int j = 0; j < 4; ++j) { v[j] = xr[64 * j]; s += (v[j][0] * v[j][0] + v[j][1] * v[j][1]) + (v[j][2] * v[j][2] + v[j][3] * v[j][3]); }
    const float rstd = 1.f / sqrtf(wave_sum(s) * (1.f / DM) + RMS_EPS);
#pragma unroll
    for (int j = 0; j < 4; ++j) { const f32x4 gq = gr[64 * j]; const f32x4 y = v[j] * rstd * gq;
        if (OUTF) ((f32x4*)orowf + lane)[64 * j] = y;
        else { u32x2 w; w.x = pkbf(y[0], y[1]); w.y = pkbf(y[2], y[3]); ((u32x2*)orow + lane)[64 * j] = w; } }
}

__device__ __forceinline__ void topk_item(int b, int e, const float* __restrict__ AFF, int* __restrict__ IDXR, float* __restrict__ VALR, int* __restrict__ SLOT, LAS unsigned* sh, int tid, int lane, int wave) {
    unsigned u[8];
    const float* src = AFF + ((size_t)(b * SEQ + tid * 8)) * 16 + e;
#pragma unroll
    for (int i = 0; i < 8; ++i) u[i] = __float_as_uint(src[i * 16]);
    LAS unsigned* hist = sh; LAS unsigned* misc = sh + 256;
    unsigned prefix = 0u, mask = 0u, kth = CAP;
    for (int pass = 0; pass < 4; ++pass) {
        const int shift = 24 - 8 * pass;
        if (tid < 256) hist[tid] = 0u;
        __syncthreads();
#pragma unroll
        for (int i = 0; i < 8; ++i) if ((u[i] & mask) == prefix) (void)__hip_atomic_fetch_add(&hist[(u[i] >> shift) & 255u], 1u, __ATOMIC_RELAXED, __HIP_MEMORY_SCOPE_WORKGROUP);
        __syncthreads();
        if (wave == 0) {
            const unsigned h0 = hist[4 * lane], h1 = hist[4 * lane + 1], h2 = hist[4 * lane + 2], h3 = hist[4 * lane + 3];
            const unsigned sl = h0 + h1 + h2 + h3;
            unsigned inc = sl;
#pragma unroll
            for (int o = 1; o < 64; o <<= 1) { const unsigned t = __shfl_down(inc, o); if (lane + o < 64) inc += t; }
            const unsigned exc = inc - sl;
            if (exc < kth && kth <= inc) {
                unsigned cc = exc; int dsel;
                if (cc + h3 >= kth) dsel = 3; else { cc += h3; if (cc + h2 >= kth) dsel = 2; else { cc += h2; if (cc + h1 >= kth) dsel = 1; else { cc += h1; dsel = 0; } } }
                misc[0] = (unsigned)(4 * lane + dsel); misc[1] = kth - cc;
            }
        }
        __syncthreads();
        prefix |= misc[0] << shift; mask |= 255u << shift; kth = misc[1];
    }
    const unsigned T = prefix, need = kth;
    unsigned ng = 0u, neq = 0u;
#pragma unroll
    for (int i = 0; i < 8; ++i) { ng += (u[i] > T) ? 1u : 0u; neq += (u[i] == T) ? 1u : 0u; }
    const unsigned packed = ng | (neq << 16);
    unsigned inc = packed;
#pragma unroll
    for (int o = 1; o < 64; o <<= 1) { const unsigned t = __shfl_up(inc, o); if (lane >= o) inc += t; }
    __syncthreads();
    if (lane == 63) misc[2 + wave] = inc;
    __syncthreads();
    unsigned woff = 0u;
#pragma unroll
    for (int w = 0; w < 8; ++w) if (w < wave) woff += misc[2 + w];
    const unsigned exc = woff + inc - packed;
    unsigned gpos = exc & 0xffffu, epos = exc >> 16;
    const unsigned total_gt = CAP - need;
#pragma unroll
    for (int i = 0; i < 8; ++i) { const int t = tid * 8 + i; int slot = -1;
        if (u[i] > T) slot = (int)(gpos++);
        else if (u[i] == T) { if (epos < need) slot = (int)(total_gt + epos); epos++; }
        SLOT[(size_t)(b * SEQ + t) * 16 + e] = slot;
        if (slot >= 0) { const int rr = (e * NB + b) * CAP + slot; IDXR[rr] = b * SEQ + t; VALR[rr] = __uint_as_float(u[i]); } }
    __syncthreads();
}

struct Args { const float* in[24]; int ph_lo, ph_hi; };
constexpr int NPH = 14, NPHASES = 1 + NLAYER * NPH;

__global__ void __launch_bounds__(512, 2) fwd(Args a) {
    extern __shared__ __attribute__((aligned(16))) unsigned char lds_raw[];
    LAS unsigned char* lds = (LAS unsigned char*)lds_raw;
    const int G = gridDim.x, bx = blockIdx.x;
    const int vcu = (G % 8 == 0) ? (bx % 8) * (G / 8) + bx / 8 : bx;
    const int NGW = G * 8;
    unsigned char* ws = (unsigned char*)a.in[22];
    volatile LAS unsigned* MISC = (volatile LAS unsigned*)(lds + LDSCTL_OFF);
    for (int u = threadIdx.x; u < (LDS_BYTES - LDSCTL_OFF) / 4; u += 512) ((LAS unsigned*)(lds + LDSCTL_OFF))[u] = 0u;
    __syncthreads();
    const int lo = a.ph_lo, hi = a.ph_hi;
    XcdBarrier bar; bar.bar = (unsigned*)(ws + WS_CTL) + CW_BAR; bar.x = 0; bar.st = nullptr;
    if (hi - lo > 1) bar = xcd_barrier_post((unsigned*)(ws + WS_CTL) + CW_BAR, MISC + 8);
#define IN(k) (lo <= (k) && (k) < hi)
#define SEAM(k) do { if (IN(k) && IN((k) + 1)) xcd_barrier(bar); } while (0)

#define ARGP(k) ({ int kk_ = (k); asm volatile("" : "+s"(kk_)); (const float*)(GAS const float*)a.in[kk_]; })
#define WSP(T, off) ((T*)(wsq + (off)))
#define PHASE_PTRS() int tid = threadIdx.x; asm volatile("" : "+v"(tid)); const int lane = tid & 63, wave = __builtin_amdgcn_readfirstlane(tid >> 6); const int gw = vcu * 8 + wave; (void)lane; (void)gw; \
    unsigned char* wsq = (unsigned char*)ARGP(22); float* X = (float*)ARGP(21); \
    bf16_t* H = WSP(bf16_t, WS_H); float* TAB = WSP(float, WS_TAB); float* AFF = WSP(float, WS_AFF); int* SLOT = WSP(int, WS_SLOT); int* IDXR = WSP(int, WS_IDXR); float* VALR = WSP(float, WS_VALR); \
    bf16_t* KPE = WSP(bf16_t, WS_KPE); bf16_t* PROJA = WSP(bf16_t, R_PROJA); bf16_t* GATES = WSP(bf16_t, R_GATES); bf16_t* VT = WSP(bf16_t, R_VT); bf16_t* Qb = WSP(bf16_t, R_Q); bf16_t* KVb = WSP(bf16_t, R_KV); \
    bf16_t* ATT = WSP(bf16_t, R_ATT); bf16_t* MERGED = WSP(bf16_t, R_MERGED); bf16_t* XG = WSP(bf16_t, R_XG); bf16_t* MOEOUT = WSP(bf16_t, R_MOEOUT); bf16_t* ACT = WSP(bf16_t, R_ACT); \
    bf16_t* W13 = WSP(bf16_t, R_W13); bf16_t* W2T = WSP(bf16_t, R_W2T); bf16_t* PBF = WSP(bf16_t, R_PBF); bf16_t* PE = WSP(bf16_t, R_PE); \
    const bf16_t* wl = (const bf16_t*)(wsq + WS_WSM + (size_t)l * WSM_STRIDE); \
    (void)H; (void)TAB; (void)AFF; (void)SLOT; (void)IDXR; (void)VALR; (void)KPE; (void)PROJA; (void)GATES; (void)VT; (void)Qb; (void)KVb; (void)ATT; (void)MERGED; (void)XG; (void)MOEOUT; (void)ACT; (void)W13; (void)W2T; (void)PBF; (void)PE; (void)wl; (void)X

    if (IN(0)) {
        const int l = 0; PHASE_PTRS(); const float* x_in = ARGP(0);
        LAS float* scr = (LAS float*)(lds + wave * 16384);
        for (int it = gw; it < 2 * 4064; it += NGW) {
            const int l = it / 4064; int r = it % 4064;
            bf16_t* wl = (bf16_t*)(wsq + WS_WSM + (size_t)l * WSM_STRIDE);
            if (r < 2128) { const int kb = r / 133, nb = r % 133, n0 = nb * 32; bf16_t* dst; int dr;
                if (n0 < 1024) { dst = wl + OFF_WIN; dr = n0; } else if (n0 < 1536) { dst = wl + OFF_WV; dr = n0 - 1024; } else if (n0 < 2208) { dst = wl + OFF_WIN; dr = n0 - 512; } else { dst = wl + OFF_WIN; dr = n0 - 416; }
                tr_item(ARGP(3) + (size_t)l * 1024 * IN_COLS, IN_COLS, kb * 64, n0, dst, 1024, dr, scr, lane); continue; } r -= 2128;
            if (r < 144) { tr_item(ARGP(6) + (size_t)l * 384 * 768, 768, (r / 24) * 64, (r % 24) * 32, wl + OFF_WQ, 384, (r % 24) * 32, scr, lane); continue; } r -= 144;
            if (r < 128) { tr_item(ARGP(8) + (size_t)l * 256 * 1024, 1024, (r / 32) * 64, (r % 32) * 32, wl + OFF_WKV, 256, (r % 32) * 32, scr, lane); continue; } r -= 128;
            if (r < 256) { tr_item(ARGP(9) + (size_t)l * 512 * 1024, 1024, (r / 32) * 64, (r % 32) * 32, wl + OFF_WNAO, 512, (r % 32) * 32, scr, lane); continue; } r -= 256;
            if (r < 256) { tr_item(ARGP(10) + (size_t)l * 512 * 1024, 1024, (r / 32) * 64, (r % 32) * 32, wl + OFF_WMLAO, 512, (r % 32) * 32, scr, lane); continue; } r -= 256;
            if (r < 512) { tr_item(ARGP(11) + (size_t)l * 1024 * 1024, 1024, (r / 32) * 64, (r % 32) * 32, wl + OFF_WOUT, 1024, (r % 32) * 32, scr, lane); continue; } r -= 512;
            if (r < 512) { tr_item(ARGP(18) + (size_t)l * 1024 * 1024, 1024, (r / 32) * 64, (r % 32) * 32, wl + OFF_WPG, 1024, (r % 32) * 32, scr, lane); continue; } r -= 512;
            tr_item(ARGP(19) + (size_t)l * 256 * 1024, 1024, (r / 32) * 64, (r % 32) * 32, wl + OFF_WPW, 256, (r % 32) * 32, scr, lane);
        }
        for (int i = bx * 512 + tid; i < 2 * 96 * 128; i += G * 512) { const int l = i / (96 * 128), r = i % (96 * 128);
            bf16_t* wl = (bf16_t*)(wsq + WS_WSM + (size_t)l * WSM_STRIDE) + OFF_WIN + (size_t)1696 * 1024; *(u32x4*)(wl + (size_t)r * 8) = (u32x4){0u, 0u, 0u, 0u}; }
        if (bx == 0) { const int pos = tid >> 3, j = tid & 7; const float f = exp2f(-(float)j * 1.6609640474436813f); const float rev = (float)pos * f * 0.15915494309189535f; const float fr = rev - floorf(rev);
            TAB[tid * 2] = __builtin_amdgcn_cosf(fr); TAB[tid * 2 + 1] = __builtin_amdgcn_sinf(fr); }
        for (int m = gw; m < M; m += NGW) rms_row<false>(x_in + (size_t)m * DM, ARGP(2), H + (size_t)m * DM, nullptr, lane);
    }
    SEAM(0);

    for (int l = 0; l < NLAYER; ++l) {
        const int pb = 1 + l * NPH;
        if (IN(pb + 0)) { PHASE_PTRS();
            { pg8::Gemm g{H, wl + OFF_WIN, 1024, 1024, 1024}; pg8::StaticOrder S; S.init(M, NINP, G, bx); pg8::EpiInProj E{PROJA, GATES};
              pg8::gemm_phase(lds, g, S, E); }
            { pg8::Gemm g{wl + OFF_WV, H, 1024, 1024, 1024}; pg8::StaticOrder S; S.init(512, M, G, bx); pg8::EpiPlain E{VT, M, 1 << 20};
              pg8::gemm_phase(lds, g, S, E); }
        }
        SEAM(pb + 0);
        if (IN(pb + 1)) { PHASE_PTRS();
            const float* qn = ARGP(5) + l * 384; const float* kn = ARGP(7) + l * 256;
            for (int t = gw; t < M; t += NGW) {
                bf16_t* pr = PROJA + (size_t)t * NPA;
                unsigned q[3], kv[2]; float sq = 0.f, sk = 0.f;
#pragma unroll
                for (int j = 0; j < 3; ++j) { q[j] = *(const unsigned*)(pr + PROJ_QLAT + 2 * lane + 128 * j); const float a0 = bf_lo(q[j]), a1 = bf_hi(q[j]); sq += a0 * a0 + a1 * a1; }
#pragma unroll
                for (int j = 0; j < 2; ++j) { kv[j] = *(const unsigned*)(pr + PROJ_KVLAT + 2 * lane + 128 * j); const float a0 = bf_lo(kv[j]), a1 = bf_hi(kv[j]); sk += a0 * a0 + a1 * a1; }
                const float xr = bf1(pr[PROJ_KROPE + (lane & 31)]);
                const float rq = 1.f / sqrtf(wave_sum(sq) * (1.f / 384.f) + RMS_EPS), rk = 1.f / sqrtf(wave_sum(sk) * (1.f / 256.f) + RMS_EPS);
#pragma unroll
                for (int j = 0; j < 3; ++j) { const f32x2 gq = *(const f32x2*)(qn + 2 * lane + 128 * j); *(unsigned*)(pr + PROJ_QLAT + 2 * lane + 128 * j) = pkbf(bf_lo(q[j]) * rq * gq[0], bf_hi(q[j]) * rq * gq[1]); }
#pragma unroll
                for (int j = 0; j < 2; ++j) { const f32x2 gk = *(const f32x2*)(kn + 2 * lane + 128 * j); *(unsigned*)(pr + PROJ_KVLAT + 2 * lane + 128 * j) = pkbf(bf_lo(kv[j]) * rk * gk[0], bf_hi(kv[j]) * rk * gk[1]); }
                const float xp = __shfl_xor(xr, 8);
                const int s = t & (SEQ - 1), pos = (lane & 16) ? (s & 63) : (s >> 6), jf = lane & 7;
                const float cs = TAB[(pos * 8 + jf) * 2], sn = TAB[(pos * 8 + jf) * 2 + 1];
                const float outv = (lane & 8) ? (xr * cs + xp * sn) : (xr * cs - xp * sn);
                if (lane < 32) KPE[(size_t)t * 32 + lane] = (bf16_t)(pkbf(outv, 0.f) & 0xffffu);
            }
        }
        SEAM(pb + 1);
        if (IN(pb + 2)) { PHASE_PTRS();
            { pg8::Gemm g{PROJA + PROJ_QLAT, wl + OFF_WQ, NPA, 384, 384}; pg8::StaticOrder S; S.init(M, 768, G, bx); pg8::EpiQRope E{Qb, TAB};
              pg8::gemm_phase(lds, g, S, E); }
            { pg8::Gemm g{PROJA + PROJ_KVLAT, wl + OFF_WKV, NPA, 256, 256}; pg8::StaticOrder S; S.init(M, 1024, G, G - 1 - bx); pg8::EpiPlain E{KVb, 1024, 1 << 20};
              pg8::gemm_phase(lds, g, S, E); }
        }
        SEAM(pb + 2);
        if (IN(pb + 3)) { PHASE_PTRS();
            { const int upb = (1024 + G - 1) / G;
              for (int i = 0; i < upb; ++i) { const int u = vcu * upb + i; if (u >= 1024) break; const int bh = u >> 4, qb = u & 15; mla::unit(bh >> 3, bh & 7, qb, Qb, KVb, KPE, ATT, lds); } }
            LAS float* rpb = (LAS float*)(lds + 65536);
            for (int i = tid; i < 8 * 465; i += 512) rpb[i] = ARGP(4)[l * 8 * 465 + i];
            __syncthreads();
            { const int upb = (2048 + G - 1) / G;
              for (int i = 0; i < upb; ++i) { const int u = vcu * upb + i; if (u >= 2048) break; const int r = u & 63, bh = u >> 6; na::unit(bh >> 2, bh & 3, r, PROJA, VT, ATT, rpb); } }
            __syncthreads();
        }
        SEAM(pb + 3);
        if (IN(pb + 4)) { PHASE_PTRS();
            { pg8::Gemm g{ATT, wl + OFF_WNAO, 1024, 512, 512}; pg8::StaticOrder S; S.init(M, 1024, G, bx); pg8::EpiGate E{GATES, MERGED, 0};
              pg8::gemm_phase(lds, g, S, E); }
            { pg8::Gemm g{ATT + 512, wl + OFF_WMLAO, 1024, 512, 512}; pg8::StaticOrder S; S.init(M, 1024, G, bx); pg8::EpiGate E{GATES + 1024, MERGED, 1};
              pg8::gemm_phase(lds, g, S, E); }
        }
        SEAM(pb + 4);
        if (IN(pb + 5)) { PHASE_PTRS();
            pg8::Gemm g{MERGED, wl + OFF_WOUT, 1024, 1024, 1024}; pg8::StaticOrder S; S.init(M, 1024, G, bx); pg8::EpiResid E{l == 0 ? ARGP(0) : (const float*)X, X};
            pg8::gemm_phase(lds, g, S, E);
        }
        SEAM(pb + 5);
        if (IN(pb + 6)) { PHASE_PTRS();
            LAS float* wr = (LAS float*)lds;
            const float* wrg = ARGP(13) + (size_t)l * 1024 * 16;
            for (int i = tid; i < 1024 * 4; i += 512) { const int k = i >> 2, c4 = i & 3; const int slot = (k & 3) * 256 + ((k >> 8) & 3) * 64 + ((k >> 2) & 63);
                *(LAS f32x4*)(wr + slot * 20 + c4 * 4) = *(const f32x4*)(wrg + k * 16 + c4 * 4); }
            __syncthreads();
            const float* gain = ARGP(12) + l * 1024;
            for (int m = gw; m < M; m += NGW) {
                const f32x4* xr = (const f32x4*)(X + (size_t)m * DM) + lane; const f32x4* gr = (const f32x4*)gain + lane;
                f32x4 v[4]; float s = 0.f;
#pragma unroll
                for (int j = 0; j < 4; ++j) { v[j] = xr[64 * j]; s += (v[j][0] * v[j][0] + v[j][1] * v[j][1]) + (v[j][2] * v[j][2] + v[j][3] * v[j][3]); }
                const float rstd = 1.f / sqrtf(wave_sum(s) * (1.f / DM) + RMS_EPS);
                float lg[16];
#pragma unroll
                for (int e = 0; e < 16; ++e) lg[e] = 0.f;
#pragma unroll
                for (int j = 0; j < 4; ++j) { v[j] = v[j] * rstd * gr[64 * j];
                    u32x2 w; w.x = pkbf(v[j][0], v[j][1]); w.y = pkbf(v[j][2], v[j][3]); ((u32x2*)(H + (size_t)m * DM) + lane)[64 * j] = w;
#pragma unroll
                    for (int q = 0; q < 4; ++q) { const LAS f32x4* wp = (const LAS f32x4*)(wr + (q * 256 + j * 64 + lane) * 20); const float xv = v[j][q];
#pragma unroll
                        for (int c4 = 0; c4 < 4; ++c4) { const f32x4 w4 = wp[c4]; lg[c4 * 4 + 0] += xv * w4[0]; lg[c4 * 4 + 1] += xv * w4[1]; lg[c4 * 4 + 2] += xv * w4[2]; lg[c4 * 4 + 3] += xv * w4[3]; } __builtin_amdgcn_sched_barrier(0); } }
                float mxl = -1e30f;
#pragma unroll
                for (int e = 0; e < 16; ++e) { lg[e] = wave_sum(lg[e]); mxl = fmaxf(mxl, lg[e]); }
                float se = 0.f;
#pragma unroll
                for (int e = 0; e < 16; ++e) { lg[e] = __expf(lg[e] - mxl); se += lg[e]; }
                float mine = 0.f;
#pragma unroll
                for (int e = 0; e < 16; ++e) mine = (lane == e) ? lg[e] : mine;
                if (lane < 16) AFF[(size_t)m * 16 + lane] = mine / se;
            }
            __syncthreads();
        }
        SEAM(pb + 6);
        if (IN(pb + 7)) { PHASE_PTRS();
            LAS unsigned* sh = (LAS unsigned*)(lds + 9216);
            for (int it = bx; it < NB * NE; it += G) topk_item(it >> 4, it & 15, AFF, IDXR, VALR, SLOT, sh, tid, lane, wave);
            LAS float* scr = (LAS float*)(lds + wave * 16384);
            for (int it = gw; it < 3 * 8192; it += NGW) {
                const int which = it >> 13, r = it & 8191, e = r >> 9, kb = (r >> 5) & 15, nb = r & 31, n0 = nb * 32;
                const size_t eoff = (size_t)(l * 16 + e) * 1024 * 1024;
                if (which == 0) tr_item(ARGP(14) + eoff, 1024, kb * 64, n0, W13 + (size_t)e * 2048 * 1024, 1024, (n0 >> 7) * 256 + (n0 & 127), scr, lane);
                else if (which == 1) tr_item(ARGP(15) + eoff, 1024, kb * 64, n0, W13 + (size_t)e * 2048 * 1024, 1024, (n0 >> 7) * 256 + 128 + (n0 & 127), scr, lane);
                else tr_item(ARGP(16) + eoff, 1024, kb * 64, n0, W2T + (size_t)e * 1024 * 1024, 1024, n0, scr, lane);
            }
            const float* pl = ARGP(1) + (size_t)l * M * 256;
            for (size_t i = (size_t)bx * 512 + tid; i < (size_t)M * 256 / 8; i += (size_t)G * 512) { const f32x4 a0 = *(const f32x4*)(pl + i * 8), a1 = *(const f32x4*)(pl + i * 8 + 4);
                u32x4 w; w.x = pkbf(a0[0], a0[1]); w.y = pkbf(a0[2], a0[3]); w.z = pkbf(a1[0], a1[1]); w.w = pkbf(a1[2], a1[3]); *(u32x4*)(PBF + i * 8) = w; }
        }
        SEAM(pb + 7);
        if (IN(pb + 8)) { PHASE_PTRS();
            for (int rr = gw; rr < MR; rr += NGW) { const int src = __builtin_amdgcn_readfirstlane(IDXR[rr]);
                const u32x4* sp = (const u32x4*)(H + (size_t)src * DM) + lane; u32x4* dp = (u32x4*)(XG + (size_t)rr * DM) + lane;
                const u32x4 v0 = sp[0], v1 = sp[64]; dp[0] = v0; dp[64] = v1; }
        }
        SEAM(pb + 8);
        if (IN(pb + 9)) { PHASE_PTRS();
            pg8::Gemm g{XG, W13, 1024, 1024, 1024}; pg8::MoeOrder S; S.init(MR, 2048, G, bx, 3); pg8::EpiSwiGLU E{ACT};
            pg8::gemm_phase(lds, g, S, E);
        }
        SEAM(pb + 9);
        if (IN(pb + 10)) { PHASE_PTRS();
            { pg8::Gemm g{ACT, W2T, 1024, 1024, 1024}; pg8::MoeOrder S; S.init(MR, 1024, G, bx, 2); pg8::EpiMoeDown E{MOEOUT, VALR};
              pg8::gemm_phase(lds, g, S, E); }
            { pg8::Gemm g{PBF, wl + OFF_WPW, 256, 256, 256}; pg8::StaticOrder S; S.init(M, 1024, G, bx); pg8::EpiPlain E{PE, 1024, 1 << 20};
              pg8::gemm_phase(lds, g, S, E); }
        }
        SEAM(pb + 10);
        if (IN(pb + 11)) { PHASE_PTRS();
            const float* gain = ARGP(17) + l * 1024;
            for (int m = gw; m < M; m += NGW) {
                const int myslot = SLOT[(size_t)m * 16 + (lane & 15)];
                f32x4* xr = (f32x4*)(X + (size_t)m * DM) + lane; const f32x4* gr = (const f32x4*)gain + lane;
                f32x4 v[4];
#pragma unroll
                for (int j = 0; j < 4; ++j) v[j] = xr[64 * j];
                const int b = m >> 12;
#pragma unroll
                for (int e = 0; e < 16; ++e) { const int c = __builtin_amdgcn_readlane(myslot, e);
                    if (c >= 0) { const u32x2* mr = (const u32x2*)(MOEOUT + (size_t)((e * NB + b) * CAP + c) * DM) + lane;
#pragma unroll
                        for (int j = 0; j < 4; ++j) { const u32x2 w = mr[64 * j]; v[j][0] += bf_lo(w.x); v[j][1] += bf_hi(w.x); v[j][2] += bf_lo(w.y); v[j][3] += bf_hi(w.y); } } }
                float s = 0.f;
#pragma unroll
                for (int j = 0; j < 4; ++j) { xr[64 * j] = v[j]; s += (v[j][0] * v[j][0] + v[j][1] * v[j][1]) + (v[j][2] * v[j][2] + v[j][3] * v[j][3]); }
                const float rstd = 1.f / sqrtf(wave_sum(s) * (1.f / DM) + RMS_EPS);
#pragma unroll
                for (int j = 0; j < 4; ++j) { const f32x4 y = v[j] * rstd * gr[64 * j]; u32x2 w; w.x = pkbf(y[0], y[1]); w.y = pkbf(y[2], y[3]); ((u32x2*)(H + (size_t)m * DM) + lane)[64 * j] = w; }
            }
        }
        SEAM(pb + 11);
        if (IN(pb + 12)) { PHASE_PTRS();
            pg8::Gemm g{H, wl + OFF_WPG, 1024, 1024, 1024}; pg8::StaticOrder S; S.init(M, 1024, G, bx); pg8::EpiPle E{X, PE};
            pg8::gemm_phase(lds, g, S, E);
        }
        SEAM(pb + 12);
        if (IN(pb + 13)) { PHASE_PTRS();
            if (l + 1 < NLAYER) { for (int m = gw; m < M; m += NGW) rms_row<false>(X + (size_t)m * DM, ARGP(2) + (l + 1) * 1024, H + (size_t)m * DM, nullptr, lane); }
            else { for (int m = gw; m < M; m += NGW) rms_row<true>(X + (size_t)m * DM, ARGP(20), nullptr, X + (size_t)m * DM, lane); }
        }
        if (l + 1 < NLAYER) SEAM(pb + 13);
    }
#undef IN
#undef SEAM
}

extern "C" void kernel_launch(void* const* d_in, const int* in_sizes, int n_in, void* d_out, int out_size, void* d_ws, size_t ws_size, hipStream_t stream) {
    static int grid = 0;
    if (grid == 0) {
        if (n_in != 21 || out_size != M * DM || ws_size < WS_END) { fprintf(stderr, "kernel_launch: unexpected shapes (n_in %d out %d ws %zu, need ws >= %zu)\n", n_in, out_size, ws_size, (size_t)WS_END); grid = -1; return; }
        int dev = 0, cus = 0, per_cu = 0;
        if (hipGetDevice(&dev) != hipSuccess || hipDeviceGetAttribute(&cus, hipDeviceAttributeMultiprocessorCount, dev) != hipSuccess) { grid = -1; return; }
        if (hipFuncSetAttribute((const void*)fwd, hipFuncAttributeMaxDynamicSharedMemorySize, LDS_BYTES) != hipSuccess) { fprintf(stderr, "kernel_launch: hipFuncSetAttribute failed\n"); grid = -1; return; }
        if (hipOccupancyMaxActiveBlocksPerMultiprocessor(&per_cu, (const void*)fwd, 512, LDS_BYTES) != hipSuccess || per_cu < 1) { fprintf(stderr, "kernel_launch: occupancy query reports %d blocks per CU\n", per_cu); }
        (void)hipGetLastError();
        grid = cus;
    }
    if (grid < 0) return;
    (void)hipMemsetAsync((char*)d_ws + WS_CTL, 0, CTL_ZERO_BYTES, stream);
    Args a{};
    for (int i = 0; i < 21; ++i) a.in[i] = (const float*)d_in[i];
    a.in[21] = (const float*)d_out; a.in[22] = (const float*)d_ws; a.in[23] = nullptr;
#if MK_ONE_LAUNCH
    a.ph_lo = 0; a.ph_hi = NPHASES;
    hipLaunchKernelGGL(fwd, dim3(grid), dim3(512), LDS_BYTES, stream, a);
#else
    for (int p = 0; p < NPHASES; ++p) { a.ph_lo = p; a.ph_hi = p + 1; hipLaunchKernelGGL(fwd, dim3(grid), dim3(512), LDS_BYTES, stream, a); }
#endif
}
```

```cpp
#include <hip/hip_runtime.h>
#include <cstdio>
#include <cstdint>

#ifndef MK_ONE_LAUNCH
#define MK_ONE_LAUNCH 1
#endif

#define GAS __attribute__((address_space(1)))
#define LAS __attribute__((address_space(3)))
typedef unsigned short bf16_t;
typedef short bf16x8 __attribute__((ext_vector_type(8)));
typedef short s16x4 __attribute__((ext_vector_type(4)));
typedef float f32x2 __attribute__((ext_vector_type(2)));
typedef float f32x4 __attribute__((ext_vector_type(4)));
typedef float f32x16 __attribute__((ext_vector_type(16)));
typedef unsigned u32x2 __attribute__((ext_vector_type(2)));
typedef unsigned u32x4 __attribute__((ext_vector_type(4)));
typedef __bf16 bf16x2_t __attribute__((ext_vector_type(2)));

constexpr int NB = 8, SEQ = 4096, DM = 1024, M = NB * SEQ, NLAYER = 2;
constexpr int IN_COLS = 4256, NPA = 1792, NGATE = 2048, NINP = 3840;
constexpr int NE = 16, CAP = 512, MR = NB * NE * CAP;
constexpr float RMS_EPS = 1e-6f;
constexpr int PROJ_QLAT = 1024, PROJ_KVLAT = 1408, PROJ_KROPE = 1664;

constexpr size_t MiB = 1u << 20;
constexpr size_t WS_CTL = 0, CTL_ZERO_BYTES = 64 * 1024;
constexpr size_t WS_TAB = 1 * MiB;
constexpr size_t WS_AFF = 2 * MiB;
constexpr size_t WS_SLOT = 4 * MiB;
constexpr size_t WS_IDXR = 6 * MiB;
constexpr size_t WS_VALR = 6 * MiB + 512 * 1024;
constexpr size_t WS_KPE = 7 * MiB;
constexpr size_t WS_WSM = 9 * MiB;
constexpr size_t WSM_STRIDE = 17 * MiB;
constexpr size_t WS_H = 44 * MiB;
constexpr size_t WS_R1 = 108 * MiB;
constexpr size_t R_PROJA = WS_R1 + 0, R_GATES = WS_R1 + 112 * MiB, R_VT = WS_R1 + 240 * MiB, R_Q = WS_R1 + 272 * MiB, R_KV = WS_R1 + 320 * MiB, R_ATT = WS_R1 + 384 * MiB;
constexpr size_t R_MERGED = WS_R1 + 0;
constexpr size_t R_XG = WS_R1 + 0, R_MOEOUT = WS_R1 + 0, R_ACT = WS_R1 + 128 * MiB, R_W13 = WS_R1 + 256 * MiB, R_W2T = WS_R1 + 320 * MiB, R_PBF = WS_R1 + 352 * MiB, R_PE = WS_R1 + 368 * MiB;
constexpr size_t WS_END = WS_R1 + 448 * MiB;
constexpr size_t OFF_WIN = 0, OFF_WV = 3932160, OFF_WQ = 4456448, OFF_WKV = 4751360, OFF_WNAO = 5013504, OFF_WMLAO = 5537792, OFF_WOUT = 6062080, OFF_WPG = 7110656, OFF_WPW = 8159232;
static_assert(8421376 * 2 <= WSM_STRIDE, "small weights fit");
constexpr int CW_BAR = 1024;

constexpr int RING_BYTES = 131072, LDSCTL_OFF = RING_BYTES, LDS_BYTES = 147456;

#define LDS_WAIT() asm volatile("s_waitcnt lgkmcnt(0)" ::: "memory")
__device__ __forceinline__ unsigned pkbf(float lo, float hi) { f32x2 v = {lo, hi}; bf16x2_t b = __builtin_convertvector(v, bf16x2_t); return __builtin_bit_cast(unsigned, b); }
__device__ __forceinline__ float bf_lo(unsigned w) { return __uint_as_float(w << 16); }
__device__ __forceinline__ float bf_hi(unsigned w) { return __uint_as_float(w & 0xffff0000u); }
__device__ __forceinline__ float bf1(bf16_t h) { return __uint_as_float(((unsigned)h) << 16); }
__device__ __forceinline__ float sigmoidf_(float x) { return __builtin_amdgcn_rcpf(1.f + __expf(-x)); }
__device__ __forceinline__ float wave_sum(float v) {
#pragma unroll
    for (int o = 1; o < 64; o <<= 1) v += __shfl_xor(v, o);
    return v;
}

namespace pg8 {
constexpr int BM = 256, BK = 64, HALF = 128, HTB = HALF * BK * 2, STAGE_BYTES = 8 * HTB, NXCD = 8, WGM = 8;
__host__ __device__ __forceinline__ int lds_byte(int r, int c) { const int st = (r >> 4) * 2 + (c >> 5), rr = r & 15, cc = c & 31, ob = rr * 64 + cc * 2; return st * 1024 + (ob ^ (((ob >> 9) & 1) << 5)); }
__host__ __device__ __forceinline__ void stage_rc(int b, int& R, int& C) { const int st = b / 1024, sb = b % 1024, swz = sb ^ (((sb >> 9) & 1) << 5); R = (st >> 1) * 16 + swz / 64; C = (st & 1) * 32 + (swz % 64) / 2; }
__host__ __device__ __forceinline__ int perm32(int rho) { const int n = rho >> 4, i = rho & 15; return 8 * (i >> 2) + 4 * n + (i & 3); }

struct Unit { int pm, pn; };
struct Gemm { const bf16_t* A; const bf16_t* Bt; int lda, ldb, K; };

struct StaticOrder {
    int nM, nN, nwg, G, c;
    __host__ __device__ void init(int M_, int N_, int G_, int c_) { nM = M_ / BM; nN = N_ / BM; nwg = nM * nN; G = G_; c = c_; }
    __host__ __device__ bool next(int i, Unit& u) const {
        const long L = (long)i * G + c; if (L >= nwg) return false;
        int wgid = (int)L; { const int q = nwg / NXCD, r = nwg % NXCD, xcd = wgid % NXCD, off = wgid / NXCD; wgid = (xcd < r ? xcd * (q + 1) : r * (q + 1) + (xcd - r) * q) + off; }
        const int nig = WGM * nN, gid = wgid / nig, fm = gid * WGM, gsz = (nM - fm) < WGM ? (nM - fm) : WGM;
        u.pm = fm + ((wgid % nig) % gsz); u.pn = (wgid % nig) / gsz; return true;
    }
};
struct MoeOrder {
    StaticOrder S; int shift;
    __device__ void init(int M_, int N_, int G_, int c_, int shift_) { S.init(M_, N_, G_, c_); shift = shift_; }
    __device__ bool next(int i, Unit& u) const { if (!S.next(i, u)) return false; u.pn += (u.pm >> 4) << shift; return true; }
};

typedef f32x4 Acc[2][2][4][2];

struct EpiPlain {
    bf16_t* O; int ldc; int pn_mod;
    __device__ __forceinline__ void operator()(const Acc& acc, const Unit& u, int wr, int wc, int fr, int fq) const {
        const int col0 = (u.pn % pn_mod) * BM + wc * 32 + 8 * fq, row0 = u.pm * BM + wr * 64 + fr;
#pragma unroll
        for (int ai = 0; ai < 2; ++ai)
#pragma unroll
            for (int m = 0; m < 4; ++m) { bf16_t* rowp = O + (size_t)(row0 + ai * HALF + m * 16) * ldc + col0;
#pragma unroll
                for (int bj = 0; bj < 2; ++bj) { const f32x4 v0 = acc[ai][bj][m][0], v1 = acc[ai][bj][m][1];
                    u32x4 w; w.x = pkbf(v0[0], v0[1]); w.y = pkbf(v0[2], v0[3]); w.z = pkbf(v1[0], v1[1]); w.w = pkbf(v1[2], v1[3]);
                    *(u32x4*)(rowp + bj * HALF) = w; } }
    }
};
struct EpiInProj {
    bf16_t* PA; bf16_t* GT;
    __device__ __forceinline__ void operator()(const Acc& acc, const Unit& u, int wr, int wc, int fr, int fq) const {
        const bool gate = u.pn >= 7; bf16_t* O = gate ? GT : PA; const int ldc = gate ? NGATE : NPA;
        const int col0 = (gate ? (u.pn - 7) : u.pn) * BM + wc * 32 + 8 * fq, row0 = u.pm * BM + wr * 64 + fr;
#pragma unroll
        for (int ai = 0; ai < 2; ++ai)
#pragma unroll
            for (int m = 0; m < 4; ++m) { bf16_t* rowp = O + (size_t)(row0 + ai * HALF + m * 16) * ldc + col0;
#pragma unroll
                for (int bj = 0; bj < 2; ++bj) { f32x4 v0 = acc[ai][bj][m][0], v1 = acc[ai][bj][m][1];
                    if (gate) {
#pragma unroll
                        for (int q = 0; q < 4; ++q) { v0[q] = sigmoidf_(v0[q]); v1[q] = sigmoidf_(v1[q]); } }
                    u32x4 w; w.x = pkbf(v0[0], v0[1]); w.y = pkbf(v0[2], v0[3]); w.z = pkbf(v1[0], v1[1]); w.w = pkbf(v1[2], v1[3]);
                    *(u32x4*)(rowp + bj * HALF) = w; } }
    }
};
struct EpiQRope {
    bf16_t* O; const float* tab;
    __device__ __forceinline__ void operator()(const Acc& acc, const Unit& u, int wr, int wc, int fr, int fq) const {
        const int row0 = u.pm * BM + wr * 64 + fr;
#pragma unroll
        for (int bj = 0; bj < 2; ++bj) {
            const int col = u.pn * BM + bj * HALF + wc * 32 + 8 * fq;
            const int dl = col % 96;
            const bool pe = dl >= 64; const int grp = (dl - 64) >> 4;
#pragma unroll
            for (int ai = 0; ai < 2; ++ai)
#pragma unroll
                for (int m = 0; m < 4; ++m) { const int row = row0 + ai * HALF + m * 16;
                    f32x4 v0 = acc[ai][bj][m][0], v1 = acc[ai][bj][m][1];
                    float x[8] = {v0[0], v0[1], v0[2], v0[3], v1[0], v1[1], v1[2], v1[3]}, y[8];
#pragma unroll
                    for (int q = 0; q < 8; ++q) y[q] = __shfl_xor(x[q], 16);
                    if (pe) { const int s = row & (SEQ - 1); const int pos = grp ? (s & 63) : (s >> 6);
                        const f32x4* tp = (const f32x4*)(tab + pos * 16);
                        const f32x4 t0 = tp[0], t1 = tp[1], t2 = tp[2], t3 = tp[3];
                        const float cs[8] = {t0[0], t0[2], t1[0], t1[2], t2[0], t2[2], t3[0], t3[2]}, sn[8] = {t0[1], t0[3], t1[1], t1[3], t2[1], t2[3], t3[1], t3[3]};
                        const float sg = (fq & 1) ? 1.f : -1.f;
#pragma unroll
                        for (int q = 0; q < 8; ++q) x[q] = x[q] * cs[q] + sg * y[q] * sn[q]; }
                    u32x4 w; w.x = pkbf(x[0], x[1]); w.y = pkbf(x[2], x[3]); w.z = pkbf(x[4], x[5]); w.w = pkbf(x[6], x[7]);
                    *(u32x4*)(O + (size_t)row * 768 + col) = w; __builtin_amdgcn_sched_barrier(0); } }
    }
};
struct EpiGate {
    const bf16_t* Gt; bf16_t* O; int add;
    __device__ __forceinline__ void operator()(const Acc& acc, const Unit& u, int wr, int wc, int fr, int fq) const {
        const int col0 = u.pn * BM + wc * 32 + 8 * fq, row0 = u.pm * BM + wr * 64 + fr;
#pragma unroll
        for (int ai = 0; ai < 2; ++ai)
#pragma unroll
            for (int m = 0; m < 4; ++m) { const size_t row = (size_t)(row0 + ai * HALF + m * 16);
#pragma unroll
                for (int bj = 0; bj < 2; ++bj) { const f32x4 v0 = acc[ai][bj][m][0], v1 = acc[ai][bj][m][1];
                    const u32x4 g = *(const u32x4*)(Gt + row * NGATE + col0 + bj * HALF);
                    u32x4 p = {0u, 0u, 0u, 0u}; if (add) p = *(const u32x4*)(O + row * DM + col0 + bj * HALF);
                    u32x4 w;
                    w.x = pkbf(bf_lo(p.x) + bf_lo(g.x) * v0[0], bf_hi(p.x) + bf_hi(g.x) * v0[1]);
                    w.y = pkbf(bf_lo(p.y) + bf_lo(g.y) * v0[2], bf_hi(p.y) + bf_hi(g.y) * v0[3]);
                    w.z = pkbf(bf_lo(p.z) + bf_lo(g.z) * v1[0], bf_hi(p.z) + bf_hi(g.z) * v1[1]);
                    w.w = pkbf(bf_lo(p.w) + bf_lo(g.w) * v1[2], bf_hi(p.w) + bf_hi(g.w) * v1[3]);
                    *(u32x4*)(O + row * DM + col0 + bj * HALF) = w; } }
    }
};
struct EpiResid {
    const float* Xin; float* Xout;
    __device__ __forceinline__ void operator()(const Acc& acc, const Unit& u, int wr, int wc, int fr, int fq) const {
        const int col0 = u.pn * BM + wc * 32 + 8 * fq, row0 = u.pm * BM + wr * 64 + fr;
#pragma unroll
        for (int ai = 0; ai < 2; ++ai)
#pragma unroll
            for (int m = 0; m < 4; ++m) { const size_t off = (size_t)(row0 + ai * HALF + m * 16) * DM + col0;
#pragma unroll
                for (int bj = 0; bj < 2; ++bj) { const f32x4 a0 = *(const f32x4*)(Xin + off + bj * HALF), a1 = *(const f32x4*)(Xin + off + bj * HALF + 4);
                    *(f32x4*)(Xout + off + bj * HALF) = a0 + acc[ai][bj][m][0]; *(f32x4*)(Xout + off + bj * HALF + 4) = a1 + acc[ai][bj][m][1]; } }
    }
};
struct EpiSwiGLU {
    bf16_t* O;
    __device__ __forceinline__ void operator()(const Acc& acc, const Unit& u, int wr, int wc, int fr, int fq) const {
        const int col0 = (u.pn & 7) * HALF + wc * 32 + 8 * fq, row0 = u.pm * BM + wr * 64 + fr;
#pragma unroll
        for (int ai = 0; ai < 2; ++ai)
#pragma unroll
            for (int m = 0; m < 4; ++m) { float r[8];
#pragma unroll
                for (int n = 0; n < 2; ++n)
#pragma unroll
                    for (int q = 0; q < 4; ++q) { const float a = acc[ai][0][m][n][q], b = acc[ai][1][m][n][q]; r[n * 4 + q] = a * sigmoidf_(a) * b; }
                u32x4 w; w.x = pkbf(r[0], r[1]); w.y = pkbf(r[2], r[3]); w.z = pkbf(r[4], r[5]); w.w = pkbf(r[6], r[7]);
                *(u32x4*)(O + (size_t)(row0 + ai * HALF + m * 16) * 1024 + col0) = w; }
    }
};
struct EpiMoeDown {
    bf16_t* O; const float* val;
    __device__ __forceinline__ void operator()(const Acc& acc, const Unit& u, int wr, int wc, int fr, int fq) const {
        const int col0 = (u.pn & 3) * BM + wc * 32 + 8 * fq, row0 = u.pm * BM + wr * 64 + fr;
#pragma unroll
        for (int ai = 0; ai < 2; ++ai)
#pragma unroll
            for (int m = 0; m < 4; ++m) { const int row = row0 + ai * HALF + m * 16; const float s = val[row]; bf16_t* rowp = O + (size_t)row * 1024 + col0;
#pragma unroll
                for (int bj = 0; bj < 2; ++bj) { const f32x4 v0 = acc[ai][bj][m][0] * s, v1 = acc[ai][bj][m][1] * s;
                    u32x4 w; w.x = pkbf(v0[0], v0[1]); w.y = pkbf(v0[2], v0[3]); w.z = pkbf(v1[0], v1[1]); w.w = pkbf(v1[2], v1[3]);
                    *(u32x4*)(rowp + bj * HALF) = w; } }
    }
};
struct EpiPle {
    float* X; const bf16_t* PE;
    __device__ __forceinline__ void operator()(const Acc& acc, const Unit& u, int wr, int wc, int fr, int fq) const {
        const int col0 = u.pn * BM + wc * 32 + 8 * fq, row0 = u.pm * BM + wr * 64 + fr;
#pragma unroll
        for (int ai = 0; ai < 2; ++ai)
#pragma unroll
            for (int m = 0; m < 4; ++m) { const size_t off = (size_t)(row0 + ai * HALF + m * 16) * DM + col0;
#pragma unroll
                for (int bj = 0; bj < 2; ++bj) { const f32x4 v0 = acc[ai][bj][m][0], v1 = acc[ai][bj][m][1];
                    const u32x4 p = *(const u32x4*)(PE + off + bj * HALF);
                    f32x4 a0 = *(const f32x4*)(X + off + bj * HALF), a1 = *(const f32x4*)(X + off + bj * HALF + 4);
                    a0[0] += sigmoidf_(v0[0]) * bf_lo(p.x); a0[1] += sigmoidf_(v0[1]) * bf_hi(p.x); a0[2] += sigmoidf_(v0[2]) * bf_lo(p.y); a0[3] += sigmoidf_(v0[3]) * bf_hi(p.y);
                    a1[0] += sigmoidf_(v1[0]) * bf_lo(p.z); a1[1] += sigmoidf_(v1[1]) * bf_hi(p.z); a1[2] += sigmoidf_(v1[2]) * bf_lo(p.w); a1[3] += sigmoidf_(v1[3]) * bf_hi(p.w);
                    *(f32x4*)(X + off + bj * HALF) = a0; *(f32x4*)(X + off + bj * HALF + 4) = a1; } }
    }
};

template <class Epi, class Sched>
__device__ __forceinline__ void gemm_phase(LAS unsigned char* lds, const Gemm g, const Sched& S, const Epi& E) {
    int tid = threadIdx.x; asm volatile("" : "+v"(tid));
    const int wid = __builtin_amdgcn_readfirstlane(tid >> 6), lane = tid & 63, wr = wid >> 2, wc = wid & 3, fr = lane & 15, fq = lane >> 4;
    const int K = g.K, nt = K / BK;
    unsigned voffA[2], voffB[2];
#pragma unroll
    for (int i = 0; i < 2; ++i) { int R, C; stage_rc(tid * 16 + i * 8192, R, C); const int Rb = (R & ~31) + perm32(R & 31);
        voffA[i] = (unsigned)(R * g.lda + C) * 2u; voffB[i] = (unsigned)(Rb * g.ldb + C) * 2u; }
    const size_t kstep = (size_t)(BK * 2);
    const size_t hstepA = (size_t)HALF * g.lda * 2, hstepB = (size_t)HALF * g.ldb * 2;
    const size_t tstepA = 2 * hstepA, tstepB = 2 * hstepB;
    const unsigned ldsw = (unsigned)wid * 1024u;
    const int aoff = lds_byte(wr * 64 + fr, fq * 8), boff = lds_byte(wc * 32 + fr, fq * 8);
#define PG8_SA(b, h) (((b) * 2 + (h)) * HTB)
#define PG8_SB(b, h) ((4 + (b) * 2 + (h)) * HTB)
#define PG8_STAGE(bufoff, gbase, voff) do { _Pragma("unroll") for (int _i = 0; _i < 2; ++_i) \
        __builtin_amdgcn_global_load_lds((const unsigned*)((const char*)(gbase) + (voff)[_i]), (LAS unsigned*)(lds + (bufoff) + ldsw + _i * 8192), 16, 0, 0); } while (0)
#define PG8_LDA(dst, b, h) do { _Pragma("unroll") for (int m = 0; m < 4; ++m) _Pragma("unroll") for (int k = 0; k < 2; ++k) dst[m][k] = *(const LAS bf16x8*)(lds + PG8_SA(b, h) + aoff + m * 2048 + k * 1024); } while (0)
#define PG8_LDB(dst, b, h) do { _Pragma("unroll") for (int n = 0; n < 2; ++n) _Pragma("unroll") for (int k = 0; k < 2; ++k) dst[n][k] = *(const LAS bf16x8*)(lds + PG8_SB(b, h) + boff + n * 2048 + k * 1024); } while (0)
#define PG8_MMA(ai, bj, At, Bt) do { __builtin_amdgcn_s_setprio(1); _Pragma("unroll") for (int m = 0; m < 4; ++m) _Pragma("unroll") for (int n = 0; n < 2; ++n) _Pragma("unroll") for (int k = 0; k < 2; ++k) \
        acc[ai][bj][m][n] = __builtin_amdgcn_mfma_f32_16x16x32_bf16(Bt[n][k], At[m][k], acc[ai][bj][m][n], 0, 0, 0); __builtin_amdgcn_s_setprio(0); } while (0)
#define PG8_WAIT_V(n) asm volatile("s_waitcnt vmcnt(" #n ")" ::: "memory")
#define PG8_WAIT_L(n) asm volatile("s_waitcnt lgkmcnt(" #n ")" ::: "memory")
#define PG8_BAR __builtin_amdgcn_s_barrier()
#define PG8_SCHED __builtin_amdgcn_sched_barrier(0)
    Unit cur, nxt; int ui = 0;
    if (!S.next(0, cur)) return;
    f32x4 acc[2][2][4][2];
#pragma unroll
    for (int a = 0; a < 2; ++a)
#pragma unroll
        for (int b = 0; b < 2; ++b)
#pragma unroll
            for (int m = 0; m < 4; ++m)
#pragma unroll
                for (int n = 0; n < 2; ++n) acc[a][b][m][n] = (f32x4){0.f, 0.f, 0.f, 0.f};
    bf16x8 At[4][2], B0[2][2], B1[2][2];
    const char* cA = (const char*)g.A + (size_t)cur.pm * tstepA; const char* cB = (const char*)g.Bt + (size_t)cur.pn * tstepB;
    PG8_STAGE(PG8_SB(0, 0), cB, voffB); PG8_STAGE(PG8_SB(0, 1), cB + hstepB, voffB); PG8_STAGE(PG8_SA(0, 0), cA, voffA); PG8_STAGE(PG8_SA(0, 1), cA + hstepA, voffA);
    if (wr == 1) PG8_BAR;
    PG8_WAIT_V(2); PG8_BAR;
    PG8_STAGE(PG8_SB(1, 0), cB + kstep, voffB); PG8_STAGE(PG8_SA(1, 0), cA + kstep, voffA); PG8_STAGE(PG8_SB(1, 1), cB + hstepB + kstep, voffB);
    PG8_WAIT_V(6); PG8_BAR;
    for (;;) {
        const bool has_next = S.next(ui + 1, nxt);
        const char* nA = has_next ? (const char*)g.A + (size_t)nxt.pm * tstepA : cA; const char* nB = has_next ? (const char*)g.Bt + (size_t)nxt.pn * tstepB : cB;
#pragma unroll 1
        for (int t = 0; t < nt; t += 2) {
            const bool last = (t == nt - 2);
            const char* a1 = cA + (size_t)(t + 1) * kstep;
            const char* a2 = last ? nA : cA + (size_t)(t + 2) * kstep; const char* b2 = last ? nB : cB + (size_t)(t + 2) * kstep;
            const char* a3 = a2 + kstep; const char* b3 = b2 + kstep;
            PG8_LDB(B0, 0, 0); PG8_LDB(B1, 0, 1); PG8_SCHED; PG8_LDA(At, 0, 0); PG8_STAGE(PG8_SA(1, 1), a1 + hstepA, voffA);
            PG8_WAIT_V(8); PG8_WAIT_L(0); PG8_BAR; PG8_MMA(0, 0, At, B0); PG8_MMA(0, 1, At, B1); PG8_BAR; PG8_SCHED;
            PG8_LDA(At, 0, 1); PG8_STAGE(PG8_SB(0, 0), b2, voffB); PG8_STAGE(PG8_SB(0, 1), b2 + hstepB, voffB); PG8_STAGE(PG8_SA(0, 0), a2, voffA);
            PG8_WAIT_V(8); PG8_WAIT_L(0); PG8_BAR; PG8_MMA(1, 0, At, B0); PG8_MMA(1, 1, At, B1); PG8_BAR; PG8_SCHED;
            PG8_LDB(B0, 1, 0); PG8_LDB(B1, 1, 1); PG8_SCHED; PG8_LDA(At, 1, 0); PG8_STAGE(PG8_SA(0, 1), a2 + hstepA, voffA);
            PG8_WAIT_V(8); PG8_WAIT_L(0); PG8_BAR; PG8_MMA(0, 0, At, B0); PG8_MMA(0, 1, At, B1); PG8_BAR; PG8_SCHED;
            PG8_LDA(At, 1, 1); PG8_STAGE(PG8_SB(1, 0), b3, voffB); PG8_STAGE(PG8_SB(1, 1), b3 + hstepB, voffB); PG8_STAGE(PG8_SA(1, 0), a3, voffA);
            PG8_WAIT_V(8); PG8_WAIT_L(0); PG8_BAR; PG8_MMA(1, 0, At, B0); PG8_MMA(1, 1, At, B1); PG8_BAR; PG8_SCHED;
        }
        if (wr == 0) PG8_BAR;
        E(acc, cur, wr, wc, fr, fq);
        if (!has_next) break;
#pragma unroll
        for (int a = 0; a < 2; ++a)
#pragma unroll
            for (int b = 0; b < 2; ++b)
#pragma unroll
                for (int m = 0; m < 4; ++m)
#pragma unroll
                    for (int n = 0; n < 2; ++n) acc[a][b][m][n] = (f32x4){0.f, 0.f, 0.f, 0.f};
        cur = nxt; cA = nA; cB = nB; ++ui;
        if (wr == 1) PG8_BAR;
    }
    PG8_WAIT_V(0);
    PG8_BAR;
#undef PG8_SA
#undef PG8_SB
#undef PG8_STAGE
#undef PG8_LDA
#undef PG8_LDB
#undef PG8_MMA
#undef PG8_WAIT_V
#undef PG8_WAIT_L
#undef PG8_BAR
#undef PG8_SCHED
}
}

namespace mla {
constexpr int NW = 8, QBLK = 32, KVBLK = 64;
constexpr float SCALE = 0.10206207261596575f;
constexpr float THR = 8.f;
constexpr int SHM_V = KVBLK * 64 * 2, SHM_K = KVBLK * 256;
constexpr int OFF_V = 0, OFF_K = 2 * SHM_V, OFF_WS = OFF_K + 2 * SHM_K, LDS_NEED = OFF_WS + NW * 64 * 4;
#define KSWZ(row, colB) ((row) * 256 + ((colB) ^ (((row) & 7) << 4)))
#define SBAR() __builtin_amdgcn_sched_barrier(0)
__device__ __forceinline__ int crow(int r, int hi) { return (r & 3) + 8 * (r >> 2) + 4 * hi; }

__device__ __forceinline__ void partialSM(f32x16& p0, f32x16& p1, float& m_reg, float& mn, float& alpha) {
  constexpr float C = SCALE * 1.4426950408889634f;
  float pmax = p0[0];
#pragma unroll
  for (int r = 1; r < 16; ++r) pmax = fmaxf(pmax, p0[r]);
#pragma unroll
  for (int r = 0; r < 16; ++r) pmax = fmaxf(pmax, p1[r]);
  { auto rr = __builtin_amdgcn_permlane32_swap(__float_as_uint(pmax), __float_as_uint(pmax), false, false);
    pmax = fmaxf(__uint_as_float(rr[0]), __uint_as_float(rr[1])); }
  if (__builtin_expect(__all(pmax - m_reg <= THR / SCALE), 1)) { mn = m_reg; alpha = 1.f; }
  else { mn = fmaxf(m_reg, pmax); alpha = __builtin_amdgcn_exp2f((m_reg - mn) * C); m_reg = mn; }
  const float mnC = -mn * C;
#pragma unroll
  for (int r = 0; r < 16; ++r) p0[r] = fmaf(p0[r], C, mnC);
#pragma unroll
  for (int r = 0; r < 16; ++r) p1[r] = fmaf(p1[r], C, mnC);
#pragma unroll
  for (int r = 0; r < 16; ++r) p0[r] = __builtin_amdgcn_exp2f(p0[r]);
}
__device__ __forceinline__ void finishSM(f32x16& p0, f32x16& p1, float alpha, float& l_reg, bf16x8& pa0, bf16x8& pa1, bf16x8& pa2, bf16x8& pa3) {
#pragma unroll
  for (int r = 0; r < 16; ++r) p1[r] = __builtin_amdgcn_exp2f(p1[r]);
  float ps = 0;
#pragma unroll
  for (int r = 0; r < 16; ++r) ps += p0[r];
#pragma unroll
  for (int r = 0; r < 16; ++r) ps += p1[r];
  { auto rr = __builtin_amdgcn_permlane32_swap(__float_as_uint(ps), __float_as_uint(ps), false, false);
    ps = __uint_as_float(rr[0]) + __uint_as_float(rr[1]); }
  l_reg = l_reg * alpha + ps;
#define PK4(P, BASE, OUT) do { unsigned a0 = pkbf(P[BASE + 0], P[BASE + 1]), a1 = pkbf(P[BASE + 2], P[BASE + 3]);   \
    unsigned b0 = pkbf(P[BASE + 4], P[BASE + 5]), b1 = pkbf(P[BASE + 6], P[BASE + 7]);                              \
    auto r0 = __builtin_amdgcn_permlane32_swap(a0, b0, false, false); auto r1 = __builtin_amdgcn_permlane32_swap(a1, b1, false, false); \
    u32x4 w = {r0[0], r1[0], r0[1], r1[1]}; OUT = __builtin_bit_cast(bf16x8, w); } while (0)
  PK4(p0, 0, pa0); PK4(p0, 8, pa1); PK4(p1, 0, pa2); PK4(p1, 8, pa3);
#undef PK4
}
__device__ __forceinline__ void qkt(f32x16& p0, f32x16& p1, const LAS unsigned char* Ks, const bf16x8* qr, int r32, int hi) {
  p0 = f32x16{}; p1 = f32x16{};
#pragma unroll
  for (int d0 = 0; d0 < 6; ++d0) { const int cb = (d0 * 16 + hi * 8) * 2;
    const bf16x8 b0 = *(const LAS bf16x8*)(Ks + KSWZ(r32, cb));
    const bf16x8 b1 = *(const LAS bf16x8*)(Ks + KSWZ(32 + r32, cb));
    p0 = __builtin_amdgcn_mfma_f32_32x32x16_bf16(b0, qr[d0], p0, 0, 0, 0);
    p1 = __builtin_amdgcn_mfma_f32_32x32x16_bf16(b1, qr[d0], p1, 0, 0, 0); }
}
__device__ __forceinline__ int v_st(int k, int c) { const int kk = (k & ~0xC) | ((k & 4) << 1) | ((k & 8) >> 1); return ((kk >> 3) * 2 + (c >> 5)) * 512 + ((kk & 7) * 32 + (c & 31)) * 2; }
__device__ __forceinline__ int v_rd_base(int lane) { return ((lane & 3) << 3) | (((lane >> 2) & 3) << 6) | (((lane >> 4) & 1) << 5) | (((lane >> 5) & 1) << 8); }
constexpr int v_rd_off(int d0, int ks, int half) { return d0 * 512 + ks * 2048 + half * 1024; }
template <int OFF> __device__ __forceinline__ s16x4 tr_read(int vb) {
  s16x4 r; asm volatile("ds_read_b64_tr_b16 %0, %1 offset:%2" : "=&v"(r) : "v"(vb), "i"(OFF) : "memory"); return r;
}
template <int D0> __device__ __forceinline__ void pv_one(f32x16& od, int vb, bf16x8 pa0, bf16x8 pa1, bf16x8 pa2, bf16x8 pa3) {
  const s16x4 l0 = tr_read<v_rd_off(D0, 0, 0)>(vb), h0 = tr_read<v_rd_off(D0, 0, 1)>(vb), l1 = tr_read<v_rd_off(D0, 1, 0)>(vb), h1 = tr_read<v_rd_off(D0, 1, 1)>(vb);
  const s16x4 l2 = tr_read<v_rd_off(D0, 2, 0)>(vb), h2 = tr_read<v_rd_off(D0, 2, 1)>(vb), l3 = tr_read<v_rd_off(D0, 3, 0)>(vb), h3 = tr_read<v_rd_off(D0, 3, 1)>(vb);
  asm volatile("s_waitcnt lgkmcnt(0)" ::: "memory"); SBAR();
#define PK(L, H) (bf16x8){L[0], L[1], L[2], L[3], H[0], H[1], H[2], H[3]}
  od = __builtin_amdgcn_mfma_f32_32x32x16_bf16(pa0, PK(l0, h0), od, 0, 0, 0);
  od = __builtin_amdgcn_mfma_f32_32x32x16_bf16(pa1, PK(l1, h1), od, 0, 0, 0);
  od = __builtin_amdgcn_mfma_f32_32x32x16_bf16(pa2, PK(l2, h2), od, 0, 0, 0);
  od = __builtin_amdgcn_mfma_f32_32x32x16_bf16(pa3, PK(l3, h3), od, 0, 0, 0);
#undef PK
}
__device__ __forceinline__ void pv_d0(f32x16* o, int vb, bf16x8 pa0, bf16x8 pa1, bf16x8 pa2, bf16x8 pa3) {
  pv_one<0>(o[0], vb, pa0, pa1, pa2, pa3); pv_one<1>(o[1], vb, pa0, pa1, pa2, pa3);
}
__device__ __forceinline__ void unit(int b, int h, int qb, const bf16_t* __restrict__ Qg, const bf16_t* __restrict__ KVg, const bf16_t* __restrict__ KPE, bf16_t* __restrict__ ATT, LAS unsigned char* lds) {
  int tid = threadIdx.x; asm volatile("" : "+v"(tid));
  const int wid = tid >> 6, lane = tid & 63, r32 = lane & 31, hi = lane >> 5;
  LAS unsigned char* V_lds = lds + OFF_V; LAS unsigned char* K_lds = lds + OFF_K;
  LAS float* ws = (LAS float*)(lds + OFF_WS) + wid * 64; LAS float* li_l = ws; LAS float* al_l = ws + 32;
  float m_reg = -1e30f, l_reg = 0; f32x16 o[2] = {}; bf16x8 qr[6];
  const size_t tok0 = (size_t)b * SEQ;
  const bf16_t* Qw = Qg + (tok0 + qb * 256 + wid * QBLK + r32) * 768 + h * 96 + hi * 8;
#pragma unroll
  for (int d0 = 0; d0 < 6; ++d0) qr[d0] = *(const bf16x8*)(Qw + d0 * 16);
  const int sk = tid >> 3, sc8 = tid & 7, skp = (tid & 255) >> 2, scp = tid & 3;
  const bf16_t* vsrc = KVg + (tok0 + sk) * 1024 + h * 128 + 64 + sc8 * 8;
  const bf16_t* ksrc = KVg + (tok0 + sk) * 1024 + h * 128 + sc8 * 8;
  const bf16_t* psrc = KPE + (tok0 + skp) * 32 + scp * 8;
  const int vst = v_st(sk, sc8 * 8), kst = KSWZ(sk, sc8 * 16), pst = KSWZ(skp, 128 + scp * 16);
  const int vb0 = (int)(unsigned)(uintptr_t)V_lds + v_rd_base(lane);
  struct { bf16x8 v, k, p; } sr_[2];
#define SLOAD(i, k0) do { sr_[i].v = *(const bf16x8*)(vsrc + (size_t)(k0) * 1024); sr_[i].k = *(const bf16x8*)(ksrc + (size_t)(k0) * 1024); sr_[i].p = *(const bf16x8*)(psrc + (size_t)(k0) * 32); } while (0)
#define SWRITE(bb, i) do { *(LAS bf16x8*)(V_lds + (bb) * SHM_V + vst) = sr_[i].v; *(LAS bf16x8*)(K_lds + (bb) * SHM_K + kst) = sr_[i].k; *(LAS bf16x8*)(K_lds + (bb) * SHM_K + pst) = sr_[i].p; } while (0)
#define SWAIT() asm volatile("s_waitcnt vmcnt(3)" ::: "memory")
#define RESC(a) do { if (__any((a) < 1.f)) { if (hi == 0) al_l[r32] = (a); asm volatile("s_waitcnt lgkmcnt(0)" ::: "memory"); \
    _Pragma("unroll") for (int d = 0; d < 2; ++d) _Pragma("unroll") for (int r = 0; r < 16; ++r) o[d][r] *= al_l[crow(r, hi)]; } } while (0)
  f32x16 pA0, pA1, pB0, pB1; float mnA, mnB, alA, alB; bf16x8 pa0, pa1, pa2, pa3; constexpr int NT = SEQ / KVBLK;
  constexpr int SE = 0, SO = 1;
  SLOAD(SE, 0); asm volatile("s_waitcnt vmcnt(0)" ::: "memory"); SWRITE(0, SE); __syncthreads();
  qkt(pA0, pA1, K_lds, qr, r32, hi); partialSM(pA0, pA1, m_reg, mnA, alA);
  SLOAD(SO, KVBLK); SLOAD(SE, 2 * KVBLK);
  SWAIT(); SWRITE(1, SO); __syncthreads();
  for (int j = 1; j + 1 < NT; j += 2) {
    SBAR(); qkt(pB0, pB1, K_lds + SHM_K, qr, r32, hi);
    finishSM(pA0, pA1, alA, l_reg, pa0, pa1, pa2, pa3); SBAR();
    SLOAD(SO, (j + 2) * KVBLK); SBAR();
    pv_d0(o, vb0, pa0, pa1, pa2, pa3); partialSM(pB0, pB1, m_reg, mnB, alB);
    __syncthreads(); SWAIT(); SWRITE(0, SE);
    RESC(alB); __syncthreads();
    SBAR(); qkt(pA0, pA1, K_lds, qr, r32, hi);
    finishSM(pB0, pB1, alB, l_reg, pa0, pa1, pa2, pa3); SBAR();
    if (j + 3 < NT) SLOAD(SE, (j + 3) * KVBLK); SBAR();
    pv_d0(o, vb0 + SHM_V, pa0, pa1, pa2, pa3); partialSM(pA0, pA1, m_reg, mnA, alA);
    __syncthreads(); SWAIT(); SWRITE(1, SO);
    RESC(alA); __syncthreads();
  }
  SBAR(); qkt(pB0, pB1, K_lds + SHM_K, qr, r32, hi);
  finishSM(pA0, pA1, alA, l_reg, pa0, pa1, pa2, pa3); SBAR();
  pv_d0(o, vb0, pa0, pa1, pa2, pa3); partialSM(pB0, pB1, m_reg, mnB, alB);
  __syncthreads(); RESC(alB);
  finishSM(pB0, pB1, alB, l_reg, pa0, pa1, pa2, pa3); SBAR();
  pv_d0(o, vb0 + SHM_V, pa0, pa1, pa2, pa3);
  if (hi == 0) li_l[r32] = l_reg; asm volatile("s_waitcnt lgkmcnt(0)" ::: "memory");
  float rli[16];
#pragma unroll
  for (int r = 0; r < 16; ++r) rli[r] = __builtin_amdgcn_rcpf(li_l[crow(r, hi)]);
  bf16_t* Ow = ATT + (tok0 + qb * 256 + wid * QBLK) * 1024 + 512 + h * 64;
#pragma unroll
  for (int r = 0; r < 16; ++r) { const int orow = crow(r, hi);
#pragma unroll
    for (int d0 = 0; d0 < 2; ++d0) Ow[(size_t)orow * 1024 + d0 * 32 + r32] = (bf16_t)(pkbf(o[d0][r] * rli[r], 0.f) & 0xffffu); }
  asm volatile("s_waitcnt lgkmcnt(0)" ::: "memory");
  __syncthreads();
#undef SLOAD
#undef SWRITE
#undef SWAIT
#undef RESC
}
#undef KSWZ
#undef SBAR
}

namespace na {
__device__ __forceinline__ void unit(int b, int hp, int r, const bf16_t* __restrict__ PA, const bf16_t* __restrict__ VT, bf16_t* __restrict__ ATT, const LAS float* rpb) {
  int tid = threadIdx.x; asm volatile("" : "+v"(tid));
  const int wid = tid >> 6, lane = tid & 63, l15 = lane & 15, g = lane >> 4;
  const int h = hp * 2 + (wid >> 2), w4 = wid & 3;
  const int bs = (w4 == 0) ? 0 : (w4 == 1) ? 8 : (w4 == 2) ? 24 : 32;
  const int r0 = min(max(r - 4, 0), 56);
  const int c = 16 * w4 + l15, cs = min(max(c - 8, 0), 48);
  const size_t tokq = (size_t)b * SEQ + r * 64 + c;
  bf16x8 qf[2];
#pragma unroll
  for (int ks = 0; ks < 2; ++ks) qf[ks] = *(const bf16x8*)(PA + tokq * NPA + h * 64 + ks * 32 + g * 8);
  f32x4 s[16];
#pragma unroll
  for (int j = 0; j < 8; ++j)
#pragma unroll
    for (int hf = 0; hf < 2; ++hf) {
      const size_t tokk = (size_t)b * SEQ + (r0 + j) * 64 + bs + 16 * hf + l15;
      const bf16x8 k0 = *(const bf16x8*)(PA + tokk * NPA + 512 + h * 64 + g * 8), k1 = *(const bf16x8*)(PA + tokk * NPA + 512 + h * 64 + 32 + g * 8);
      f32x4 a = {0.f, 0.f, 0.f, 0.f};
      a = __builtin_amdgcn_mfma_f32_16x16x32_bf16(k0, qf[0], a, 0, 0, 0);
      a = __builtin_amdgcn_mfma_f32_16x16x32_bf16(k1, qf[1], a, 0, 0, 0);
      s[j * 2 + hf] = a; }
  const LAS float* rb = rpb + h * 465;
  float mx = -1e30f;
#pragma unroll
  for (int j = 0; j < 8; ++j)
#pragma unroll
    for (int hf = 0; hf < 2; ++hf)
#pragma unroll
      for (int i = 0; i < 4; ++i) {
        const int cp = bs + 16 * hf + 4 * g + i; const bool ok = (cp >= cs) && (cp < cs + 16);
        const int bi = (r0 + j - r + 7) * 31 + (ok ? (cp - c + 15) : 15);
        const float v = ok ? s[j * 2 + hf][i] * 0.125f + rb[bi] : -1e30f;
        s[j * 2 + hf][i] = v; mx = fmaxf(mx, v); }
  mx = fmaxf(mx, __shfl_xor(mx, 16)); mx = fmaxf(mx, __shfl_xor(mx, 32));
  float sum = 0.f;
#pragma unroll
  for (int q = 0; q < 16; ++q)
#pragma unroll
    for (int i = 0; i < 4; ++i) { const float p = __expf(s[q][i] - mx); s[q][i] = p; sum += p; }
  sum += __shfl_xor(sum, 16); sum += __shfl_xor(sum, 32);
  const float rl = __builtin_amdgcn_rcpf(sum);
  f32x4 o[4];
#pragma unroll
  for (int db = 0; db < 4; ++db) o[db] = (f32x4){0.f, 0.f, 0.f, 0.f};
#pragma unroll
  for (int j = 0; j < 8; ++j) {
    u32x4 pw; pw.x = pkbf(s[2 * j][0], s[2 * j][1]); pw.y = pkbf(s[2 * j][2], s[2 * j][3]); pw.z = pkbf(s[2 * j + 1][0], s[2 * j + 1][1]); pw.w = pkbf(s[2 * j + 1][2], s[2 * j + 1][3]);
    const bf16x8 pb = __builtin_bit_cast(bf16x8, pw);
    const size_t tk = (size_t)b * SEQ + (r0 + j) * 64 + bs + 4 * g;
#pragma unroll
    for (int db = 0; db < 4; ++db) {
      const bf16_t* vp = VT + (size_t)(h * 64 + db * 16 + l15) * M + tk;
      const u32x2 lo = *(const u32x2*)vp, hi2 = *(const u32x2*)(vp + 16);
      const u32x4 vw = {lo.x, lo.y, hi2.x, hi2.y};
      o[db] = __builtin_amdgcn_mfma_f32_16x16x32_bf16(__builtin_bit_cast(bf16x8, vw), pb, o[db], 0, 0, 0); } }
  bf16_t* op = ATT + tokq * 1024 + h * 64 + 4 * g;
#pragma unroll
  for (int db = 0; db < 4; ++db) { u32x2 w; w.x = pkbf(o[db][0] * rl, o[db][1] * rl); w.y = pkbf(o[db][2] * rl, o[db][3] * rl); *(u32x2*)(op + db * 16) = w; }
}
}

#define XB_TMO      128
#define XB_XCNT(j)  (256  + 64 * (j))
#define XB_XSUB(j)  (1280 + 64 * (j))
#define XB_XGEN(j)  (2304 + 64 * (j))
#define XB_TOP      3328
#define XB_TOPGEN   3392
#define XCD_BAR_WORDS 3456
#define XB_SPIN_CAP (1u << 22)
__device__ __forceinline__ unsigned xb_ld(unsigned* p)              { return __hip_atomic_load(p, __ATOMIC_RELAXED, __HIP_MEMORY_SCOPE_AGENT); }
__device__ __forceinline__ unsigned xb_add(unsigned* p, unsigned v) { return __hip_atomic_fetch_add(p, v, __ATOMIC_RELAXED, __HIP_MEMORY_SCOPE_AGENT); }
__device__ __forceinline__ unsigned xb_xcc_id() { return (unsigned)__builtin_amdgcn_s_getreg((3 << 11) | 20) & 0xFu; }
#define XB_SPIN(cond, bar) do { unsigned _sp = 0; while (cond) { __builtin_amdgcn_s_sleep(1); \
    if ((++_sp & 255u) == 0u) { if (xb_ld(&(bar)[XB_TMO])) break; if (_sp > XB_SPIN_CAP) { atomicAdd(&(bar)[XB_TMO], 1u); break; } } } } while (0)
struct XcdBarrier { unsigned* bar; unsigned x; volatile LAS unsigned* st; };
__device__ __forceinline__ XcdBarrier xcd_barrier_post(unsigned* bar, volatile LAS unsigned* st) {
    XcdBarrier b; b.bar = bar; b.x = xb_xcc_id(); b.st = st;
    if (threadIdx.x == 0) (void)xb_add(&bar[XB_XCNT(b.x)], 1u);
    return b;
}
__device__ __forceinline__ void xcd_barrier_complete(unsigned* bar, unsigned x, unsigned& nloc, unsigned& nx) {
    const unsigned G = gridDim.x * gridDim.y * gridDim.z;
    unsigned sum, cnt, mine, sp = 0u;
    for (;;) {
        sum = 0u; cnt = 0u; mine = 0u;
#pragma unroll
        for (unsigned j = 0; j < 16; ++j) { const unsigned c = xb_ld(&bar[XB_XCNT(j)]); sum += c; cnt += (c > 0u) ? 1u : 0u; mine = (j == x) ? c : mine; }
        if (sum == G) break;
        __builtin_amdgcn_s_sleep(1);
        if ((++sp & 255u) == 0u) { if (xb_ld(&bar[XB_TMO])) break; if (sp > XB_SPIN_CAP) { atomicAdd(&bar[XB_TMO], 1u); break; } }
    }
    nloc = mine > 0u ? mine : 1u; nx = cnt > 0u ? cnt : 1u;
}
__device__ __forceinline__ void xcd_barrier(const XcdBarrier& b) {
    asm volatile("s_waitcnt vmcnt(0)" ::: "memory");
    __syncthreads();
    if (threadIdx.x == 0) {
        unsigned* bar = b.bar;
        __builtin_amdgcn_s_waitcnt(0);
        unsigned nloc = b.st[0], nx = b.st[1];
        if (nloc == 0u) { xcd_barrier_complete(bar, b.x, nloc, nx); b.st[0] = nloc; b.st[1] = nx; }
        const unsigned old = xb_add(&bar[XB_XSUB(b.x)], 1u);
        const unsigned gen = old / nloc;
        if (old + 1u == (gen + 1u) * nloc) {
            __builtin_amdgcn_fence(__ATOMIC_RELEASE, "agent");
            asm volatile("s_waitcnt vmcnt(0)" ::: "memory");
            const unsigned og = xb_add(&bar[XB_TOP], 1u);
            const unsigned tg = og / nx;
            if (og + 1u == (tg + 1u) * nx) xb_add(&bar[XB_TOPGEN], 1u);
            else XB_SPIN(xb_ld(&bar[XB_TOPGEN]) == tg, bar);
            __builtin_amdgcn_fence(__ATOMIC_ACQUIRE, "agent");
            xb_add(&bar[XB_XGEN(b.x)], 1u);
            asm volatile("s_waitcnt vmcnt(0)" ::: "memory");
        } else {
            XB_SPIN(xb_ld(&bar[XB_XGEN(b.x)]) == gen, bar);
            __builtin_amdgcn_fence(__ATOMIC_ACQUIRE, "agent");
            asm volatile("s_waitcnt vmcnt(0)" ::: "memory");
        }
    }
    __syncthreads();
}

__device__ __forceinline__ void tr_item(const float* __restrict__ W, int ldw, int k0, int n0, bf16_t* __restrict__ WT, int ldt, int drow0, LAS float* scr, int lane) {
#pragma unroll 8
    for (int i = 0; i < 32; ++i) { const int kk = 2 * i + (lane >> 5); scr[kk * 33 + (lane & 31)] = W[(size_t)(k0 + kk) * ldw + n0 + (lane & 31)]; }
    LDS_WAIT(); asm volatile("" ::: "memory");
    const int c = lane & 7;
#pragma unroll
    for (int j = 0; j < 4; ++j) { const int n = (lane >> 3) + 8 * j; const LAS float* s = scr + (8 * c) * 33 + n;
        u32x4 o; o.x = pkbf(s[0 * 33], s[1 * 33]); o.y = pkbf(s[2 * 33], s[3 * 33]); o.z = pkbf(s[4 * 33], s[5 * 33]); o.w = pkbf(s[6 * 33], s[7 * 33]);
        *(u32x4*)(WT + (size_t)(drow0 + n) * ldt + k0 + 8 * c) = o; }
    LDS_WAIT(); asm volatile("" ::: "memory");
}
template <bool OUTF>
__device__ __forceinline__ void rms_row(const float* xrow, const float* gain, bf16_t* orow, float* orowf, int lane) {
    const f32x4* xr = (const f32x4*)xrow + lane; const f32x4* gr = (const f32x4*)gain + lane;
    f32x4 v[4]; float s = 0.f;
#pragma unroll
    for (int j = 0; j < 4; ++j) { v[j] = xr[64 * j]; s += (v[j][0] * v[j][0] + v[j][1] * v[j][1]) + (v[j][2] * v[j][2] + v[j][3] * v[j][3]); }
    const float rstd = 1.f / sqrtf(wave_sum(s) * (1.f / DM) + RMS_EPS);
#pragma unroll
    for (int j = 0; j < 4; ++j) { const f32x4 gq = gr[64 * j]; const f32x4 y = v[j] * rstd * gq;
        if (OUTF) ((f32x4*)orowf + lane)[64 * j] = y;
        else { u32x2 w; w.x = pkbf(y[0], y[1]); w.y = pkbf(y[2], y[3]); ((u32x2*)orow + lane)[64 * j] = w; } }
}

__device__ __forceinline__ void topk_item(int b, int e, const float* __restrict__ AFF, int* __restrict__ IDXR, float* __restrict__ VALR, int* __restrict__ SLOT, LAS unsigned* sh, int tid, int lane, int wave) {
    unsigned u[8];
    const float* src = AFF + ((size_t)(b * SEQ + tid * 8)) * 16 + e;
#pragma unroll
    for (int i = 0; i < 8; ++i) u[i] = __float_as_uint(src[i * 16]);
    LAS unsigned* hist = sh; LAS unsigned* misc = sh + 256;
    unsigned prefix = 0u, mask = 0u, kth = CAP;
    for (int pass = 0; pass < 4; ++pass) {
        const int shift = 24 - 8 * pass;
        if (tid < 256) hist[tid] = 0u;
        __syncthreads();
#pragma unroll
        for (int i = 0; i < 8; ++i) if ((u[i] & mask) == prefix) (void)__hip_atomic_fetch_add(&hist[(u[i] >> shift) & 255u], 1u, __ATOMIC_RELAXED, __HIP_MEMORY_SCOPE_WORKGROUP);
        __syncthreads();
        if (wave == 0) {
            const unsigned h0 = hist[4 * lane], h1 = hist[4 * lane + 1], h2 = hist[4 * lane + 2], h3 = hist[4 * lane + 3];
            const unsigned sl = h0 + h1 + h2 + h3;
            unsigned inc = sl;
#pragma unroll
            for (int o = 1; o < 64; o <<= 1) { const unsigned t = __shfl_down(inc, o); if (lane + o < 64) inc += t; }
            const unsigned exc = inc - sl;
            if (exc < kth && kth <= inc) {
                unsigned cc = exc; int dsel;
                if (cc + h3 >= kth) dsel = 3; else { cc += h3; if (cc + h2 >= kth) dsel = 2; else { cc += h2; if (cc + h1 >= kth) dsel = 1; else { cc += h1; dsel = 0; } } }
                misc[0] = (unsigned)(4 * lane + dsel); misc[1] = kth - cc;
            }
        }
        __syncthreads();
        prefix |= misc[0] << shift; mask |= 255u << shift; kth = misc[1];
    }
    const unsigned T = prefix, need = kth;
    unsigned ng = 0u, neq = 0u;
#pragma unroll
    for (int i = 0; i < 8; ++i) { ng += (u[i] > T) ? 1u : 0u; neq += (u[i] == T) ? 1u : 0u; }
    const unsigned packed = ng | (neq << 16);
    unsigned inc = packed;
#pragma unroll
    for (int o = 1; o < 64; o <<= 1) { const unsigned t = __shfl_up(inc, o); if (lane >= o) inc += t; }
    __syncthreads();
    if (lane == 63) misc[2 + wave] = inc;
    __syncthreads();
    unsigned woff = 0u;
#pragma unroll
    for (int w = 0; w < 8; ++w) if (w < wave) woff += misc[2 + w];
    const unsigned exc = woff + inc - packed;
    unsigned gpos = exc & 0xffffu, epos = exc >> 16;
    const unsigned total_gt = CAP - need;
#pragma unroll
    for (int i = 0; i < 8; ++i) { const int t = tid * 8 + i; int slot = -1;
        if (u[i] > T) slot = (int)(gpos++);
        else if (u[i] == T) { if (epos < need) slot = (int)(total_gt + epos); epos++; }
        SLOT[(size_t)(b * SEQ + t) * 16 + e] = slot;
        if (slot >= 0) { const int rr = (e * NB + b) * CAP + slot; IDXR[rr] = b * SEQ + t; VALR[rr] = __uint_as_float(u[i]); } }
    __syncthreads();
}

struct Args { const float* in[24]; int ph_lo, ph_hi; };
constexpr int NPH = 14, NPHASES = 1 + NLAYER * NPH;

__global__ void __launch_bounds__(512, 2) fwd(Args a) {
    extern __shared__ __attribute__((aligned(16))) unsigned char lds_raw[];
    LAS unsigned char* lds = (LAS unsigned char*)lds_raw;
    const int G = gridDim.x, bx = blockIdx.x;
    const int vcu = (G % 8 == 0) ? (bx % 8) * (G / 8) + bx / 8 : bx;
    const int NGW = G * 8;
    unsigned char* ws = (unsigned char*)a.in[22];
    volatile LAS unsigned* MISC = (volatile LAS unsigned*)(lds + LDSCTL_OFF);
    for (int u = threadIdx.x; u < (LDS_BYTES - LDSCTL_OFF) / 4; u += 512) ((LAS unsigned*)(lds + LDSCTL_OFF))[u] = 0u;
    __syncthreads();
    const int lo = a.ph_lo, hi = a.ph_hi;
    XcdBarrier bar; bar.bar = (unsigned*)(ws + WS_CTL) + CW_BAR; bar.x = 0; bar.st = nullptr;
    if (hi - lo > 1) bar = xcd_barrier_post((unsigned*)(ws + WS_CTL) + CW_BAR, MISC + 8);
#define IN(k) (lo <= (k) && (k) < hi)
#define SEAM(k) do { if (IN(k) && IN((k) + 1)) xcd_barrier(bar); } while (0)

#define ARGP(k) ({ int kk_ = (k); asm volatile("" : "+s"(kk_)); (const float*)(GAS const float*)a.in[kk_]; })
#define WSP(T, off) ((T*)(wsq + (off)))
#define PHASE_PTRS() int tid = threadIdx.x; asm volatile("" : "+v"(tid)); const int lane = tid & 63, wave = __builtin_amdgcn_readfirstlane(tid >> 6); const int gw = vcu * 8 + wave; (void)lane; (void)gw; \
    unsigned char* wsq = (unsigned char*)ARGP(22); float* X = (float*)ARGP(21); \
    bf16_t* H = WSP(bf16_t, WS_H); float* TAB = WSP(float, WS_TAB); float* AFF = WSP(float, WS_AFF); int* SLOT = WSP(int, WS_SLOT); int* IDXR = WSP(int, WS_IDXR); float* VALR = WSP(float, WS_VALR); \
    bf16_t* KPE = WSP(bf16_t, WS_KPE); bf16_t* PROJA = WSP(bf16_t, R_PROJA); bf16_t* GATES = WSP(bf16_t, R_GATES); bf16_t* VT = WSP(bf16_t, R_VT); bf16_t* Qb = WSP(bf16_t, R_Q); bf16_t* KVb = WSP(bf16_t, R_KV); \
    bf16_t* ATT = WSP(bf16_t, R_ATT); bf16_t* MERGED = WSP(bf16_t, R_MERGED); bf16_t* XG = WSP(bf16_t, R_XG); bf16_t* MOEOUT = WSP(bf16_t, R_MOEOUT); bf16_t* ACT = WSP(bf16_t, R_ACT); \
    bf16_t* W13 = WSP(bf16_t, R_W13); bf16_t* W2T = WSP(bf16_t, R_W2T); bf16_t* PBF = WSP(bf16_t, R_PBF); bf16_t* PE = WSP(bf16_t, R_PE); \
    const bf16_t* wl = (const bf16_t*)(wsq + WS_WSM + (size_t)l * WSM_STRIDE); \
    (void)H; (void)TAB; (void)AFF; (void)SLOT; (void)IDXR; (void)VALR; (void)KPE; (void)PROJA; (void)GATES; (void)VT; (void)Qb; (void)KVb; (void)ATT; (void)MERGED; (void)XG; (void)MOEOUT; (void)ACT; (void)W13; (void)W2T; (void)PBF; (void)PE; (void)wl; (void)X

    if (IN(0)) {
        const int l = 0; PHASE_PTRS(); const float* x_in = ARGP(0);
        LAS float* scr = (LAS float*)(lds + wave * 16384);
        for (int it = gw; it < 2 * 4064; it += NGW) {
            const int l = it / 4064; int r = it % 4064;
            bf16_t* wl = (bf16_t*)(wsq + WS_WSM + (size_t)l * WSM_STRIDE);
            if (r < 2128) { const int kb = r / 133, nb = r % 133, n0 = nb * 32; bf16_t* dst; int dr;
                if (n0 < 1024) { dst = wl + OFF_WIN; dr = n0; } else if (n0 < 1536) { dst = wl + OFF_WV; dr = n0 - 1024; } else if (n0 < 2208) { dst = wl + OFF_WIN; dr = n0 - 512; } else { dst = wl + OFF_WIN; dr = n0 - 416; }
                tr_item(ARGP(3) + (size_t)l * 1024 * IN_COLS, IN_COLS, kb * 64, n0, dst, 1024, dr, scr, lane); continue; } r -= 2128;
            if (r < 144) { tr_item(ARGP(6) + (size_t)l * 384 * 768, 768, (r / 24) * 64, (r % 24) * 32, wl + OFF_WQ, 384, (r % 24) * 32, scr, lane); continue; } r -= 144;
            if (r < 128) { tr_item(ARGP(8) + (size_t)l * 256 * 1024, 1024, (r / 32) * 64, (r % 32) * 32, wl + OFF_WKV, 256, (r % 32) * 32, scr, lane); continue; } r -= 128;
            if (r < 256) { tr_item(ARGP(9) + (size_t)l * 512 * 1024, 1024, (r / 32) * 64, (r % 32) * 32, wl + OFF_WNAO, 512, (r % 32) * 32, scr, lane); continue; } r -= 256;
            if (r < 256) { tr_item(ARGP(10) + (size_t)l * 512 * 1024, 1024, (r / 32) * 64, (r % 32) * 32, wl + OFF_WMLAO, 512, (r % 32) * 32, scr, lane); continue; } r -= 256;
            if (r < 512) { tr_item(ARGP(11) + (size_t)l * 1024 * 1024, 1024, (r / 32) * 64, (r % 32) * 32, wl + OFF_WOUT, 1024, (r % 32) * 32, scr, lane); continue; } r -= 512;
            if (r < 512) { tr_item(ARGP(18) + (size_t)l * 1024 * 1024, 1024, (r / 32) * 64, (r % 32) * 32, wl + OFF_WPG, 1024, (r % 32) * 32, scr, lane); continue; } r -= 512;
            tr_item(ARGP(19) + (size_t)l * 256 * 1024, 1024, (r / 32) * 64, (r % 32) * 32, wl + OFF_WPW, 256, (r % 32) * 32, scr, lane);
        }
        for (int i = bx * 512 + tid; i < 2 * 96 * 128; i += G * 512) { const int l = i / (96 * 128), r = i % (96 * 128);
            bf16_t* wl = (bf16_t*)(wsq + WS_WSM + (size_t)l * WSM_STRIDE) + OFF_WIN + (size_t)1696 * 1024; *(u32x4*)(wl + (size_t)r * 8) = (u32x4){0u, 0u, 0u, 0u}; }
        if (bx == 0) { const int pos = tid >> 3, j = tid & 7; const float f = exp2f(-(float)j * 1.6609640474436813f); const float rev = (float)pos * f * 0.15915494309189535f; const float fr = rev - floorf(rev);
            TAB[tid * 2] = __builtin_amdgcn_cosf(fr); TAB[tid * 2 + 1] = __builtin_amdgcn_sinf(fr); }
        for (int m = gw; m < M; m += NGW) rms_row<false>(x_in + (size_t)m * DM, ARGP(2), H + (size_t)m * DM, nullptr, lane);
    }
    SEAM(0);

    for (int l = 0; l < NLAYER; ++l) {
        const int pb = 1 + l * NPH;
        if (IN(pb + 0)) { PHASE_PTRS();
            { pg8::Gemm g{H, wl + OFF_WIN, 1024, 1024, 1024}; pg8::StaticOrder S; S.init(M, NINP, G, bx); pg8::EpiInProj E{PROJA, GATES};
              pg8::gemm_phase(lds, g, S, E); }
            { pg8::Gemm g{wl + OFF_WV, H, 1024, 1024, 1024}; pg8::StaticOrder S; S.init(512, M, G, bx); pg8::EpiPlain E{VT, M, 1 << 20};
              pg8::gemm_phase(lds, g, S, E); }
        }
        SEAM(pb + 0);
        if (IN(pb + 1)) { PHASE_PTRS();
            const float* qn = ARGP(5) + l * 384; const float* kn = ARGP(7) + l * 256;
            for (int t = gw; t < M; t += NGW) {
                bf16_t* pr = PROJA + (size_t)t * NPA;
                unsigned q[3], kv[2]; float sq = 0.f, sk = 0.f;
#pragma unroll
                for (int j = 0; j < 3; ++j) { q[j] = *(const unsigned*)(pr + PROJ_QLAT + 2 * lane + 128 * j); const float a0 = bf_lo(q[j]), a1 = bf_hi(q[j]); sq += a0 * a0 + a1 * a1; }
#pragma unroll
                for (int j = 0; j < 2; ++j) { kv[j] = *(const unsigned*)(pr + PROJ_KVLAT + 2 * lane + 128 * j); const float a0 = bf_lo(kv[j]), a1 = bf_hi(kv[j]); sk += a0 * a0 + a1 * a1; }
                const float xr = bf1(pr[PROJ_KROPE + (lane & 31)]);
                const float rq = 1.f / sqrtf(wave_sum(sq) * (1.f / 384.f) + RMS_EPS), rk = 1.f / sqrtf(wave_sum(sk) * (1.f / 256.f) + RMS_EPS);
#pragma unroll
                for (int j = 0; j < 3; ++j) { const f32x2 gq = *(const f32x2*)(qn + 2 * lane + 128 * j); *(unsigned*)(pr + PROJ_QLAT + 2 * lane + 128 * j) = pkbf(bf_lo(q[j]) * rq * gq[0], bf_hi(q[j]) * rq * gq[1]); }
#pragma unroll
                for (int j = 0; j < 2; ++j) { const f32x2 gk = *(const f32x2*)(kn + 2 * lane + 128 * j); *(unsigned*)(pr + PROJ_KVLAT + 2 * lane + 128 * j) = pkbf(bf_lo(kv[j]) * rk * gk[0], bf_hi(kv[j]) * rk * gk[1]); }
                const float xp = __shfl_xor(xr, 8);
                const int s = t & (SEQ - 1), pos = (lane & 16) ? (s & 63) : (s >> 6), jf = lane & 7;
                const float cs = TAB[(pos * 8 + jf) * 2], sn = TAB[(pos * 8 + jf) * 2 + 1];
                const float outv = (lane & 8) ? (xr * cs + xp * sn) : (xr * cs - xp * sn);
                if (lane < 32) KPE[(size_t)t * 32 + lane] = (bf16_t)(pkbf(outv, 0.f) & 0xffffu);
            }
        }
        SEAM(pb + 1);
        if (IN(pb + 2)) { PHASE_PTRS();
            { pg8::Gemm g{PROJA + PROJ_QLAT, wl + OFF_WQ, NPA, 384, 384}; pg8::StaticOrder S; S.init(M, 768, G, bx); pg8::EpiQRope E{Qb, TAB};
              pg8::gemm_phase(lds, g, S, E); }
            { pg8::Gemm g{PROJA + PROJ_KVLAT, wl + OFF_WKV, NPA, 256, 256}; pg8::StaticOrder S; S.init(M, 1024, G, G - 1 - bx); pg8::EpiPlain E{KVb, 1024, 1 << 20};
              pg8::gemm_phase(lds, g, S, E); }
        }
        SEAM(pb + 2);
        if (IN(pb + 3)) { PHASE_PTRS();
            { const int upb = (1024 + G - 1) / G;
              for (int i = 0; i < upb; ++i) { const int u = vcu * upb + i; if (u >= 1024) break; const int bh = u >> 4, qb = u & 15; mla::unit(bh >> 3, bh & 7, qb, Qb, KVb, KPE, ATT, lds); } }
            LAS float* rpb = (LAS float*)(lds + 65536);
            for (int i = tid; i < 8 * 465; i += 512) rpb[i] = ARGP(4)[l * 8 * 465 + i];
            __syncthreads();
            { const int upb = (2048 + G - 1) / G;
              for (int i = 0; i < upb; ++i) { const int u = vcu * upb + i; if (u >= 2048) break; const int r = u & 63, bh = u >> 6; na::unit(bh >> 2, bh & 3, r, PROJA, VT, ATT, rpb); } }
            __syncthreads();
        }
        SEAM(pb + 3);
        if (IN(pb + 4)) { PHASE_PTRS();
            { pg8::Gemm g{ATT, wl + OFF_WNAO, 1024, 512, 512}; pg8::StaticOrder S; S.init(M, 1024, G, bx); pg8::EpiGate E{GATES, MERGED, 0};
              pg8::gemm_phase(lds, g, S, E); }
            { pg8::Gemm g{ATT + 512, wl + OFF_WMLAO, 1024, 512, 512}; pg8::StaticOrder S; S.init(M, 1024, G, bx); pg8::EpiGate E{GATES + 1024, MERGED, 1};
              pg8::gemm_phase(lds, g, S, E); }
        }
        SEAM(pb + 4);
        if (IN(pb + 5)) { PHASE_PTRS();
            pg8::Gemm g{MERGED, wl + OFF_WOUT, 1024, 1024, 1024}; pg8::StaticOrder S; S.init(M, 1024, G, bx); pg8::EpiResid E{l == 0 ? ARGP(0) : (const float*)X, X};
            pg8::gemm_phase(lds, g, S, E);
        }
        SEAM(pb + 5);
        if (IN(pb + 6)) { PHASE_PTRS();
            LAS float* wr = (LAS float*)lds;
            const float* wrg = ARGP(13) + (size_t)l * 1024 * 16;
            for (int i = tid; i < 1024 * 4; i += 512) { const int k = i >> 2, c4 = i & 3; const int slot = (k & 3) * 256 + ((k >> 8) & 3) * 64 + ((k >> 2) & 63);
                *(LAS f32x4*)(wr + slot * 20 + c4 * 4) = *(const f32x4*)(wrg + k * 16 + c4 * 4); }
            __syncthreads();
            const float* gain = ARGP(12) + l * 1024;
            for (int m = gw; m < M; m += NGW) {
                const f32x4* xr = (const f32x4*)(X + (size_t)m * DM) + lane; const f32x4* gr = (const f32x4*)gain + lane;
                f32x4 v[4]; float s = 0.f;
#pragma unroll
                for (int j = 0; j < 4; ++j) { v[j] = xr[64 * j]; s += (v[j][0] * v[j][0] + v[j][1] * v[j][1]) + (v[j][2] * v[j][2] + v[j][3] * v[j][3]); }
                const float rstd = 1.f / sqrtf(wave_sum(s) * (1.f / DM) + RMS_EPS);
                float lg[16];
#pragma unroll
                for (int e = 0; e < 16; ++e) lg[e] = 0.f;
#pragma unroll
                for (int j = 0; j < 4; ++j) { v[j] = v[j] * rstd * gr[64 * j];
                    u32x2 w; w.x = pkbf(v[j][0], v[j][1]); w.y = pkbf(v[j][2], v[j][3]); ((u32x2*)(H + (size_t)m * DM) + lane)[64 * j] = w;
#pragma unroll
                    for (int q = 0; q < 4; ++q) { const LAS f32x4* wp = (const LAS f32x4*)(wr + (q * 256 + j * 64 + lane) * 20); const float xv = v[j][q];
#pragma unroll
                        for (int c4 = 0; c4 < 4; ++c4) { const f32x4 w4 = wp[c4]; lg[c4 * 4 + 0] += xv * w4[0]; lg[c4 * 4 + 1] += xv * w4[1]; lg[c4 * 4 + 2] += xv * w4[2]; lg[c4 * 4 + 3] += xv * w4[3]; } __builtin_amdgcn_sched_barrier(0); } }
                float mxl = -1e30f;
#pragma unroll
                for (int e = 0; e < 16; ++e) { lg[e] = wave_sum(lg[e]); mxl = fmaxf(mxl, lg[e]); }
                float se = 0.f;
#pragma unroll
                for (int e = 0; e < 16; ++e) { lg[e] = __expf(lg[e] - mxl); se += lg[e]; }
                float mine = 0.f;
#pragma unroll
                for (int e = 0; e < 16; ++e) mine = (lane == e) ? lg[e] : mine;
                if (lane < 16) AFF[(size_t)m * 16 + lane] = mine / se;
            }
            __syncthreads();
        }
        SEAM(pb + 6);
        if (IN(pb + 7)) { PHASE_PTRS();
            LAS unsigned* sh = (LAS unsigned*)(lds + 9216);
            for (int it = bx; it < NB * NE; it += G) topk_item(it >> 4, it & 15, AFF, IDXR, VALR, SLOT, sh, tid, lane, wave);
            LAS float* scr = (LAS float*)(lds + wave * 16384);
            for (int it = gw; it < 3 * 8192; it += NGW) {
                const int which = it >> 13, r = it & 8191, e = r >> 9, kb = (r >> 5) & 15, nb = r & 31, n0 = nb * 32;
                const size_t eoff = (size_t)(l * 16 + e) * 1024 * 1024;
                if (which == 0) tr_item(ARGP(14) + eoff, 1024, kb * 64, n0, W13 + (size_t)e * 2048 * 1024, 1024, (n0 >> 7) * 256 + (n0 & 127), scr, lane);
                else if (which == 1) tr_item(ARGP(15) + eoff, 1024, kb * 64, n0, W13 + (size_t)e * 2048 * 1024, 1024, (n0 >> 7) * 256 + 128 + (n0 & 127), scr, lane);
                else tr_item(ARGP(16) + eoff, 1024, kb * 64, n0, W2T + (size_t)e * 1024 * 1024, 1024, n0, scr, lane);
            }
            const float* pl = ARGP(1) + (size_t)l * M * 256;
            for (size_t i = (size_t)bx * 512 + tid; i < (size_t)M * 256 / 8; i += (size_t)G * 512) { const f32x4 a0 = *(const f32x4*)(pl + i * 8), a1 = *(const f32x4*)(pl + i * 8 + 4);
                u32x4 w; w.x = pkbf(a0[0], a0[1]); w.y = pkbf(a0[2], a0[3]); w.z = pkbf(a1[0], a1[1]); w.w = pkbf(a1[2], a1[3]); *(u32x4*)(PBF + i * 8) = w; }
        }
        SEAM(pb + 7);
        if (IN(pb + 8)) { PHASE_PTRS();
            for (int rr = gw; rr < MR; rr += NGW) { const int src = __builtin_amdgcn_readfirstlane(IDXR[rr]);
                const u32x4* sp = (const u32x4*)(H + (size_t)src * DM) + lane; u32x4* dp = (u32x4*)(XG + (size_t)rr * DM) + lane;
                const u32x4 v0 = sp[0], v1 = sp[64]; dp[0] = v0; dp[64] = v1; }
        }
        SEAM(pb + 8);
        if (IN(pb + 9)) { PHASE_PTRS();
            pg8::Gemm g{XG, W13, 1024, 1024, 1024}; pg8::MoeOrder S; S.init(MR, 2048, G, bx, 3); pg8::EpiSwiGLU E{ACT};
            pg8::gemm_phase(lds, g, S, E);
        }
        SEAM(pb + 9);
        if (IN(pb + 10)) { PHASE_PTRS();
            { pg8::Gemm g{ACT, W2T, 1024, 1024, 1024}; pg8::MoeOrder S; S.init(MR, 1024, G, bx, 2); pg8::EpiMoeDown E{MOEOUT, VALR};
              pg8::gemm_phase(lds, g, S, E); }
            { pg8::Gemm g{PBF, wl + OFF_WPW, 256, 256, 256}; pg8::StaticOrder S; S.init(M, 1024, G, bx); pg8::EpiPlain E{PE, 1024, 1 << 20};
              pg8::gemm_phase(lds, g, S, E); }
        }
        SEAM(pb + 10);
        if (IN(pb + 11)) { PHASE_PTRS();
            const float* gain = ARGP(17) + l * 1024;
            for (int m = gw; m < M; m += NGW) {
                const int myslot = SLOT[(size_t)m * 16 + (lane & 15)];
                f32x4* xr = (f32x4*)(X + (size_t)m * DM) + lane; const f32x4* gr = (const f32x4*)gain + lane;
                f32x4 v[4];
#pragma unroll
                for (int j = 0; j < 4; ++j) v[j] = xr[64 * j];
                const int b = m >> 12;
#pragma unroll
                for (int e = 0; e < 16; ++e) { const int c = __builtin_amdgcn_readlane(myslot, e);
                    if (c >= 0) { const u32x2* mr = (const u32x2*)(MOEOUT + (size_t)((e * NB + b) * CAP + c) * DM) + lane;
#pragma unroll
                        for (int j = 0; j < 4; ++j) { const u32x2 w = mr[64 * j]; v[j][0] += bf_lo(w.x); v[j][1] += bf_hi(w.x); v[j][2] += bf_lo(w.y); v[j][3] += bf_hi(w.y); } } }
                float s = 0.f;
#pragma unroll
                for (int j = 0; j < 4; ++j) { xr[64 * j] = v[j]; s += (v[j][0] * v[j][0] + v[j][1] * v[j][1]) + (v[j][2] * v[j][2] + v[j][3] * v[j][3]); }
                const float rstd = 1.f / sqrtf(wave_sum(s) * (1.f / DM) + RMS_EPS);
#pragma unroll
                for (int j = 0; j < 4; ++j) { const f32x4 y = v[j] * rstd * gr[64 * j]; u32x2 w; w.x = pkbf(y[0], y[1]); w.y = pkbf(y[2], y[3]); ((u32x2*)(H + (size_t)m * DM) + lane)[64 * j] = w; }
            }
        }
        SEAM(pb + 11);
        if (IN(pb + 12)) { PHASE_PTRS();
            pg8::Gemm g{H, wl + OFF_WPG, 1024, 1024, 1024}; pg8::StaticOrder S; S.init(M, 1024, G, bx); pg8::EpiPle E{X, PE};
            pg8::gemm_phase(lds, g, S, E);
        }
        SEAM(pb + 12);
        if (IN(pb + 13)) { PHASE_PTRS();
            if (l + 1 < NLAYER) { for (int m = gw; m < M; m += NGW) rms_row<false>(X + (size_t)m * DM, ARGP(2) + (l + 1) * 1024, H + (size_t)m * DM, nullptr, lane); }
            else { for (int m = gw; m < M; m += NGW) rms_row<true>(X + (size_t)m * DM, ARGP(20), nullptr, X + (size_t)m * DM, lane); }
        }
        if (l + 1 < NLAYER) SEAM(pb + 13);
    }
#undef IN
#undef SEAM
}

extern "C" void kernel_launch(void* const* d_in, const int* in_sizes, int n_in, void* d_out, int out_size, void* d_ws, size_t ws_size, hipStream_t stream) {
    static int grid = 0;
    if (grid == 0) {
        if (n_in != 21 || out_size != M * DM || ws_size < WS_END) { fprintf(stderr, "kernel_launch: unexpected shapes (n_in %d out %d ws %zu, need ws >= %zu)\n", n_in, out_size, ws_size, (size_t)WS_END); grid = -1; return; }
        int dev = 0, cus = 0, per_cu = 0;
        if (hipGetDevice(&dev) != hipSuccess || hipDeviceGetAttribute(&cus, hipDeviceAttributeMultiprocessorCount, dev) != hipSuccess) { grid = -1; return; }
        if (hipFuncSetAttribute((const void*)fwd, hipFuncAttributeMaxDynamicSharedMemorySize, LDS_BYTES) != hipSuccess) { fprintf(stderr, "kernel_launch: hipFuncSetAttribute failed\n"); grid = -1; return; }
        if (hipOccupancyMaxActiveBlocksPerMultiprocessor(&per_cu, (const void*)fwd, 512, LDS_BYTES) != hipSuccess || per_cu < 1) { fprintf(stderr, "kernel_launch: occupancy query reports %d blocks per CU\n", per_cu); }
        (void)hipGetLastError();
        grid = cus;
    }
    if (grid < 0) return;
    (void)hipMemsetAsync((char*)d_ws + WS_CTL, 0, CTL_ZERO_BYTES, stream);
    Args a{};
    for (int i = 0; i < 21; ++i) a.in[i] = (const float*)d_in[i];
    a.in[21] = (const float*)d_out; a.in[22] = (const float*)d_ws; a.in[23] = nullptr;
#if MK_ONE_LAUNCH
    a.ph_lo = 0; a.ph_hi = NPHASES;
    hipLaunchKernelGGL(fwd, dim3(grid), dim3(512), LDS_BYTES, stream, a);
#else
    for (int p = 0; p < NPHASES; ++p) { a.ph_lo = p; a.ph_hi = p + 1; hipLaunchKernelGGL(fwd, dim3(grid), dim3(512), LDS_BYTES, stream, a); }
#endif
}
```

```cpp
#include <hip/hip_runtime.h>
#include <cstdio>
#include <cstdint>

#ifndef PROBE_PH
#define PROBE_PH -1
#endif
#ifndef MK_ONE_LAUNCH
#define MK_ONE_LAUNCH 1
#endif

#define GAS __attribute__((address_space(1)))
#define LAS __attribute__((address_space(3)))
typedef unsigned short bf16_t;
typedef short bf16x8 __attribute__((ext_vector_type(8)));
typedef short s16x4 __attribute__((ext_vector_type(4)));
typedef float f32x2 __attribute__((ext_vector_type(2)));
typedef float f32x4 __attribute__((ext_vector_type(4)));
typedef float f32x16 __attribute__((ext_vector_type(16)));
typedef unsigned u32x2 __attribute__((ext_vector_type(2)));
typedef unsigned u32x4 __attribute__((ext_vector_type(4)));
typedef __bf16 bf16x2_t __attribute__((ext_vector_type(2)));

constexpr int NB = 8, SEQ = 4096, DM = 1024, M = NB * SEQ, NLAYER = 2;
constexpr int IN_COLS = 4256, NPA = 1792, NGATE = 2048, NINP = 3840;
constexpr int NE = 16, CAP = 512, MR = NB * NE * CAP;
constexpr float RMS_EPS = 1e-6f;
constexpr int PROJ_QLAT = 1024, PROJ_KVLAT = 1408, PROJ_KROPE = 1664;

constexpr size_t MiB = 1u << 20;
constexpr size_t WS_CTL = 0, CTL_ZERO_BYTES = 64 * 1024;
constexpr size_t WS_TAB = 1 * MiB;
constexpr size_t WS_AFF = 2 * MiB;
constexpr size_t WS_SLOT = 4 * MiB;
constexpr size_t WS_IDXR = 6 * MiB;
constexpr size_t WS_VALR = 6 * MiB + 512 * 1024;
constexpr size_t WS_KPE = 7 * MiB;
constexpr size_t WS_WSM = 9 * MiB;
constexpr size_t WSM_STRIDE = 17 * MiB;
constexpr size_t WS_H = 44 * MiB;
constexpr size_t WS_R1 = 108 * MiB;
constexpr size_t R_PROJA = WS_R1 + 0, R_GATES = WS_R1 + 112 * MiB, R_VT = WS_R1 + 240 * MiB, R_Q = WS_R1 + 272 * MiB, R_KV = WS_R1 + 320 * MiB, R_ATT = WS_R1 + 384 * MiB;
constexpr size_t R_MERGED = WS_R1 + 0;
constexpr size_t R_XG = WS_R1 + 0, R_MOEOUT = WS_R1 + 0, R_ACT = WS_R1 + 128 * MiB, R_W13 = WS_R1 + 256 * MiB, R_W2T = WS_R1 + 320 * MiB, R_PBF = WS_R1 + 352 * MiB, R_PE = WS_R1 + 368 * MiB;
constexpr size_t WS_END = WS_R1 + 448 * MiB;
constexpr size_t OFF_WIN = 0, OFF_WV = 3932160, OFF_WQ = 4456448, OFF_WKV = 4751360, OFF_WNAO = 5013504, OFF_WMLAO = 5537792, OFF_WOUT = 6062080, OFF_WPG = 7110656, OFF_WPW = 8159232;
static_assert(8421376 * 2 <= WSM_STRIDE, "small weights fit");
constexpr int CW_BAR = 1024;

constexpr int RING_BYTES = 131072, LDSCTL_OFF = RING_BYTES, LDS_BYTES = 147456;

#define LDS_WAIT() asm volatile("s_waitcnt lgkmcnt(0)" ::: "memory")
__device__ __forceinline__ unsigned pkbf(float lo, float hi) { f32x2 v = {lo, hi}; bf16x2_t b = __builtin_convertvector(v, bf16x2_t); return __builtin_bit_cast(unsigned, b); }
__device__ __forceinline__ float bf_lo(unsigned w) { return __uint_as_float(w << 16); }
__device__ __forceinline__ float bf_hi(unsigned w) { return __uint_as_float(w & 0xffff0000u); }
__device__ __forceinline__ float bf1(bf16_t h) { return __uint_as_float(((unsigned)h) << 16); }
__device__ __forceinline__ float sigmoidf_(float x) { return __builtin_amdgcn_rcpf(1.f + __expf(-x)); }
__device__ __forceinline__ float wave_sum(float v) {
#pragma unroll
    for (int o = 1; o < 64; o <<= 1) v += __shfl_xor(v, o);
    return v;
}

namespace pg8 {
constexpr int BM = 256, BK = 64, HALF = 128, HTB = HALF * BK * 2, STAGE_BYTES = 8 * HTB, NXCD = 8, WGM = 8;
__host__ __device__ __forceinline__ int lds_byte(int r, int c) { const int st = (r >> 4) * 2 + (c >> 5), rr = r & 15, cc = c & 31, ob = rr * 64 + cc * 2; return st * 1024 + (ob ^ (((ob >> 9) & 1) << 5)); }
__host__ __device__ __forceinline__ void stage_rc(int b, int& R, int& C) { const int st = b / 1024, sb = b % 1024, swz = sb ^ (((sb >> 9) & 1) << 5); R = (st >> 1) * 16 + swz / 64; C = (st & 1) * 32 + (swz % 64) / 2; }
__host__ __device__ __forceinline__ int perm32(int rho) { const int n = rho >> 4, i = rho & 15; return 8 * (i >> 2) + 4 * n + (i & 3); }

struct Unit { int pm, pn; };
struct Gemm { const bf16_t* A; const bf16_t* Bt; int lda, ldb, K; };

struct StaticOrder {
    int nM, nN, nwg, G, c;
    __host__ __device__ void init(int M_, int N_, int G_, int c_) { nM = M_ / BM; nN = N_ / BM; nwg = nM * nN; G = G_; c = c_; }
    __host__ __device__ bool next(int i, Unit& u) const {
        const long L = (long)i * G + c; if (L >= nwg) return false;
        int wgid = (int)L; { const int q = nwg / NXCD, r = nwg % NXCD, xcd = wgid % NXCD, off = wgid / NXCD; wgid = (xcd < r ? xcd * (q + 1) : r * (q + 1) + (xcd - r) * q) + off; }
        const int nig = WGM * nN, gid = wgid / nig, fm = gid * WGM, gsz = (nM - fm) < WGM ? (nM - fm) : WGM;
        u.pm = fm + ((wgid % nig) % gsz); u.pn = (wgid % nig) / gsz; return true;
    }
};
struct MoeOrder {
    StaticOrder S; int shift;
    __device__ void init(int M_, int N_, int G_, int c_, int shift_) { S.init(M_, N_, G_, c_); shift = shift_; }
    __device__ bool next(int i, Unit& u) const { if (!S.next(i, u)) return false; u.pn += (u.pm >> 4) << shift; return true; }
};

typedef f32x4 Acc[2][2][4][2];

struct EpiPlain {
    bf16_t* O; int ldc; int pn_mod;
    __device__ __forceinline__ void operator()(const Acc& acc, const Unit& u, int wr, int wc, int fr, int fq) const {
        const int col0 = (u.pn % pn_mod) * BM + wc * 32 + 8 * fq, row0 = u.pm * BM + wr * 64 + fr;
#pragma unroll
        for (int ai = 0; ai < 2; ++ai)
#pragma unroll
            for (int m = 0; m < 4; ++m) { bf16_t* rowp = O + (size_t)(row0 + ai * HALF + m * 16) * ldc + col0;
#pragma unroll
                for (int bj = 0; bj < 2; ++bj) { const f32x4 v0 = acc[ai][bj][m][0], v1 = acc[ai][bj][m][1];
                    u32x4 w; w.x = pkbf(v0[0], v0[1]); w.y = pkbf(v0[2], v0[3]); w.z = pkbf(v1[0], v1[1]); w.w = pkbf(v1[2], v1[3]);
                    *(u32x4*)(rowp + bj * HALF) = w; } }
    }
};
struct EpiInProj {
    bf16_t* PA; bf16_t* GT;
    __device__ __forceinline__ void operator()(const Acc& acc, const Unit& u, int wr, int wc, int fr, int fq) const {
        const bool gate = u.pn >= 7; bf16_t* O = gate ? GT : PA; const int ldc = gate ? NGATE : NPA;
        const int col0 = (gate ? (u.pn - 7) : u.pn) * BM + wc * 32 + 8 * fq, row0 = u.pm * BM + wr * 64 + fr;
#pragma unroll
        for (int ai = 0; ai < 2; ++ai)
#pragma unroll
            for (int m = 0; m < 4; ++m) { bf16_t* rowp = O + (size_t)(row0 + ai * HALF + m * 16) * ldc + col0;
#pragma unroll
                for (int bj = 0; bj < 2; ++bj) { f32x4 v0 = acc[ai][bj][m][0], v1 = acc[ai][bj][m][1];
                    if (gate) {
#pragma unroll
                        for (int q = 0; q < 4; ++q) { v0[q] = sigmoidf_(v0[q]); v1[q] = sigmoidf_(v1[q]); } }
                    u32x4 w; w.x = pkbf(v0[0], v0[1]); w.y = pkbf(v0[2], v0[3]); w.z = pkbf(v1[0], v1[1]); w.w = pkbf(v1[2], v1[3]);
                    *(u32x4*)(rowp + bj * HALF) = w; } }
    }
};
struct EpiQRope {
    bf16_t* O; const float* tab;
    __device__ __forceinline__ void operator()(const Acc& acc, const Unit& u, int wr, int wc, int fr, int fq) const {
        const int row0 = u.pm * BM + wr * 64 + fr;
#pragma unroll
        for (int bj = 0; bj < 2; ++bj) {
            const int col = u.pn * BM + bj * HALF + wc * 32 + 8 * fq;
            const int dl = col % 96;
            const bool pe = dl >= 64; const int grp = (dl - 64) >> 4;
#pragma unroll
            for (int ai = 0; ai < 2; ++ai)
#pragma unroll
                for (int m = 0; m < 4; ++m) { const int row = row0 + ai * HALF + m * 16;
                    f32x4 v0 = acc[ai][bj][m][0], v1 = acc[ai][bj][m][1];
                    float x[8] = {v0[0], v0[1], v0[2], v0[3], v1[0], v1[1], v1[2], v1[3]}, y[8];
#pragma unroll
                    for (int q = 0; q < 8; ++q) y[q] = __shfl_xor(x[q], 16);
                    if (pe) { const int s = row & (SEQ - 1); const int pos = grp ? (s & 63) : (s >> 6);
                        const f32x4* tp = (const f32x4*)(tab + pos * 16);
                        const f32x4 t0 = tp[0], t1 = tp[1], t2 = tp[2], t3 = tp[3];
                        const float cs[8] = {t0[0], t0[2], t1[0], t1[2], t2[0], t2[2], t3[0], t3[2]}, sn[8] = {t0[1], t0[3], t1[1], t1[3], t2[1], t2[3], t3[1], t3[3]};
                        const float sg = (fq & 1) ? 1.f : -1.f;
#pragma unroll
                        for (int q = 0; q < 8; ++q) x[q] = x[q] * cs[q] + sg * y[q] * sn[q]; }
                    u32x4 w; w.x = pkbf(x[0], x[1]); w.y = pkbf(x[2], x[3]); w.z = pkbf(x[4], x[5]); w.w = pkbf(x[6], x[7]);
                    *(u32x4*)(O + (size_t)row * 768 + col) = w; __builtin_amdgcn_sched_barrier(0); } }
    }
};
struct EpiGate {
    const bf16_t* Gt; bf16_t* O; int add;
    __device__ __forceinline__ void operator()(const Acc& acc, const Unit& u, int wr, int wc, int fr, int fq) const {
        const int col0 = u.pn * BM + wc * 32 + 8 * fq, row0 = u.pm * BM + wr * 64 + fr;
#pragma unroll
        for (int ai = 0; ai < 2; ++ai)
#pragma unroll
            for (int m = 0; m < 4; ++m) { const size_t row = (size_t)(row0 + ai * HALF + m * 16);
#pragma unroll
                for (int bj = 0; bj < 2; ++bj) { const f32x4 v0 = acc[ai][bj][m][0], v1 = acc[ai][bj][m][1];
                    const u32x4 g = *(const u32x4*)(Gt + row * NGATE + col0 + bj * HALF);
                    u32x4 p = {0u, 0u, 0u, 0u}; if (add) p = *(const u32x4*)(O + row * DM + col0 + bj * HALF);
                    u32x4 w;
                    w.x = pkbf(bf_lo(p.x) + bf_lo(g.x) * v0[0], bf_hi(p.x) + bf_hi(g.x) * v0[1]);
                    w.y = pkbf(bf_lo(p.y) + bf_lo(g.y) * v0[2], bf_hi(p.y) + bf_hi(g.y) * v0[3]);
                    w.z = pkbf(bf_lo(p.z) + bf_lo(g.z) * v1[0], bf_hi(p.z) + bf_hi(g.z) * v1[1]);
                    w.w = pkbf(bf_lo(p.w) + bf_lo(g.w) * v1[2], bf_hi(p.w) + bf_hi(g.w) * v1[3]);
                    *(u32x4*)(O + row * DM + col0 + bj * HALF) = w; } }
    }
};
struct EpiResid {
    const float* Xin; float* Xout;
    __device__ __forceinline__ void operator()(const Acc& acc, const Unit& u, int wr, int wc, int fr, int fq) const {
        const int col0 = u.pn * BM + wc * 32 + 8 * fq, row0 = u.pm * BM + wr * 64 + fr;
#pragma unroll
        for (int ai = 0; ai < 2; ++ai)
#pragma unroll
            for (int m = 0; m < 4; ++m) { const size_t off = (size_t)(row0 + ai * HALF + m * 16) * DM + col0;
#pragma unroll
                for (int bj = 0; bj < 2; ++bj) { const f32x4 a0 = *(const f32x4*)(Xin + off + bj * HALF), a1 = *(const f32x4*)(Xin + off + bj * HALF + 4);
                    *(f32x4*)(Xout + off + bj * HALF) = a0 + acc[ai][bj][m][0]; *(f32x4*)(Xout + off + bj * HALF + 4) = a1 + acc[ai][bj][m][1]; } }
    }
};
struct EpiSwiGLU {
    bf16_t* O;
    __device__ __forceinline__ void operator()(const Acc& acc, const Unit& u, int wr, int wc, int fr, int fq) const {
        const int col0 = (u.pn & 7) * HALF + wc * 32 + 8 * fq, row0 = u.pm * BM + wr * 64 + fr;
#pragma unroll
        for (int ai = 0; ai < 2; ++ai)
#pragma unroll
            for (int m = 0; m < 4; ++m) { float r[8];
#pragma unroll
                for (int n = 0; n < 2; ++n)
#pragma unroll
                    for (int q = 0; q < 4; ++q) { const float a = acc[ai][0][m][n][q], b = acc[ai][1][m][n][q]; r[n * 4 + q] = a * sigmoidf_(a) * b; }
                u32x4 w; w.x = pkbf(r[0], r[1]); w.y = pkbf(r[2], r[3]); w.z = pkbf(r[4], r[5]); w.w = pkbf(r[6], r[7]);
                *(u32x4*)(O + (size_t)(row0 + ai * HALF + m * 16) * 1024 + col0) = w; }
    }
};
struct EpiMoeDown {
    bf16_t* O; const float* val;
    __device__ __forceinline__ void operator()(const Acc& acc, const Unit& u, int wr, int wc, int fr, int fq) const {
        const int col0 = (u.pn & 3) * BM + wc * 32 + 8 * fq, row0 = u.pm * BM + wr * 64 + fr;
#pragma unroll
        for (int ai = 0; ai < 2; ++ai)
#pragma unroll
            for (int m = 0; m < 4; ++m) { const int row = row0 + ai * HALF + m * 16; const float s = val[row]; bf16_t* rowp = O + (size_t)row * 1024 + col0;
#pragma unroll
                for (int bj = 0; bj < 2; ++bj) { const f32x4 v0 = acc[ai][bj][m][0] * s, v1 = acc[ai][bj][m][1] * s;
                    u32x4 w; w.x = pkbf(v0[0], v0[1]); w.y = pkbf(v0[2], v0[3]); w.z = pkbf(v1[0], v1[1]); w.w = pkbf(v1[2], v1[3]);
                    *(u32x4*)(rowp + bj * HALF) = w; } }
    }
};
struct EpiPle {
    float* X; const bf16_t* PE;
    __device__ __forceinline__ void operator()(const Acc& acc, const Unit& u, int wr, int wc, int fr, int fq) const {
        const int col0 = u.pn * BM + wc * 32 + 8 * fq, row0 = u.pm * BM + wr * 64 + fr;
#pragma unroll
        for (int ai = 0; ai < 2; ++ai)
#pragma unroll
            for (int m = 0; m < 4; ++m) { const size_t off = (size_t)(row0 + ai * HALF + m * 16) * DM + col0;
#pragma unroll
                for (int bj = 0; bj < 2; ++bj) { const f32x4 v0 = acc[ai][bj][m][0], v1 = acc[ai][bj][m][1];
                    const u32x4 p = *(const u32x4*)(PE + off + bj * HALF);
                    f32x4 a0 = *(const f32x4*)(X + off + bj * HALF), a1 = *(const f32x4*)(X + off + bj * HALF + 4);
                    a0[0] += sigmoidf_(v0[0]) * bf_lo(p.x); a0[1] += sigmoidf_(v0[1]) * bf_hi(p.x); a0[2] += sigmoidf_(v0[2]) * bf_lo(p.y); a0[3] += sigmoidf_(v0[3]) * bf_hi(p.y);
                    a1[0] += sigmoidf_(v1[0]) * bf_lo(p.z); a1[1] += sigmoidf_(v1[1]) * bf_hi(p.z); a1[2] += sigmoidf_(v1[2]) * bf_lo(p.w); a1[3] += sigmoidf_(v1[3]) * bf_hi(p.w);
                    *(f32x4*)(X + off + bj * HALF) = a0; *(f32x4*)(X + off + bj * HALF + 4) = a1; } }
    }
};

template <class Epi, class Sched>
__device__ __forceinline__ void gemm_phase(LAS unsigned char* lds, const Gemm g, const Sched& S, const Epi& E) {
    int tid = threadIdx.x; asm volatile("" : "+v"(tid));
    const int wid = __builtin_amdgcn_readfirstlane(tid >> 6), lane = tid & 63, wr = wid >> 2, wc = wid & 3, fr = lane & 15, fq = lane >> 4;
    const int K = g.K, nt = K / BK;
    unsigned voffA[2], voffB[2];
#pragma unroll
    for (int i = 0; i < 2; ++i) { int R, C; stage_rc(tid * 16 + i * 8192, R, C); const int Rb = (R & ~31) + perm32(R & 31);
        voffA[i] = (unsigned)(R * g.lda + C) * 2u; voffB[i] = (unsigned)(Rb * g.ldb + C) * 2u; }
    const size_t kstep = (size_t)(BK * 2);
    const size_t hstepA = (size_t)HALF * g.lda * 2, hstepB = (size_t)HALF * g.ldb * 2;
    const size_t tstepA = 2 * hstepA, tstepB = 2 * hstepB;
    const unsigned ldsw = (unsigned)wid * 1024u;
    const int aoff = lds_byte(wr * 64 + fr, fq * 8), boff = lds_byte(wc * 32 + fr, fq * 8);
#define PG8_SA(b, h) (((b) * 2 + (h)) * HTB)
#define PG8_SB(b, h) ((4 + (b) * 2 + (h)) * HTB)
#define PG8_STAGE(bufoff, gbase, voff) do { _Pragma("unroll") for (int _i = 0; _i < 2; ++_i) \
        __builtin_amdgcn_global_load_lds((const unsigned*)((const char*)(gbase) + (voff)[_i]), (LAS unsigned*)(lds + (bufoff) + ldsw + _i * 8192), 16, 0, 0); } while (0)
#define PG8_LDA(dst, b, h) do { _Pragma("unroll") for (int m = 0; m < 4; ++m) _Pragma("unroll") for (int k = 0; k < 2; ++k) dst[m][k] = *(const LAS bf16x8*)(lds + PG8_SA(b, h) + aoff + m * 2048 + k * 1024); } while (0)
#define PG8_LDB(dst, b, h) do { _Pragma("unroll") for (int n = 0; n < 2; ++n) _Pragma("unroll") for (int k = 0; k < 2; ++k) dst[n][k] = *(const LAS bf16x8*)(lds + PG8_SB(b, h) + boff + n * 2048 + k * 1024); } while (0)
#define PG8_MMA(ai, bj, At, Bt) do { __builtin_amdgcn_s_setprio(1); _Pragma("unroll") for (int m = 0; m < 4; ++m) _Pragma("unroll") for (int n = 0; n < 2; ++n) _Pragma("unroll") for (int k = 0; k < 2; ++k) \
        acc[ai][bj][m][n] = __builtin_amdgcn_mfma_f32_16x16x32_bf16(Bt[n][k], At[m][k], acc[ai][bj][m][n], 0, 0, 0); __builtin_amdgcn_s_setprio(0); } while (0)
#define PG8_WAIT_V(n) asm volatile("s_waitcnt vmcnt(" #n ")" ::: "memory")
#define PG8_WAIT_L(n) asm volatile("s_waitcnt lgkmcnt(" #n ")" ::: "memory")
#define PG8_BAR __builtin_amdgcn_s_barrier()
#define PG8_SCHED __builtin_amdgcn_sched_barrier(0)
    Unit cur, nxt; int ui = 0;
    if (!S.next(0, cur)) return;
    f32x4 acc[2][2][4][2];
#pragma unroll
    for (int a = 0; a < 2; ++a)
#pragma unroll
        for (int b = 0; b < 2; ++b)
#pragma unroll
            for (int m = 0; m < 4; ++m)
#pragma unroll
                for (int n = 0; n < 2; ++n) acc[a][b][m][n] = (f32x4){0.f, 0.f, 0.f, 0.f};
    bf16x8 At[4][2], B0[2][2], B1[2][2];
    const char* cA = (const char*)g.A + (size_t)cur.pm * tstepA; const char* cB = (const char*)g.Bt + (size_t)cur.pn * tstepB;
    PG8_STAGE(PG8_SB(0, 0), cB, voffB); PG8_STAGE(PG8_SB(0, 1), cB + hstepB, voffB); PG8_STAGE(PG8_SA(0, 0), cA, voffA); PG8_STAGE(PG8_SA(0, 1), cA + hstepA, voffA);
    if (wr == 1) PG8_BAR;
    PG8_WAIT_V(2); PG8_BAR;
    PG8_STAGE(PG8_SB(1, 0), cB + kstep, voffB); PG8_STAGE(PG8_SA(1, 0), cA + kstep, voffA); PG8_STAGE(PG8_SB(1, 1), cB + hstepB + kstep, voffB);
    PG8_WAIT_V(6); PG8_BAR;
    for (;;) {
        const bool has_next = S.next(ui + 1, nxt);
        const char* nA = has_next ? (const char*)g.A + (size_t)nxt.pm * tstepA : cA; const char* nB = has_next ? (const char*)g.Bt + (size_t)nxt.pn * tstepB : cB;
#pragma unroll 1
        for (int t = 0; t < nt; t += 2) {
            const bool last = (t == nt - 2);
            const char* a1 = cA + (size_t)(t + 1) * kstep;
            const char* a2 = last ? nA : cA + (size_t)(t + 2) * kstep; const char* b2 = last ? nB : cB + (size_t)(t + 2) * kstep;
            const char* a3 = a2 + kstep; const char* b3 = b2 + kstep;
            PG8_LDB(B0, 0, 0); PG8_LDB(B1, 0, 1); PG8_SCHED; PG8_LDA(At, 0, 0); PG8_STAGE(PG8_SA(1, 1), a1 + hstepA, voffA);
            PG8_WAIT_V(8); PG8_WAIT_L(0); PG8_BAR; PG8_MMA(0, 0, At, B0); PG8_MMA(0, 1, At, B1); PG8_BAR; PG8_SCHED;
            PG8_LDA(At, 0, 1); PG8_STAGE(PG8_SB(0, 0), b2, voffB); PG8_STAGE(PG8_SB(0, 1), b2 + hstepB, voffB); PG8_STAGE(PG8_SA(0, 0), a2, voffA);
            PG8_WAIT_V(8); PG8_WAIT_L(0); PG8_BAR; PG8_MMA(1, 0, At, B0); PG8_MMA(1, 1, At, B1); PG8_BAR; PG8_SCHED;
            PG8_LDB(B0, 1, 0); PG8_LDB(B1, 1, 1); PG8_SCHED; PG8_LDA(At, 1, 0); PG8_STAGE(PG8_SA(0, 1), a2 + hstepA, voffA);
            PG8_WAIT_V(8); PG8_WAIT_L(0); PG8_BAR; PG8_MMA(0, 0, At, B0); PG8_MMA(0, 1, At, B1); PG8_BAR; PG8_SCHED;
            PG8_LDA(At, 1, 1); PG8_STAGE(PG8_SB(1, 0), b3, voffB); PG8_STAGE(PG8_SB(1, 1), b3 + hstepB, voffB); PG8_STAGE(PG8_SA(1, 0), a3, voffA);
            PG8_WAIT_V(8); PG8_WAIT_L(0); PG8_BAR; PG8_MMA(1, 0, At, B0); PG8_MMA(1, 1, At, B1); PG8_BAR; PG8_SCHED;
        }
        if (wr == 0) PG8_BAR;
        E(acc, cur, wr, wc, fr, fq);
        if (!has_next) break;
#pragma unroll
        for (int a = 0; a < 2; ++a)
#pragma unroll
            for (int b = 0; b < 2; ++b)
#pragma unroll
                for (int m = 0; m < 4; ++m)
#pragma unroll
                    for (int n = 0; n < 2; ++n) acc[a][b][m][n] = (f32x4){0.f, 0.f, 0.f, 0.f};
        cur = nxt; cA = nA; cB = nB; ++ui;
        if (wr == 1) PG8_BAR;
    }
    PG8_WAIT_V(0);
    PG8_BAR;
#undef PG8_SA
#undef PG8_SB
#undef PG8_STAGE
#undef PG8_LDA
#undef PG8_LDB
#undef PG8_MMA
#undef PG8_WAIT_V
#undef PG8_WAIT_L
#undef PG8_BAR
#undef PG8_SCHED
}
}

namespace mla {
constexpr int NW = 8, QBLK = 32, KVBLK = 64;
constexpr float SCALE = 0.10206207261596575f;
constexpr float THR = 8.f;
constexpr int SHM_V = KVBLK * 64 * 2, SHM_K = KVBLK * 256;
constexpr int OFF_V = 0, OFF_K = 2 * SHM_V, OFF_WS = OFF_K + 2 * SHM_K, LDS_NEED = OFF_WS + NW * 64 * 4;
#define KSWZ(row, colB) ((row) * 256 + ((colB) ^ (((row) & 7) << 4)))
#define SBAR() __builtin_amdgcn_sched_barrier(0)
__device__ __forceinline__ int crow(int r, int hi) { return (r & 3) + 8 * (r >> 2) + 4 * hi; }

__device__ __forceinline__ void partialSM(f32x16& p0, f32x16& p1, float& m_reg, float& mn, float& alpha) {
  constexpr float C = SCALE * 1.4426950408889634f;
  float pmax = p0[0];
#pragma unroll
  for (int r = 1; r < 16; ++r) pmax = fmaxf(pmax, p0[r]);
#pragma unroll
  for (int r = 0; r < 16; ++r) pmax = fmaxf(pmax, p1[r]);
  { auto rr = __builtin_amdgcn_permlane32_swap(__float_as_uint(pmax), __float_as_uint(pmax), false, false);
    pmax = fmaxf(__uint_as_float(rr[0]), __uint_as_float(rr[1])); }
  if (__builtin_expect(__all(pmax - m_reg <= THR / SCALE), 1)) { mn = m_reg; alpha = 1.f; }
  else { mn = fmaxf(m_reg, pmax); alpha = __builtin_amdgcn_exp2f((m_reg - mn) * C); m_reg = mn; }
  const float mnC = -mn * C;
#pragma unroll
  for (int r = 0; r < 16; ++r) p0[r] = fmaf(p0[r], C, mnC);
#pragma unroll
  for (int r = 0; r < 16; ++r) p1[r] = fmaf(p1[r], C, mnC);
#pragma unroll
  for (int r = 0; r < 16; ++r) p0[r] = __builtin_amdgcn_exp2f(p0[r]);
}
__device__ __forceinline__ void finishSM(f32x16& p0, f32x16& p1, float alpha, float& l_reg, bf16x8& pa0, bf16x8& pa1, bf16x8& pa2, bf16x8& pa3) {
#pragma unroll
  for (int r = 0; r < 16; ++r) p1[r] = __builtin_amdgcn_exp2f(p1[r]);
  float ps = 0;
#pragma unroll
  for (int r = 0; r < 16; ++r) ps += p0[r];
#pragma unroll
  for (int r = 0; r < 16; ++r) ps += p1[r];
  { auto rr = __builtin_amdgcn_permlane32_swap(__float_as_uint(ps), __float_as_uint(ps), false, false);
    ps = __uint_as_float(rr[0]) + __uint_as_float(rr[1]); }
  l_reg = l_reg * alpha + ps;
#define PK4(P, BASE, OUT) do { unsigned a0 = pkbf(P[BASE + 0], P[BASE + 1]), a1 = pkbf(P[BASE + 2], P[BASE + 3]);   \
    unsigned b0 = pkbf(P[BASE + 4], P[BASE + 5]), b1 = pkbf(P[BASE + 6], P[BASE + 7]);                              \
    auto r0 = __builtin_amdgcn_permlane32_swap(a0, b0, false, false); auto r1 = __builtin_amdgcn_permlane32_swap(a1, b1, false, false); \
    u32x4 w = {r0[0], r1[0], r0[1], r1[1]}; OUT = __builtin_bit_cast(bf16x8, w); } while (0)
  PK4(p0, 0, pa0); PK4(p0, 8, pa1); PK4(p1, 0, pa2); PK4(p1, 8, pa3);
#undef PK4
}
__device__ __forceinline__ void qkt(f32x16& p0, f32x16& p1, const LAS unsigned char* Ks, const bf16x8* qr, int r32, int hi) {
  p0 = f32x16{}; p1 = f32x16{};
#pragma unroll
  for (int d0 = 0; d0 < 6; ++d0) { const int cb = (d0 * 16 + hi * 8) * 2;
    const bf16x8 b0 = *(const LAS bf16x8*)(Ks + KSWZ(r32, cb));
    const bf16x8 b1 = *(const LAS bf16x8*)(Ks + KSWZ(32 + r32, cb));
    p0 = __builtin_amdgcn_mfma_f32_32x32x16_bf16(b0, qr[d0], p0, 0, 0, 0);
    p1 = __builtin_amdgcn_mfma_f32_32x32x16_bf16(b1, qr[d0], p1, 0, 0, 0); }
}
__device__ __forceinline__ int v_st(int k, int c) { const int kk = (k & ~0xC) | ((k & 4) << 1) | ((k & 8) >> 1); return ((kk >> 3) * 2 + (c >> 5)) * 512 + ((kk & 7) * 32 + (c & 31)) * 2; }
__device__ __forceinline__ int v_rd_base(int lane) { return ((lane & 3) << 3) | (((lane >> 2) & 3) << 6) | (((lane >> 4) & 1) << 5) | (((lane >> 5) & 1) << 8); }
constexpr int v_rd_off(int d0, int ks, int half) { return d0 * 512 + ks * 2048 + half * 1024; }
template <int OFF> __device__ __forceinline__ s16x4 tr_read(int vb) {
  s16x4 r; asm volatile("ds_read_b64_tr_b16 %0, %1 offset:%2" : "=&v"(r) : "v"(vb), "i"(OFF) : "memory"); return r;
}
template <int D0> __device__ __forceinline__ void pv_one(f32x16& od, int vb, bf16x8 pa0, bf16x8 pa1, bf16x8 pa2, bf16x8 pa3) {
  const s16x4 l0 = tr_read<v_rd_off(D0, 0, 0)>(vb), h0 = tr_read<v_rd_off(D0, 0, 1)>(vb), l1 = tr_read<v_rd_off(D0, 1, 0)>(vb), h1 = tr_read<v_rd_off(D0, 1, 1)>(vb);
  const s16x4 l2 = tr_read<v_rd_off(D0, 2, 0)>(vb), h2 = tr_read<v_rd_off(D0, 2, 1)>(vb), l3 = tr_read<v_rd_off(D0, 3, 0)>(vb), h3 = tr_read<v_rd_off(D0, 3, 1)>(vb);
  asm volatile("s_waitcnt lgkmcnt(0)" ::: "memory"); SBAR();
#define PK(L, H) (bf16x8){L[0], L[1], L[2], L[3], H[0], H[1], H[2], H[3]}
  od = __builtin_amdgcn_mfma_f32_32x32x16_bf16(pa0, PK(l0, h0), od, 0, 0, 0);
  od = __builtin_amdgcn_mfma_f32_32x32x16_bf16(pa1, PK(l1, h1), od, 0, 0, 0);
  od = __builtin_amdgcn_mfma_f32_32x32x16_bf16(pa2, PK(l2, h2), od, 0, 0, 0);
  od = __builtin_amdgcn_mfma_f32_32x32x16_bf16(pa3, PK(l3, h3), od, 0, 0, 0);
#undef PK
}
__device__ __forceinline__ void pv_d0(f32x16* o, int vb, bf16x8 pa0, bf16x8 pa1, bf16x8 pa2, bf16x8 pa3) {
  pv_one<0>(o[0], vb, pa0, pa1, pa2, pa3); pv_one<1>(o[1], vb, pa0, pa1, pa2, pa3);
}
__device__ __forceinline__ void unit(int b, int h, int qb, const bf16_t* __restrict__ Qg, const bf16_t* __restrict__ KVg, const bf16_t* __restrict__ KPE, bf16_t* __restrict__ ATT, LAS unsigned char* lds) {
  int tid = threadIdx.x; asm volatile("" : "+v"(tid));
  const int wid = tid >> 6, lane = tid & 63, r32 = lane & 31, hi = lane >> 5;
  LAS unsigned char* V_lds = lds + OFF_V; LAS unsigned char* K_lds = lds + OFF_K;
  LAS float* ws = (LAS float*)(lds + OFF_WS) + wid * 64; LAS float* li_l = ws; LAS float* al_l = ws + 32;
  float m_reg = -1e30f, l_reg = 0; f32x16 o[2] = {}; bf16x8 qr[6];
  const size_t tok0 = (size_t)b * SEQ;
  const bf16_t* Qw = Qg + (tok0 + qb * 256 + wid * QBLK + r32) * 768 + h * 96 + hi * 8;
#pragma unroll
  for (int d0 = 0; d0 < 6; ++d0) qr[d0] = *(const bf16x8*)(Qw + d0 * 16);
  const int sk = tid >> 3, sc8 = tid & 7, skp = (tid & 255) >> 2, scp = tid & 3;
  const bf16_t* vsrc = KVg + (tok0 + sk) * 1024 + h * 128 + 64 + sc8 * 8;
  const bf16_t* ksrc = KVg + (tok0 + sk) * 1024 + h * 128 + sc8 * 8;
  const bf16_t* psrc = KPE + (tok0 + skp) * 32 + scp * 8;
  const int vst = v_st(sk, sc8 * 8), kst = KSWZ(sk, sc8 * 16), pst = KSWZ(skp, 128 + scp * 16);
  const int vb0 = (int)(unsigned)(uintptr_t)V_lds + v_rd_base(lane);
  struct { bf16x8 v, k, p; } sr_[2];
#define SLOAD(i, k0) do { sr_[i].v = *(const bf16x8*)(vsrc + (size_t)(k0) * 1024); sr_[i].k = *(const bf16x8*)(ksrc + (size_t)(k0) * 1024); sr_[i].p = *(const bf16x8*)(psrc + (size_t)(k0) * 32); } while (0)
#define SWRITE(bb, i) do { *(LAS bf16x8*)(V_lds + (bb) * SHM_V + vst) = sr_[i].v; *(LAS bf16x8*)(K_lds + (bb) * SHM_K + kst) = sr_[i].k; *(LAS bf16x8*)(K_lds + (bb) * SHM_K + pst) = sr_[i].p; } while (0)
#define SWAIT() asm volatile("s_waitcnt vmcnt(3)" ::: "memory")
#define RESC(a) do { if (__any((a) < 1.f)) { if (hi == 0) al_l[r32] = (a); asm volatile("s_waitcnt lgkmcnt(0)" ::: "memory"); \
    _Pragma("unroll") for (int d = 0; d < 2; ++d) _Pragma("unroll") for (int r = 0; r < 16; ++r) o[d][r] *= al_l[crow(r, hi)]; } } while (0)
  f32x16 pA0, pA1, pB0, pB1; float mnA, mnB, alA, alB; bf16x8 pa0, pa1, pa2, pa3; constexpr int NT = SEQ / KVBLK;
  constexpr int SE = 0, SO = 1;
  SLOAD(SE, 0); asm volatile("s_waitcnt vmcnt(0)" ::: "memory"); SWRITE(0, SE); __syncthreads();
  qkt(pA0, pA1, K_lds, qr, r32, hi); partialSM(pA0, pA1, m_reg, mnA, alA);
  SLOAD(SO, KVBLK); SLOAD(SE, 2 * KVBLK);
  SWAIT(); SWRITE(1, SO); __syncthreads();
  for (int j = 1; j + 1 < NT; j += 2) {
    SBAR(); qkt(pB0, pB1, K_lds + SHM_K, qr, r32, hi);
    finishSM(pA0, pA1, alA, l_reg, pa0, pa1, pa2, pa3); SBAR();
    SLOAD(SO, (j + 2) * KVBLK); SBAR();
    pv_d0(o, vb0, pa0, pa1, pa2, pa3); partialSM(pB0, pB1, m_reg, mnB, alB);
    __syncthreads(); SWAIT(); SWRITE(0, SE);
    RESC(alB); __syncthreads();
    SBAR(); qkt(pA0, pA1, K_lds, qr, r32, hi);
    finishSM(pB0, pB1, alB, l_reg, pa0, pa1, pa2, pa3); SBAR();
    if (j + 3 < NT) SLOAD(SE, (j + 3) * KVBLK); SBAR();
    pv_d0(o, vb0 + SHM_V, pa0, pa1, pa2, pa3); partialSM(pA0, pA1, m_reg, mnA, alA);
    __syncthreads(); SWAIT(); SWRITE(1, SO);
    RESC(alA); __syncthreads();
  }
  SBAR(); qkt(pB0, pB1, K_lds + SHM_K, qr, r32, hi);
  finishSM(pA0, pA1, alA, l_reg, pa0, pa1, pa2, pa3); SBAR();
  pv_d0(o, vb0, pa0, pa1, pa2, pa3); partialSM(pB0, pB1, m_reg, mnB, alB);
  __syncthreads(); RESC(alB);
  finishSM(pB0, pB1, alB, l_reg, pa0, pa1, pa2, pa3); SBAR();
  pv_d0(o, vb0 + SHM_V, pa0, pa1, pa2, pa3);
  if (hi == 0) li_l[r32] = l_reg; asm volatile("s_waitcnt lgkmcnt(0)" ::: "memory");
  float rli[16];
#pragma unroll
  for (int r = 0; r < 16; ++r) rli[r] = __builtin_amdgcn_rcpf(li_l[crow(r, hi)]);
  bf16_t* Ow = ATT + (tok0 + qb * 256 + wid * QBLK) * 1024 + 512 + h * 64;
#pragma unroll
  for (int r = 0; r < 16; ++r) { const int orow = crow(r, hi);
#pragma unroll
    for (int d0 = 0; d0 < 2; ++d0) Ow[(size_t)orow * 1024 + d0 * 32 + r32] = (bf16_t)(pkbf(o[d0][r] * rli[r], 0.f) & 0xffffu); }
  asm volatile("s_waitcnt lgkmcnt(0)" ::: "memory");
  __syncthreads();
#undef SLOAD
#undef SWRITE
#undef SWAIT
#undef RESC
}
#undef KSWZ
#undef SBAR
}

namespace na {
constexpr int OFF_K = 0, OFF_V = 65536;
__device__ __forceinline__ void stage_load(int b, int h, int kr, const bf16_t* __restrict__ PA, const bf16_t* __restrict__ VT, int tid, u32x4& kreg, u32x4& vreg) {
  const int t = tid >> 3, ch = tid & 7;
  kreg = *(const u32x4*)(PA + ((size_t)b * SEQ + kr * 64 + t) * NPA + 512 + h * 64 + ch * 8);
  vreg = *(const u32x4*)(VT + (size_t)(h * 64 + t) * M + (size_t)b * SEQ + kr * 64 + ch * 8);
}
__device__ __forceinline__ void stage_write(LAS unsigned char* lds, int kr, int tid, u32x4 kreg, u32x4 vreg) {
  const int t = tid >> 3, ch = tid & 7, slot = kr & 7;
  *(LAS u32x4*)(lds + OFF_K + slot * 8192 + t * 128 + ((ch ^ (t & 7)) << 4)) = kreg;
  LAS unsigned char* vb = lds + OFF_V + slot * 8192 + t * 128;
  *(LAS u32x2*)(vb + (((2 * ch) ^ (t & 15)) << 3)) = (u32x2){vreg.x, vreg.y};
  *(LAS u32x2*)(vb + (((2 * ch + 1) ^ (t & 15)) << 3)) = (u32x2){vreg.z, vreg.w};
}
__device__ __forceinline__ void unit(int b, int h, int seg, const bf16_t* __restrict__ PA, const bf16_t* __restrict__ VT, bf16_t* __restrict__ ATT, const float* __restrict__ rpb_g, LAS unsigned char* lds, LAS float* rb) {
  int tid = threadIdx.x; asm volatile("" : "+v"(tid));
  const int wid = tid >> 6, lane = tid & 63, l15 = lane & 15, g = lane >> 4;
  const int w4 = wid & 3, dh = wid >> 2;
  const int bs = (w4 == 0) ? 0 : (w4 == 1) ? 8 : (w4 == 2) ? 24 : 32;
  const int c = 16 * w4 + l15, cs = min(max(c - 8, 0), 48);
  const int rs = seg * 16;
  for (int i = tid; i < 465; i += 512) rb[i] = rpb_g[h * 465 + i];
  { const int r0 = min(max(rs - 4, 0), 56);
#pragma unroll 2
    for (int j = 0; j < 8; ++j) { u32x4 kreg, vreg; stage_load(b, h, r0 + j, PA, VT, tid, kreg, vreg); stage_write(lds, r0 + j, tid, kreg, vreg); } }
  bf16x8 qf[2];
  { const size_t tokq = (size_t)b * SEQ + rs * 64 + c;
#pragma unroll
    for (int ks = 0; ks < 2; ++ks) qf[ks] = *(const bf16x8*)(PA + tokq * NPA + h * 64 + ks * 32 + g * 8); }
  __syncthreads();
  for (int r = rs; r < rs + 16; ++r) {
    const int r0 = min(max(r - 4, 0), 56);
    const int r0n = min(max(r + 1 - 4, 0), 56);
    const bool more = (r + 1 < rs + 16), newrow = more && (r0n != r0);
    u32x4 kreg = {0u, 0u, 0u, 0u}, vreg = {0u, 0u, 0u, 0u}; bf16x8 qn[2] = {qf[0], qf[1]};
    if (newrow) stage_load(b, h, r0n + 7, PA, VT, tid, kreg, vreg);
    if (more) { const size_t tokn = (size_t)b * SEQ + (r + 1) * 64 + c;
#pragma unroll
      for (int ks = 0; ks < 2; ++ks) qn[ks] = *(const bf16x8*)(PA + tokn * NPA + h * 64 + ks * 32 + g * 8); }
    f32x4 s[16];
#pragma unroll
    for (int j = 0; j < 8; ++j) { const int slot = (r0 + j) & 7;
#pragma unroll
      for (int hf = 0; hf < 2; ++hf) { const int tk = bs + 16 * hf + l15; const LAS unsigned char* kb = lds + OFF_K + slot * 8192 + tk * 128;
        const bf16x8 k0 = *(const LAS bf16x8*)(kb + ((g ^ (tk & 7)) << 4)), k1 = *(const LAS bf16x8*)(kb + (((4 + g) ^ (tk & 7)) << 4));
        f32x4 a = {0.f, 0.f, 0.f, 0.f};
        a = __builtin_amdgcn_mfma_f32_16x16x32_bf16(k0, qf[0], a, 0, 0, 0);
        a = __builtin_amdgcn_mfma_f32_16x16x32_bf16(k1, qf[1], a, 0, 0, 0);
        s[j * 2 + hf] = a; } }
    float mx = -1e30f;
#pragma unroll
    for (int j = 0; j < 8; ++j)
#pragma unroll
      for (int hf = 0; hf < 2; ++hf)
#pragma unroll
        for (int i = 0; i < 4; ++i) {
          const int cp = bs + 16 * hf + 4 * g + i; const bool ok = (cp >= cs) && (cp < cs + 16);
          const int bi = (r0 + j - r + 7) * 31 + (ok ? (cp - c + 15) : 15);
          const float v = ok ? s[j * 2 + hf][i] * 0.125f + rb[bi] : -1e30f;
          s[j * 2 + hf][i] = v; mx = fmaxf(mx, v); }
    mx = fmaxf(mx, __shfl_xor(mx, 16)); mx = fmaxf(mx, __shfl_xor(mx, 32));
    float sum = 0.f;
#pragma unroll
    for (int q = 0; q < 16; ++q)
#pragma unroll
      for (int i = 0; i < 4; ++i) { const float p = __expf(s[q][i] - mx); s[q][i] = p; sum += p; }
    sum += __shfl_xor(sum, 16); sum += __shfl_xor(sum, 32);
    const float rl = __builtin_amdgcn_rcpf(sum);
    f32x4 o[2] = {{0.f, 0.f, 0.f, 0.f}, {0.f, 0.f, 0.f, 0.f}};
#pragma unroll
    for (int j = 0; j < 8; ++j) { const int slot = (r0 + j) & 7;
      u32x4 pw; pw.x = pkbf(s[2 * j][0], s[2 * j][1]); pw.y = pkbf(s[2 * j][2], s[2 * j][3]); pw.z = pkbf(s[2 * j + 1][0], s[2 * j + 1][1]); pw.w = pkbf(s[2 * j + 1][2], s[2 * j + 1][3]);
      const bf16x8 pb = __builtin_bit_cast(bf16x8, pw);
      const int c8 = (bs >> 2) + g;
#pragma unroll
      for (int dbi = 0; dbi < 2; ++dbi) { const int d = (2 * dh + dbi) * 16 + l15; const LAS unsigned char* vb = lds + OFF_V + slot * 8192 + d * 128;
        const u32x2 lo = *(const LAS u32x2*)(vb + ((c8 ^ l15) << 3)), hi2 = *(const LAS u32x2*)(vb + (((c8 + 4) ^ l15) << 3));
        const u32x4 vw = {lo.x, lo.y, hi2.x, hi2.y};
        o[dbi] = __builtin_amdgcn_mfma_f32_16x16x32_bf16(__builtin_bit_cast(bf16x8, vw), pb, o[dbi], 0, 0, 0); } }
    bf16_t* op = ATT + ((size_t)b * SEQ + r * 64 + c) * 1024 + h * 64 + 32 * dh + 4 * g;
#pragma unroll
    for (int dbi = 0; dbi < 2; ++dbi) { u32x2 w; w.x = pkbf(o[dbi][0] * rl, o[dbi][1] * rl); w.y = pkbf(o[dbi][2] * rl, o[dbi][3] * rl); *(u32x2*)(op + dbi * 16) = w; }
    __syncthreads();
    if (newrow) stage_write(lds, r0n + 7, tid, kreg, vreg);
    qf[0] = qn[0]; qf[1] = qn[1];
    __syncthreads();
  }
}
}

#define XB_TMO      128
#define XB_XCNT(j)  (256  + 64 * (j))
#define XB_XSUB(j)  (1280 + 64 * (j))
#define XB_XGEN(j)  (2304 + 64 * (j))
#define XB_TOP      3328
#define XB_TOPGEN   3392
#define XCD_BAR_WORDS 3456
#define XB_SPIN_CAP (1u << 22)
__device__ __forceinline__ unsigned xb_ld(unsigned* p)              { return __hip_atomic_load(p, __ATOMIC_RELAXED, __HIP_MEMORY_SCOPE_AGENT); }
__device__ __forceinline__ unsigned xb_add(unsigned* p, unsigned v) { return __hip_atomic_fetch_add(p, v, __ATOMIC_RELAXED, __HIP_MEMORY_SCOPE_AGENT); }
__device__ __forceinline__ unsigned xb_xcc_id() { return (unsigned)__builtin_amdgcn_s_getreg((3 << 11) | 20) & 0xFu; }
#define XB_SPIN(cond, bar) do { unsigned _sp = 0; while (cond) { __builtin_amdgcn_s_sleep(1); \
    if ((++_sp & 255u) == 0u) { if (xb_ld(&(bar)[XB_TMO])) break; if (_sp > XB_SPIN_CAP) { atomicAdd(&(bar)[XB_TMO], 1u); break; } } } } while (0)
struct XcdBarrier { unsigned* bar; unsigned x; volatile LAS unsigned* st; };
__device__ __forceinline__ XcdBarrier xcd_barrier_post(unsigned* bar, volatile LAS unsigned* st) {
    XcdBarrier b; b.bar = bar; b.x = xb_xcc_id(); b.st = st;
    if (threadIdx.x == 0) (void)xb_add(&bar[XB_XCNT(b.x)], 1u);
    return b;
}
__device__ __forceinline__ void xcd_barrier_complete(unsigned* bar, unsigned x, unsigned& nloc, unsigned& nx) {
    const unsigned G = gridDim.x * gridDim.y * gridDim.z;
    unsigned sum, cnt, mine, sp = 0u;
    for (;;) {
        sum = 0u; cnt = 0u; mine = 0u;
#pragma unroll
        for (unsigned j = 0; j < 16; ++j) { const unsigned c = xb_ld(&bar[XB_XCNT(j)]); sum += c; cnt += (c > 0u) ? 1u : 0u; mine = (j == x) ? c : mine; }
        if (sum == G) break;
        __builtin_amdgcn_s_sleep(1);
        if ((++sp & 255u) == 0u) { if (xb_ld(&bar[XB_TMO])) break; if (sp > XB_SPIN_CAP) { atomicAdd(&bar[XB_TMO], 1u); break; } }
    }
    nloc = mine > 0u ? mine : 1u; nx = cnt > 0u ? cnt : 1u;
}
__device__ __forceinline__ void xcd_barrier(const XcdBarrier& b) {
    asm volatile("s_waitcnt vmcnt(0)" ::: "memory");
    __syncthreads();
    if (threadIdx.x == 0) {
        unsigned* bar = b.bar;
        __builtin_amdgcn_s_waitcnt(0);
        unsigned nloc = b.st[0], nx = b.st[1];
        if (nloc == 0u) { xcd_barrier_complete(bar, b.x, nloc, nx); b.st[0] = nloc; b.st[1] = nx; }
        const unsigned old = xb_add(&bar[XB_XSUB(b.x)], 1u);
        const unsigned gen = old / nloc;
        if (old + 1u == (gen + 1u) * nloc) {
            __builtin_amdgcn_fence(__ATOMIC_RELEASE, "agent");
            asm volatile("s_waitcnt vmcnt(0)" ::: "memory");
            const unsigned og = xb_add(&bar[XB_TOP], 1u);
            const unsigned tg = og / nx;
            if (og + 1u == (tg + 1u) * nx) xb_add(&bar[XB_TOPGEN], 1u);
            else XB_SPIN(xb_ld(&bar[XB_TOPGEN]) == tg, bar);
            __builtin_amdgcn_fence(__ATOMIC_ACQUIRE, "agent");
            xb_add(&bar[XB_XGEN(b.x)], 1u);
            asm volatile("s_waitcnt vmcnt(0)" ::: "memory");
        } else {
            XB_SPIN(xb_ld(&bar[XB_XGEN(b.x)]) == gen, bar);
            __builtin_amdgcn_fence(__ATOMIC_ACQUIRE, "agent");
            asm volatile("s_waitcnt vmcnt(0)" ::: "memory");
        }
    }
    __syncthreads();
}

__device__ __forceinline__ void tr_item(const float* __restrict__ W, int ldw, int k0, int n0, bf16_t* __restrict__ WT, int ldt, int drow0, LAS float* scr, int lane) {
    float tv[32];
#pragma unroll
    for (int i = 0; i < 32; ++i) tv[i] = W[(size_t)(k0 + 2 * i + (lane >> 5)) * ldw + n0 + (lane & 31)];
#pragma unroll
    for (int i = 0; i < 32; ++i) scr[(2 * i + (lane >> 5)) * 33 + (lane & 31)] = tv[i];
    LDS_WAIT(); asm volatile("" ::: "memory");
    const int c = lane & 7;
#pragma unroll
    for (int j = 0; j < 4; ++j) { const int n = (lane >> 3) + 8 * j; const LAS float* s = scr + (8 * c) * 33 + n;
        u32x4 o; o.x = pkbf(s[0 * 33], s[1 * 33]); o.y = pkbf(s[2 * 33], s[3 * 33]); o.z = pkbf(s[4 * 33], s[5 * 33]); o.w = pkbf(s[6 * 33], s[7 * 33]);
        *(u32x4*)(WT + (size_t)(drow0 + n) * ldt + k0 + 8 * c) = o; }
    LDS_WAIT(); asm volatile("" ::: "memory");
}
template <bool OUTF>
__device__ __forceinline__ void rms_row(const float* xrow, const float* gain, bf16_t* orow, float* orowf, int lane) {
    const f32x4* xr = (const f32x4*)xrow + lane; const f32x4* gr = (const f32x4*)gain + lane;
    f32x4 v[4]; float s = 0.f;
#pragma unroll
    for (int j = 0; j < 4; ++j) { v[j] = xr[64 * j]; s += (v[j][0] * v[j][0] + v[j][1] * v[j][1]) + (v[j][2] * v[j][2] + v[j][3] * v[j][3]); }
    const float rstd = 1.f / sqrtf(wave_sum(s) * (1.f / DM) + RMS_EPS);
#pragma unroll
    for (int j = 0; j < 4; ++j) { const f32x4 gq = gr[64 * j]; const f32x4 y = v[j] * rstd * gq;
        if (OUTF) ((f32x4*)orowf + lane)[64 * j] = y;
        else { u32x2 w; w.x = pkbf(y[0], y[1]); w.y = pkbf(y[2], y[3]); ((u32x2*)orow + lane)[64 * j] = w; } }
}

__device__ __forceinline__ void topk_item(int b, int e, const float* __restrict__ AFF, int* __restrict__ IDXR, float* __restrict__ VALR, int* __restrict__ SLOT, LAS unsigned* sh, int tid, int lane, int wave) {
    unsigned u[8];
    const float* src = AFF + ((size_t)(b * SEQ + tid * 8)) * 16 + e;
#pragma unroll
    for (int i = 0; i < 8; ++i) u[i] = __float_as_uint(src[i * 16]);
    LAS unsigned* hist = sh; LAS unsigned* misc = sh + 256;
    unsigned prefix = 0u, mask = 0u, kth = CAP;
    for (int pass = 0; pass < 4; ++pass) {
        const int shift = 24 - 8 * pass;
        if (tid < 256) hist[tid] = 0u;
        __syncthreads();
#pragma unroll
        for (int i = 0; i < 8; ++i) if ((u[i] & mask) == prefix) (void)__hip_atomic_fetch_add(&hist[(u[i] >> shift) & 255u], 1u, __ATOMIC_RELAXED, __HIP_MEMORY_SCOPE_WORKGROUP);
        __syncthreads();
        if (wave == 0) {
            const unsigned h0 = hist[4 * lane], h1 = hist[4 * lane + 1], h2 = hist[4 * lane + 2], h3 = hist[4 * lane + 3];
            const unsigned sl = h0 + h1 + h2 + h3;
            unsigned inc = sl;
#pragma unroll
            for (int o = 1; o < 64; o <<= 1) { const unsigned t = __shfl_down(inc, o); if (lane + o < 64) inc += t; }
            const unsigned exc = inc - sl;
            if (exc < kth && kth <= inc) {
                unsigned cc = exc; int dsel;
                if (cc + h3 >= kth) dsel = 3; else { cc += h3; if (cc + h2 >= kth) dsel = 2; else { cc += h2; if (cc + h1 >= kth) dsel = 1; else { cc += h1; dsel = 0; } } }
                misc[0] = (unsigned)(4 * lane + dsel); misc[1] = kth - cc;
            }
        }
        __syncthreads();
        prefix |= misc[0] << shift; mask |= 255u << shift; kth = misc[1];
    }
    const unsigned T = prefix, need = kth;
    unsigned ng = 0u, neq = 0u;
#pragma unroll
    for (int i = 0; i < 8; ++i) { ng += (u[i] > T) ? 1u : 0u; neq += (u[i] == T) ? 1u : 0u; }
    const unsigned packed = ng | (neq << 16);
    unsigned inc = packed;
#pragma unroll
    for (int o = 1; o < 64; o <<= 1) { const unsigned t = __shfl_up(inc, o); if (lane >= o) inc += t; }
    __syncthreads();
    if (lane == 63) misc[2 + wave] = inc;
    __syncthreads();
    unsigned woff = 0u;
#pragma unroll
    for (int w = 0; w < 8; ++w) if (w < wave) woff += misc[2 + w];
    const unsigned exc = woff + inc - packed;
    unsigned gpos = exc & 0xffffu, epos = exc >> 16;
    const unsigned total_gt = CAP - need;
#pragma unroll
    for (int i = 0; i < 8; ++i) { const int t = tid * 8 + i; int slot = -1;
        if (u[i] > T) slot = (int)(gpos++);
        else if (u[i] == T) { if (epos < need) slot = (int)(total_gt + epos); epos++; }
        SLOT[(size_t)(b * SEQ + t) * 16 + e] = slot;
        if (slot >= 0) { const int rr = (e * NB + b) * CAP + slot; IDXR[rr] = b * SEQ + t; VALR[rr] = __uint_as_float(u[i]); } }
    __syncthreads();
}

struct Args { const float* in[24]; int ph_lo, ph_hi; };
constexpr int NPH = 14, NPHASES = 1 + NLAYER * NPH;

__global__ void __launch_bounds__(512, 2) fwd(Args a) {
    extern __shared__ __attribute__((aligned(16))) unsigned char lds_raw[];
    LAS unsigned char* lds = (LAS unsigned char*)lds_raw;
    const int G = gridDim.x, bx = blockIdx.x;
    const int vcu = (G % 8 == 0) ? (bx % 8) * (G / 8) + bx / 8 : bx;
    const int NGW = G * 8;
    unsigned char* ws = (unsigned char*)a.in[22];
    volatile LAS unsigned* MISC = (volatile LAS unsigned*)(lds + LDSCTL_OFF);
    for (int u = threadIdx.x; u < (LDS_BYTES - LDSCTL_OFF) / 4; u += 512) ((LAS unsigned*)(lds + LDSCTL_OFF))[u] = 0u;
    __syncthreads();
    const int lo = a.ph_lo, hi = a.ph_hi;
    XcdBarrier bar; bar.bar = (unsigned*)(ws + WS_CTL) + CW_BAR; bar.x = 0; bar.st = nullptr;
    if (hi - lo > 1) bar = xcd_barrier_post((unsigned*)(ws + WS_CTL) + CW_BAR, MISC + 8);
#define IN(k) (lo <= (k) && (k) < hi)
#define SEAM(k) do { if (IN(k) && IN((k) + 1)) xcd_barrier(bar); } while (0)

#define ARGP(k) ({ int kk_ = (k); asm volatile("" : "+s"(kk_)); (const float*)(GAS const float*)a.in[kk_]; })
#define WSP(T, off) ((T*)(wsq + (off)))
#define REP(k) for (int rep_ = 0, nrep_ = ({ int n_ = (PROBE_PH == (k)) ? 2 : 1; asm volatile("" : "+s"(n_)); n_; }); rep_ < nrep_; ++rep_)
#define PHASE_PTRS() int tid = threadIdx.x; asm volatile("" : "+v"(tid)); const int lane = tid & 63, wave = __builtin_amdgcn_readfirstlane(tid >> 6); const int gw = vcu * 8 + wave; (void)lane; (void)gw; \
    unsigned char* wsq = (unsigned char*)ARGP(22); float* X = (float*)ARGP(21); \
    bf16_t* H = WSP(bf16_t, WS_H); float* TAB = WSP(float, WS_TAB); float* AFF = WSP(float, WS_AFF); int* SLOT = WSP(int, WS_SLOT); int* IDXR = WSP(int, WS_IDXR); float* VALR = WSP(float, WS_VALR); \
    bf16_t* KPE = WSP(bf16_t, WS_KPE); bf16_t* PROJA = WSP(bf16_t, R_PROJA); bf16_t* GATES = WSP(bf16_t, R_GATES); bf16_t* VT = WSP(bf16_t, R_VT); bf16_t* Qb = WSP(bf16_t, R_Q); bf16_t* KVb = WSP(bf16_t, R_KV); \
    bf16_t* ATT = WSP(bf16_t, R_ATT); bf16_t* MERGED = WSP(bf16_t, R_MERGED); bf16_t* XG = WSP(bf16_t, R_XG); bf16_t* MOEOUT = WSP(bf16_t, R_MOEOUT); bf16_t* ACT = WSP(bf16_t, R_ACT); \
    bf16_t* W13 = WSP(bf16_t, R_W13); bf16_t* W2T = WSP(bf16_t, R_W2T); bf16_t* PBF = WSP(bf16_t, R_PBF); bf16_t* PE = WSP(bf16_t, R_PE); \
    const bf16_t* wl = (const bf16_t*)(wsq + WS_WSM + (size_t)l * WSM_STRIDE); \
    (void)H; (void)TAB; (void)AFF; (void)SLOT; (void)IDXR; (void)VALR; (void)KPE; (void)PROJA; (void)GATES; (void)VT; (void)Qb; (void)KVb; (void)ATT; (void)MERGED; (void)XG; (void)MOEOUT; (void)ACT; (void)W13; (void)W2T; (void)PBF; (void)PE; (void)wl; (void)X

    if (IN(0)) {
        const int l = 0; PHASE_PTRS(); const float* x_in = ARGP(0);
        LAS float* scr = (LAS float*)(lds + wave * 16384);
        for (int it = gw; it < 2 * 4064; it += NGW) {
            const int l = it / 4064; int r = it % 4064;
            bf16_t* wl = (bf16_t*)(wsq + WS_WSM + (size_t)l * WSM_STRIDE);
            if (r < 2128) { const int kb = r / 133, nb = r % 133, n0 = nb * 32; bf16_t* dst; int dr;
                if (n0 < 1024) { dst = wl + OFF_WIN; dr = n0; } else if (n0 < 1536) { dst = wl + OFF_WV; dr = n0 - 1024; } else if (n0 < 2208) { dst = wl + OFF_WIN; dr = n0 - 512; } else { dst = wl + OFF_WIN; dr = n0 - 416; }
                tr_item(ARGP(3) + (size_t)l * 1024 * IN_COLS, IN_COLS, kb * 64, n0, dst, 1024, dr, scr, lane); continue; } r -= 2128;
            if (r < 144) { tr_item(ARGP(6) + (size_t)l * 384 * 768, 768, (r / 24) * 64, (r % 24) * 32, wl + OFF_WQ, 384, (r % 24) * 32, scr, lane); continue; } r -= 144;
            if (r < 128) { tr_item(ARGP(8) + (size_t)l * 256 * 1024, 1024, (r / 32) * 64, (r % 32) * 32, wl + OFF_WKV, 256, (r % 32) * 32, scr, lane); continue; } r -= 128;
            if (r < 256) { tr_item(ARGP(9) + (size_t)l * 512 * 1024, 1024, (r / 32) * 64, (r % 32) * 32, wl + OFF_WNAO, 512, (r % 32) * 32, scr, lane); continue; } r -= 256;
            if (r < 256) { tr_item(ARGP(10) + (size_t)l * 512 * 1024, 1024, (r / 32) * 64, (r % 32) * 32, wl + OFF_WMLAO, 512, (r % 32) * 32, scr, lane); continue; } r -= 256;
            if (r < 512) { tr_item(ARGP(11) + (size_t)l * 1024 * 1024, 1024, (r / 32) * 64, (r % 32) * 32, wl + OFF_WOUT, 1024, (r % 32) * 32, scr, lane); continue; } r -= 512;
            if (r < 512) { tr_item(ARGP(18) + (size_t)l * 1024 * 1024, 1024, (r / 32) * 64, (r % 32) * 32, wl + OFF_WPG, 1024, (r % 32) * 32, scr, lane); continue; } r -= 512;
            tr_item(ARGP(19) + (size_t)l * 256 * 1024, 1024, (r / 32) * 64, (r % 32) * 32, wl + OFF_WPW, 256, (r % 32) * 32, scr, lane);
        }
        for (int i = bx * 512 + tid; i < 2 * 96 * 128; i += G * 512) { const int l = i / (96 * 128), r = i % (96 * 128);
            bf16_t* wl = (bf16_t*)(wsq + WS_WSM + (size_t)l * WSM_STRIDE) + OFF_WIN + (size_t)1696 * 1024; *(u32x4*)(wl + (size_t)r * 8) = (u32x4){0u, 0u, 0u, 0u}; }
        if (bx == 0) { const int pos = tid >> 3, j = tid & 7; const float f = exp2f(-(float)j * 1.6609640474436813f); const float rev = (float)pos * f * 0.15915494309189535f; const float fr = rev - floorf(rev);
            TAB[tid * 2] = __builtin_amdgcn_cosf(fr); TAB[tid * 2 + 1] = __builtin_amdgcn_sinf(fr); }
        for (int m = gw; m < M; m += NGW) rms_row<false>(x_in + (size_t)m * DM, ARGP(2), H + (size_t)m * DM, nullptr, lane);
    }
    SEAM(0);

    for (int l = 0; l < NLAYER; ++l) {
        const int pb = 1 + l * NPH;
        if (IN(pb + 0)) { PHASE_PTRS();
            REP(0)
            { pg8::Gemm g{H, wl + OFF_WIN, 1024, 1024, 1024}; pg8::StaticOrder S; S.init(M, NINP, G, bx); pg8::EpiInProj E{PROJA, GATES};
              pg8::gemm_phase(lds, g, S, E); }
            { pg8::Gemm g{wl + OFF_WV, H, 1024, 1024, 1024}; pg8::StaticOrder S; S.init(512, M, G, bx); pg8::EpiPlain E{VT, M, 1 << 20};
              pg8::gemm_phase(lds, g, S, E); }
        }
        SEAM(pb + 0);
        if (IN(pb + 1)) { PHASE_PTRS();
            const float* qn = ARGP(5) + l * 384; const float* kn = ARGP(7) + l * 256;
            for (int t = gw; t < M; t += NGW) {
                bf16_t* pr = PROJA + (size_t)t * NPA;
                unsigned q[3], kv[2]; float sq = 0.f, sk = 0.f;
#pragma unroll
                for (int j = 0; j < 3; ++j) { q[j] = *(const unsigned*)(pr + PROJ_QLAT + 2 * lane + 128 * j); const float a0 = bf_lo(q[j]), a1 = bf_hi(q[j]); sq += a0 * a0 + a1 * a1; }
#pragma unroll
                for (int j = 0; j < 2; ++j) { kv[j] = *(const unsigned*)(pr + PROJ_KVLAT + 2 * lane + 128 * j); const float a0 = bf_lo(kv[j]), a1 = bf_hi(kv[j]); sk += a0 * a0 + a1 * a1; }
                const float xr = bf1(pr[PROJ_KROPE + (lane & 31)]);
                const float rq = 1.f / sqrtf(wave_sum(sq) * (1.f / 384.f) + RMS_EPS), rk = 1.f / sqrtf(wave_sum(sk) * (1.f / 256.f) + RMS_EPS);
#pragma unroll
                for (int j = 0; j < 3; ++j) { const f32x2 gq = *(const f32x2*)(qn + 2 * lane + 128 * j); *(unsigned*)(pr + PROJ_QLAT + 2 * lane + 128 * j) = pkbf(bf_lo(q[j]) * rq * gq[0], bf_hi(q[j]) * rq * gq[1]); }
#pragma unroll
                for (int j = 0; j < 2; ++j) { const f32x2 gk = *(const f32x2*)(kn + 2 * lane + 128 * j); *(unsigned*)(pr + PROJ_KVLAT + 2 * lane + 128 * j) = pkbf(bf_lo(kv[j]) * rk * gk[0], bf_hi(kv[j]) * rk * gk[1]); }
                const float xp = __shfl_xor(xr, 8);
                const int s = t & (SEQ - 1), pos = (lane & 16) ? (s & 63) : (s >> 6), jf = lane & 7;
                const float cs = TAB[(pos * 8 + jf) * 2], sn = TAB[(pos * 8 + jf) * 2 + 1];
                const float outv = (lane & 8) ? (xr * cs + xp * sn) : (xr * cs - xp * sn);
                if (lane < 32) KPE[(size_t)t * 32 + lane] = (bf16_t)(pkbf(outv, 0.f) & 0xffffu);
            }
        }
        SEAM(pb + 1);
        if (IN(pb + 2)) { PHASE_PTRS();
            REP(2) {
            { pg8::Gemm g{PROJA + PROJ_QLAT, wl + OFF_WQ, NPA, 384, 384}; pg8::StaticOrder S; S.init(M, 768, G, bx); pg8::EpiQRope E{Qb, TAB};
              pg8::gemm_phase(lds, g, S, E); }
            { pg8::Gemm g{PROJA + PROJ_KVLAT, wl + OFF_WKV, NPA, 256, 256}; pg8::StaticOrder S; S.init(M, 1024, G, G - 1 - bx); pg8::EpiPlain E{KVb, 1024, 1 << 20};
              pg8::gemm_phase(lds, g, S, E); }
            }
        }
        SEAM(pb + 2);
        if (IN(pb + 3)) { PHASE_PTRS();
            REP(100)
            { const int upb = (1024 + G - 1) / G;
              for (int i = 0; i < upb; ++i) { const int u = vcu * upb + i; if (u >= 1024) break; const int bh = u >> 4, qb = u & 15; mla::unit(bh >> 3, bh & 7, qb, Qb, KVb, KPE, ATT, lds); } }
            { LAS float* rb = (LAS float*)(lds + LDSCTL_OFF + 1024); const float* rpb_g = ARGP(4) + l * 8 * 465;
              REP(101)
              for (int u = vcu; u < 256; u += G) na::unit(u >> 5, (u >> 2) & 7, u & 3, PROJA, VT, ATT, rpb_g, lds, rb); }
        }
        SEAM(pb + 3);
        if (IN(pb + 4)) { PHASE_PTRS();
            REP(4) {
            { pg8::Gemm g{ATT, wl + OFF_WNAO, 1024, 512, 512}; pg8::StaticOrder S; S.init(M, 1024, G, bx); pg8::EpiGate E{GATES, MERGED, 0};
              pg8::gemm_phase(lds, g, S, E); }
            { pg8::Gemm g{ATT + 512, wl + OFF_WMLAO, 1024, 512, 512}; pg8::StaticOrder S; S.init(M, 1024, G, bx); pg8::EpiGate E{GATES + 1024, MERGED, 1};
              pg8::gemm_phase(lds, g, S, E); }
            }
        }
        SEAM(pb + 4);
        if (IN(pb + 5)) { PHASE_PTRS();
            pg8::Gemm g{MERGED, wl + OFF_WOUT, 1024, 1024, 1024}; pg8::StaticOrder S; S.init(M, 1024, G, bx); pg8::EpiResid E{l == 0 ? ARGP(0) : (const float*)X, X};
            pg8::gemm_phase(lds, g, S, E);
        }
        SEAM(pb + 5);
        if (IN(pb + 6)) { PHASE_PTRS();
            REP(6) {
            LAS float* wr = (LAS float*)lds;
            const float* wrg = ARGP(13) + (size_t)l * 1024 * 16;
            for (int i = tid; i < 1024 * 4; i += 512) { const int k = i >> 2, c4 = i & 3; const int slot = (k & 3) * 256 + ((k >> 8) & 3) * 64 + ((k >> 2) & 63);
                *(LAS f32x4*)(wr + slot * 20 + c4 * 4) = *(const f32x4*)(wrg + k * 16 + c4 * 4); }
            __syncthreads();
            const float* gain = ARGP(12) + l * 1024;
            for (int mb = gw; mb < M / 4; mb += NGW) {
                const f32x4* gr = (const f32x4*)gain + lane;
                f32x4 v[4][4]; float rs[4];
#pragma unroll
                for (int rr = 0; rr < 4; ++rr) { const f32x4* xr = (const f32x4*)(X + (size_t)(mb * 4 + rr) * DM) + lane; float s = 0.f;
#pragma unroll
                    for (int j = 0; j < 4; ++j) { v[rr][j] = xr[64 * j]; s += (v[rr][j][0] * v[rr][j][0] + v[rr][j][1] * v[rr][j][1]) + (v[rr][j][2] * v[rr][j][2] + v[rr][j][3] * v[rr][j][3]); }
                    rs[rr] = s; }
#pragma unroll
                for (int rr = 0; rr < 4; ++rr) rs[rr] = 1.f / sqrtf(wave_sum(rs[rr]) * (1.f / DM) + RMS_EPS);
                float lg[64];
#pragma unroll
                for (int e = 0; e < 64; ++e) lg[e] = 0.f;
#pragma unroll
                for (int j = 0; j < 4; ++j) { const f32x4 gq = gr[64 * j];
#pragma unroll
                    for (int rr = 0; rr < 4; ++rr) { v[rr][j] = v[rr][j] * rs[rr] * gq;
                        u32x2 w; w.x = pkbf(v[rr][j][0], v[rr][j][1]); w.y = pkbf(v[rr][j][2], v[rr][j][3]); ((u32x2*)(H + (size_t)(mb * 4 + rr) * DM) + lane)[64 * j] = w; }
#pragma unroll
                    for (int q = 0; q < 4; ++q) { const LAS f32x4* wp = (const LAS f32x4*)(wr + (q * 256 + j * 64 + lane) * 20);
#pragma unroll
                        for (int c4 = 0; c4 < 4; ++c4) { const f32x4 w4 = wp[c4];
#pragma unroll
                            for (int rr = 0; rr < 4; ++rr) { const float xv = v[rr][j][q];
                                lg[rr * 16 + c4 * 4 + 0] += xv * w4[0]; lg[rr * 16 + c4 * 4 + 1] += xv * w4[1]; lg[rr * 16 + c4 * 4 + 2] += xv * w4[2]; lg[rr * 16 + c4 * 4 + 3] += xv * w4[3]; } }
                        __builtin_amdgcn_sched_barrier(0); } }
#define RSTEP(N, MASK, SRC, DST) _Pragma("unroll") for (int i = 0; i < N; ++i) { const bool up = (lane & MASK) != 0; const float mine = up ? SRC[N + i] : SRC[i], send = up ? SRC[i] : SRC[N + i]; DST[i] = mine + __shfl_xor(send, MASK); }
                float t32[32], t16[16], t8[8], t4[4], t2[2], t1[1];
                RSTEP(32, 32, lg, t32) RSTEP(16, 16, t32, t16) RSTEP(8, 8, t16, t8) RSTEP(4, 4, t8, t4) RSTEP(2, 2, t4, t2) RSTEP(1, 1, t2, t1)
#undef RSTEP
                const float lgt = t1[0];
                float mxl = lgt;
#pragma unroll
                for (int o = 1; o < 16; o <<= 1) mxl = fmaxf(mxl, __shfl_xor(mxl, o));
                const float ex = __expf(lgt - mxl); float se = ex;
#pragma unroll
                for (int o = 1; o < 16; o <<= 1) se += __shfl_xor(se, o);
                AFF[(size_t)mb * 64 + lane] = ex / se;
            }
            __syncthreads();
            }
        }
        SEAM(pb + 6);
        if (IN(pb + 7)) { PHASE_PTRS();
            REP(7) {
            LAS unsigned* sh = (LAS unsigned*)(lds + 9216);
            for (int it = bx; it < NB * NE; it += G) topk_item(it >> 4, it & 15, AFF, IDXR, VALR, SLOT, sh, tid, lane, wave);
            LAS float* scr = (LAS float*)(lds + wave * 16384);
            for (int it = gw; it < 3 * 8192; it += NGW) {
                const int which = it >> 13, r = it & 8191, e = r >> 9, kb = (r >> 5) & 15, nb = r & 31, n0 = nb * 32;
                const size_t eoff = (size_t)(l * 16 + e) * 1024 * 1024;
                if (which == 0) tr_item(ARGP(14) + eoff, 1024, kb * 64, n0, W13 + (size_t)e * 2048 * 1024, 1024, (n0 >> 7) * 256 + (n0 & 127), scr, lane);
                else if (which == 1) tr_item(ARGP(15) + eoff, 1024, kb * 64, n0, W13 + (size_t)e * 2048 * 1024, 1024, (n0 >> 7) * 256 + 128 + (n0 & 127), scr, lane);
                else tr_item(ARGP(16) + eoff, 1024, kb * 64, n0, W2T + (size_t)e * 1024 * 1024, 1024, n0, scr, lane);
            }
            const float* pl = ARGP(1) + (size_t)l * M * 256;
            for (size_t i = (size_t)bx * 512 + tid; i < (size_t)M * 256 / 8; i += (size_t)G * 512) { const f32x4 a0 = *(const f32x4*)(pl + i * 8), a1 = *(const f32x4*)(pl + i * 8 + 4);
                u32x4 w; w.x = pkbf(a0[0], a0[1]); w.y = pkbf(a0[2], a0[3]); w.z = pkbf(a1[0], a1[1]); w.w = pkbf(a1[2], a1[3]); *(u32x4*)(PBF + i * 8) = w; }
            }
        }
        SEAM(pb + 7);
        if (IN(pb + 8)) { PHASE_PTRS();
            REP(8)
            for (int rr = gw; rr < MR; rr += NGW) { const int src = __builtin_amdgcn_readfirstlane(IDXR[rr]);
                const u32x4* sp = (const u32x4*)(H + (size_t)src * DM) + lane; u32x4* dp = (u32x4*)(XG + (size_t)rr * DM) + lane;
                const u32x4 v0 = sp[0], v1 = sp[64]; dp[0] = v0; dp[64] = v1; }
        }
        SEAM(pb + 8);
        if (IN(pb + 9)) { PHASE_PTRS();
            REP(9) {
            pg8::Gemm g{XG, W13, 1024, 1024, 1024}; pg8::MoeOrder S; S.init(MR, 2048, G, bx, 3); pg8::EpiSwiGLU E{ACT};
            pg8::gemm_phase(lds, g, S, E); }
        }
        SEAM(pb + 9);
        if (IN(pb + 10)) { PHASE_PTRS();
            REP(10) {
            { pg8::Gemm g{ACT, W2T, 1024, 1024, 1024}; pg8::MoeOrder S; S.init(MR, 1024, G, bx, 2); pg8::EpiMoeDown E{MOEOUT, VALR};
              pg8::gemm_phase(lds, g, S, E); }
            { pg8::Gemm g{PBF, wl + OFF_WPW, 256, 256, 256}; pg8::StaticOrder S; S.init(M, 1024, G, bx); pg8::EpiPlain E{PE, 1024, 1 << 20};
              pg8::gemm_phase(lds, g, S, E); }
            }
        }
        SEAM(pb + 10);
        if (IN(pb + 11)) { PHASE_PTRS();
            const float* gain = ARGP(17) + l * 1024;
            for (int m = gw; m < M; m += NGW) {
                const int myslot = SLOT[(size_t)m * 16 + (lane & 15)];
                f32x4* xr = (f32x4*)(X + (size_t)m * DM) + lane; const f32x4* gr = (const f32x4*)gain + lane;
                f32x4 v[4];
#pragma unroll
                for (int j = 0; j < 4; ++j) v[j] = xr[64 * j];
                const int b = m >> 12;
#pragma unroll
                for (int e = 0; e < 16; ++e) { const int c = __builtin_amdgcn_readlane(myslot, e);
                    if (c >= 0) { const u32x2* mr = (const u32x2*)(MOEOUT + (size_t)((e * NB + b) * CAP + c) * DM) + lane;
#pragma unroll
                        for (int j = 0; j < 4; ++j) { const u32x2 w = mr[64 * j]; v[j][0] += bf_lo(w.x); v[j][1] += bf_hi(w.x); v[j][2] += bf_lo(w.y); v[j][3] += bf_hi(w.y); } } }
                float s = 0.f;
#pragma unroll
                for (int j = 0; j < 4; ++j) { xr[64 * j] = v[j]; s += (v[j][0] * v[j][0] + v[j][1] * v[j][1]) + (v[j][2] * v[j][2] + v[j][3] * v[j][3]); }
                const float rstd = 1.f / sqrtf(wave_sum(s) * (1.f / DM) + RMS_EPS);
#pragma unroll
                for (int j = 0; j < 4; ++j) { const f32x4 y = v[j] * rstd * gr[64 * j]; u32x2 w; w.x = pkbf(y[0], y[1]); w.y = pkbf(y[2], y[3]); ((u32x2*)(H + (size_t)m * DM) + lane)[64 * j] = w; }
            }
        }
        SEAM(pb + 11);
        if (IN(pb + 12)) { PHASE_PTRS();
            pg8::Gemm g{H, wl + OFF_WPG, 1024, 1024, 1024}; pg8::StaticOrder S; S.init(M, 1024, G, bx); pg8::EpiPle E{X, PE};
            pg8::gemm_phase(lds, g, S, E);
        }
        SEAM(pb + 12);
        if (IN(pb + 13)) { PHASE_PTRS();
            if (l + 1 < NLAYER) { REP(13) for (int m = gw; m < M; m += NGW) rms_row<false>(X + (size_t)m * DM, ARGP(2) + (l + 1) * 1024, H + (size_t)m * DM, nullptr, lane); }
            else { for (int m = gw; m < M; m += NGW) rms_row<true>(X + (size_t)m * DM, ARGP(20), nullptr, X + (size_t)m * DM, lane); }
        }
        if (l + 1 < NLAYER) SEAM(pb + 13);
    }
#undef IN
#undef SEAM
}

extern "C" void kernel_launch(void* const* d_in, const int* in_sizes, int n_in, void* d_out, int out_size, void* d_ws, size_t ws_size, hipStream_t stream) {
    static int grid = 0;
    if (grid == 0) {
        if (n_in != 21 || out_size != M * DM || ws_size < WS_END) { fprintf(stderr, "kernel_launch: unexpected shapes (n_in %d out %d ws %zu, need ws >= %zu)\n", n_in, out_size, ws_size, (size_t)WS_END); grid = -1; return; }
        int dev = 0, cus = 0, per_cu = 0;
        if (hipGetDevice(&dev) != hipSuccess || hipDeviceGetAttribute(&cus, hipDeviceAttributeMultiprocessorCount, dev) != hipSuccess) { grid = -1; return; }
        if (hipFuncSetAttribute((const void*)fwd, hipFuncAttributeMaxDynamicSharedMemorySize, LDS_BYTES) != hipSuccess) { fprintf(stderr, "kernel_launch: hipFuncSetAttribute failed\n"); grid = -1; return; }
        if (hipOccupancyMaxActiveBlocksPerMultiprocessor(&per_cu, (const void*)fwd, 512, LDS_BYTES) != hipSuccess || per_cu < 1) { fprintf(stderr, "kernel_launch: occupancy query reports %d blocks per CU\n", per_cu); }
        (void)hipGetLastError();
        grid = cus;
    }
    if (grid < 0) return;
    (void)hipMemsetAsync((char*)d_ws + WS_CTL, 0, CTL_ZERO_BYTES, stream);
    Args a{};
    for (int i = 0; i < 21; ++i) a.in[i] = (const float*)d_in[i];
    a.in[21] = (const float*)d_out; a.in[22] = (const float*)d_ws; a.in[23] = nullptr;
#if MK_ONE_LAUNCH
    a.ph_lo = 0; a.ph_hi = NPHASES;
    hipLaunchKernelGGL(fwd, dim3(grid), dim3(512), LDS_BYTES, stream, a);
#else
    for (int p = 0; p < NPHASES; ++p) { a.ph_lo = p; a.ph_hi = p + 1; hipLaunchKernelGGL(fwd, dim3(grid), dim3(512), LDS_BYTES, stream, a); }
#endif
}
```

```cpp
#include <hip/hip_runtime.h>
#include <cstdio>
#include <cstdint>

#ifndef PROBE_PH
#define PROBE_PH -1
#endif
#ifndef PROBE_T
#define PROBE_T -1
#endif
#define PROBE_MULT 4
#ifndef MK_ONE_LAUNCH
#define MK_ONE_LAUNCH 1
#endif

#define GAS __attribute__((address_space(1)))
#define LAS __attribute__((address_space(3)))
typedef unsigned short bf16_t;
typedef short bf16x8 __attribute__((ext_vector_type(8)));
typedef short s16x4 __attribute__((ext_vector_type(4)));
typedef float f32x2 __attribute__((ext_vector_type(2)));
typedef float f32x4 __attribute__((ext_vector_type(4)));
typedef float f32x16 __attribute__((ext_vector_type(16)));
typedef unsigned u32x2 __attribute__((ext_vector_type(2)));
typedef unsigned u32x4 __attribute__((ext_vector_type(4)));
typedef __bf16 bf16x2_t __attribute__((ext_vector_type(2)));

constexpr int NB = 8, SEQ = 4096, DM = 1024, M = NB * SEQ, NLAYER = 2;
constexpr int IN_COLS = 4256, NPA = 1792, NGATE = 2048, NINP = 3840;
constexpr int NE = 16, CAP = 512, MR = NB * NE * CAP;
constexpr float RMS_EPS = 1e-6f;
constexpr int PROJ_QLAT = 1024, PROJ_KVLAT = 1408, PROJ_KROPE = 1664;

constexpr size_t MiB = 1u << 20;
constexpr size_t WS_CTL = 0, CTL_ZERO_BYTES = 64 * 1024;
constexpr size_t WS_TAB = 1 * MiB;
constexpr size_t WS_RSR = 1 * MiB + 256 * 1024, WS_RS1 = 1 * MiB + 512 * 1024, WS_RS2 = 1 * MiB + 640 * 1024, WS_RS3 = 1 * MiB + 768 * 1024;
constexpr size_t WS_AFF = 2 * MiB;
constexpr size_t WS_SLOT = 4 * MiB;
constexpr size_t WS_IDXR = 6 * MiB;
constexpr size_t WS_VALR = 6 * MiB + 512 * 1024;
constexpr size_t WS_KPE = 7 * MiB;
constexpr size_t WS_WSM = 9 * MiB;
constexpr size_t WSM_STRIDE = 17 * MiB;
constexpr size_t WS_H = 44 * MiB;
constexpr size_t WS_R1 = 108 * MiB;
constexpr size_t R_PROJA = WS_R1 + 0, R_GATES = WS_R1 + 112 * MiB, R_VT = WS_R1 + 240 * MiB, R_Q = WS_R1 + 272 * MiB, R_KV = WS_R1 + 320 * MiB, R_ATT = WS_R1 + 384 * MiB;
constexpr size_t R_MERGED = WS_R1 + 0;
constexpr size_t R_XG = WS_R1 + 0, R_MOEOUT = WS_R1 + 0, R_ACT = WS_R1 + 128 * MiB, R_W13 = WS_R1 + 256 * MiB, R_W2T = WS_R1 + 320 * MiB, R_PBF = WS_R1 + 352 * MiB, R_PE = WS_R1 + 368 * MiB;
constexpr size_t WS_END = WS_R1 + 448 * MiB;
constexpr size_t OFF_WIN = 0, OFF_WV = 3932160, OFF_WQ = 4456448, OFF_WKV = 4751360, OFF_WNAO = 5013504, OFF_WMLAO = 5537792, OFF_WOUT = 6062080, OFF_WPG = 7110656, OFF_WPW = 8159232;
static_assert(8421376 * 2 <= WSM_STRIDE, "small weights fit");
constexpr int CW_BAR = 1024;

constexpr int RING_BYTES = 131072, LDSCTL_OFF = 147456, LDS_BYTES = 163840;

#define LDS_WAIT() asm volatile("s_waitcnt lgkmcnt(0)" ::: "memory")
__device__ __forceinline__ unsigned pkbf(float lo, float hi) { f32x2 v = {lo, hi}; bf16x2_t b = __builtin_convertvector(v, bf16x2_t); return __builtin_bit_cast(unsigned, b); }
__device__ __forceinline__ float bf_lo(unsigned w) { return __uint_as_float(w << 16); }
__device__ __forceinline__ float bf_hi(unsigned w) { return __uint_as_float(w & 0xffff0000u); }
__device__ __forceinline__ float bf1(bf16_t h) { return __uint_as_float(((unsigned)h) << 16); }
__device__ __forceinline__ float sigmoidf_(float x) { return __builtin_amdgcn_rcpf(1.f + __expf(-x)); }
__device__ __forceinline__ float wave_sum(float v) {
#pragma unroll
    for (int o = 1; o < 64; o <<= 1) v += __shfl_xor(v, o);
    return v;
}

namespace pg8 {
constexpr int BM = 256, BK = 64, HALF = 128, HTB = HALF * BK * 2, STAGE_BYTES = 8 * HTB, NXCD = 8, WGM = 8;
__host__ __device__ __forceinline__ int lds_byte(int r, int c) { const int st = (r >> 4) * 2 + (c >> 5), rr = r & 15, cc = c & 31, ob = rr * 64 + cc * 2; return st * 1024 + (ob ^ (((ob >> 9) & 1) << 5)); }
__host__ __device__ __forceinline__ void stage_rc(int b, int& R, int& C) { const int st = b / 1024, sb = b % 1024, swz = sb ^ (((sb >> 9) & 1) << 5); R = (st >> 1) * 16 + swz / 64; C = (st & 1) * 32 + (swz % 64) / 2; }
__host__ __device__ __forceinline__ int perm32(int rho) { const int n = rho >> 4, i = rho & 15; return 8 * (i >> 2) + 4 * n + (i & 3); }

struct Unit { int pm, pn, aux; };
struct Gemm { const bf16_t* A; const bf16_t* Bt; int lda, ldb, K; const int* rowidx; };

struct StaticOrder {
    int nM, nN, nwg, G, c;
    __host__ __device__ __forceinline__ void init(int M_, int N_, int G_, int c_) { nM = M_ / BM; nN = N_ / BM; nwg = nM * nN; G = G_; c = c_; }
    __host__ __device__ __forceinline__ bool next(int i, Unit& u) const {
        const long L = (long)i * G + c; if (L >= nwg) return false;
        int wgid = (int)L; { const int q = nwg / NXCD, r = nwg % NXCD, xcd = wgid % NXCD, off = wgid / NXCD; wgid = (xcd < r ? xcd * (q + 1) : r * (q + 1) + (xcd - r) * q) + off; }
        const int nig = WGM * nN, gid = wgid / nig, fm = gid * WGM, gsz = (nM - fm) < WGM ? (nM - fm) : WGM;
        u.pm = fm + ((wgid % nig) % gsz); u.pn = (wgid % nig) / gsz; u.aux = 0; return true;
    }
};
struct MoeOrder {
    StaticOrder S; int shift;
    __device__ __forceinline__ void init(int M_, int N_, int G_, int c_, int shift_) { S.init(M_, N_, G_, c_); shift = shift_; }
    __device__ __forceinline__ bool next(int i, Unit& u) const { if (!S.next(i, u)) return false; u.pn += (u.pm >> 4) << shift; return true; }
};
struct PanelOrder {
    int sh, G, c, npan;
    __device__ __forceinline__ void init(int sh_, int G_, int c_, int npan_) { sh = sh_; G = G_; c = c_; npan = npan_; }
    __device__ __forceinline__ bool next(int i, Unit& u) const { const int pm = c + (i >> sh) * G; if (pm >= npan) return false; u.pm = pm; u.pn = ((pm >> 4) << sh) + (i & ((1 << sh) - 1)); u.aux = i >> sh; return true; }
};

typedef f32x4 Acc[2][2][4][2];

template <int NC>
__device__ __forceinline__ void panel_rstd_lds(const bf16_t* __restrict__ A, int lda, int pm, LAS float* tab, int tid) {
    const int row = tid >> 1, half = tid & 1;
    const u32x4* p = (const u32x4*)(A + (size_t)(pm * BM + row) * lda + half * (NC / 2)); float s = 0.f;
#pragma unroll
    for (int i = 0; i < NC / 16; ++i) { const u32x4 w = p[i];
        s += bf_lo(w.x) * bf_lo(w.x) + bf_hi(w.x) * bf_hi(w.x) + bf_lo(w.y) * bf_lo(w.y) + bf_hi(w.y) * bf_hi(w.y) + bf_lo(w.z) * bf_lo(w.z) + bf_hi(w.z) * bf_hi(w.z) + bf_lo(w.w) * bf_lo(w.w) + bf_hi(w.w) * bf_hi(w.w); }
    s += __shfl_xor(s, 1);
    int rowq = row; asm volatile("" : "+v"(rowq));
    if (half == 0) tab[rowq] = 1.f / sqrtf(s * (1.f / NC) + RMS_EPS);
}
struct RsTab { const LAS float* tab; int t0, t1, t2, t3;
    __device__ __forceinline__ const LAS float* find(int pm) const { return tab + ((pm == t0) ? 0 : (pm == t1) ? 256 : (pm == t2) ? 512 : 768); } };
__device__ __forceinline__ float dpp_lo(float a, float b) { return __int_as_float(__builtin_amdgcn_update_dpp(__float_as_int(a), __float_as_int(b), 0x128, 0xF, 0xC, false)); }
__device__ __forceinline__ float dpp_hi(float a, float b) { return __int_as_float(__builtin_amdgcn_update_dpp(__float_as_int(b), __float_as_int(a), 0x128, 0xF, 0x3, false)); }
struct FL { f32x4 lo0, lo1, hi0, hi1; };
__device__ __forceinline__ FL fl_swap(const f32x4 a0, const f32x4 a1, const f32x4 b0, const f32x4 b1) { FL f;
#pragma unroll
    for (int q = 0; q < 4; ++q) { f.lo0[q] = dpp_lo(a0[q], b0[q]); f.lo1[q] = dpp_lo(a1[q], b1[q]); f.hi0[q] = dpp_hi(a0[q], b0[q]); f.hi1[q] = dpp_hi(a1[q], b1[q]); }
    return f; }
__device__ __forceinline__ u32x4 pk8(const f32x4 v0, const f32x4 v1) { u32x4 w; w.x = pkbf(v0[0], v0[1]); w.y = pkbf(v0[2], v0[3]); w.z = pkbf(v1[0], v1[1]); w.w = pkbf(v1[2], v1[3]); return w; }
struct EpiPlain {
    static constexpr bool WIDE = true;
    bf16_t* O; int ldc; int pn_mod; const float* cs;
    __device__ __forceinline__ void operator()(const Acc& acc, const Unit& u, int wr, int wc, int fr, int fq) const {
        const int col = (u.pn % pn_mod) * BM + wc * 64 + (fr >> 3) * 32 + 8 * fq, row0 = u.pm * BM + wr * 64 + (fr & 7);
        f32x4 c0 = {1.f, 1.f, 1.f, 1.f}, c1 = {1.f, 1.f, 1.f, 1.f};
        if (cs) { c0 = *(const f32x4*)(cs + col); c1 = *(const f32x4*)(cs + col + 4); }
#pragma unroll
        for (int ai = 0; ai < 2; ++ai)
#pragma unroll
            for (int m = 0; m < 4; ++m) { bf16_t* rowp = O + (size_t)(row0 + ai * HALF + m * 16) * ldc + col;
                const FL f = fl_swap(acc[ai][0][m][0], acc[ai][0][m][1], acc[ai][1][m][0], acc[ai][1][m][1]);
                *(u32x4*)rowp = pk8(f.lo0 * c0, f.lo1 * c1); *(u32x4*)(rowp + (size_t)8 * ldc) = pk8(f.hi0 * c0, f.hi1 * c1); }
    }
};
struct EpiInProj {
    static constexpr bool WIDE = true;
    bf16_t* PA; bf16_t* GT; const float* rs;
    __device__ __forceinline__ void operator()(const Acc& acc, const Unit& u, int wr, int wc, int fr, int fq) const {
        const bool gate = u.pn >= 7; bf16_t* O = gate ? GT : PA; const int ldc = gate ? NGATE : NPA;
        const int col = (gate ? (u.pn - 7) : u.pn) * BM + wc * 64 + (fr >> 3) * 32 + 8 * fq, row0 = u.pm * BM + wr * 64 + (fr & 7), rowf = u.pm * BM + wr * 64 + fr;
#pragma unroll
        for (int ai = 0; ai < 2; ++ai)
#pragma unroll
            for (int m = 0; m < 4; ++m) { bf16_t* rowp = O + (size_t)(row0 + ai * HALF + m * 16) * ldc + col; const float rsv = rs[rowf + ai * HALF + m * 16];
                FL f = fl_swap(acc[ai][0][m][0] * rsv, acc[ai][0][m][1] * rsv, acc[ai][1][m][0] * rsv, acc[ai][1][m][1] * rsv);
                if (gate) {
#pragma unroll
                    for (int q = 0; q < 4; ++q) { f.lo0[q] = sigmoidf_(f.lo0[q]); f.lo1[q] = sigmoidf_(f.lo1[q]); f.hi0[q] = sigmoidf_(f.hi0[q]); f.hi1[q] = sigmoidf_(f.hi1[q]); } }
                *(u32x4*)rowp = pk8(f.lo0, f.lo1); *(u32x4*)(rowp + (size_t)8 * ldc) = pk8(f.hi0, f.hi1); }
    }
};
struct EpiQRope {
    static constexpr bool WIDE = false;
    bf16_t* O; const float* tab; RsTab rt;
    __device__ __forceinline__ void operator()(const Acc& acc, const Unit& u, int wr, int wc, int fr, int fq) const {
        const int row0 = u.pm * BM + wr * 64 + fr;
        float rs[8]; { const LAS float* rp = rt.find(u.pm) + wr * 64 + fr;
#pragma unroll
            for (int k = 0; k < 8; ++k) rs[k] = rp[(k >> 2) * HALF + (k & 3) * 16]; }
#pragma unroll
        for (int bj = 0; bj < 2; ++bj) {
            const int col = u.pn * BM + bj * HALF + wc * 32 + 8 * fq;
            const int dl = col % 96;
            const bool pe = dl >= 64; const int grp = (dl - 64) >> 4;
#pragma unroll
            for (int ai = 0; ai < 2; ++ai)
#pragma unroll
                for (int m = 0; m < 4; ++m) { const int row = row0 + ai * HALF + m * 16;
                    const f32x4 v0 = acc[ai][bj][m][0] * rs[ai * 4 + m], v1 = acc[ai][bj][m][1] * rs[ai * 4 + m];
                    float x[8] = {v0[0], v0[1], v0[2], v0[3], v1[0], v1[1], v1[2], v1[3]}, y[8];
#pragma unroll
                    for (int q = 0; q < 8; ++q) y[q] = __shfl_xor(x[q], 16);
                    if (pe) { const int s = row & (SEQ - 1); const int pos = grp ? (s & 63) : (s >> 6);
                        const f32x4* tp = (const f32x4*)(tab + pos * 16);
                        const f32x4 t0 = tp[0], t1 = tp[1], t2 = tp[2], t3 = tp[3];
                        const float cs[8] = {t0[0], t0[2], t1[0], t1[2], t2[0], t2[2], t3[0], t3[2]}, sn[8] = {t0[1], t0[3], t1[1], t1[3], t2[1], t2[3], t3[1], t3[3]};
                        const float sg = (fq & 1) ? 1.f : -1.f;
#pragma unroll
                        for (int q = 0; q < 8; ++q) x[q] = x[q] * cs[q] + sg * y[q] * sn[q]; }
                    constexpr float QC = 0.10206207261596575f * 1.4426950408889634f;
                    u32x4 w; w.x = pkbf(x[0] * QC, x[1] * QC); w.y = pkbf(x[2] * QC, x[3] * QC); w.z = pkbf(x[4] * QC, x[5] * QC); w.w = pkbf(x[6] * QC, x[7] * QC);
                    *(u32x4*)(O + (size_t)row * 768 + col) = w; __builtin_amdgcn_sched_barrier(0); } }
    }
};
struct EpiKV {
    static constexpr bool WIDE = false;
    bf16_t* O; const bf16_t* PA; bf16_t* KPE; const float* tab; RsTab rt;
    __device__ __forceinline__ void operator()(const Acc& acc, const Unit& u, int wr, int wc, int fr, int fq) const {
        const int col0 = u.pn * BM + wc * 32 + 8 * fq, row0 = u.pm * BM + wr * 64 + fr;
        float rs[8]; { const LAS float* rp = rt.find(u.pm) + wr * 64 + fr;
#pragma unroll
            for (int k = 0; k < 8; ++k) rs[k] = rp[(k >> 2) * HALF + (k & 3) * 16]; }
#pragma unroll
        for (int ai = 0; ai < 2; ++ai)
#pragma unroll
            for (int m = 0; m < 4; ++m) { bf16_t* rowp = O + (size_t)(row0 + ai * HALF + m * 16) * 1024 + col0; const float r = rs[ai * 4 + m];
#pragma unroll
                for (int bj = 0; bj < 2; ++bj) { const f32x4 v0 = acc[ai][bj][m][0] * r, v1 = acc[ai][bj][m][1] * r;
                    u32x4 w; w.x = pkbf(v0[0], v0[1]); w.y = pkbf(v0[2], v0[3]); w.z = pkbf(v1[0], v1[1]); w.w = pkbf(v1[2], v1[3]);
                    *(u32x4*)(rowp + bj * HALF) = w; } }
        if (u.pn == 0) {
            const int t = ((wr * 4 + wc) << 6) | (fq << 4) | fr, row = u.pm * BM + (t >> 1), grp = t & 1;
            const u32x4* src = (const u32x4*)(PA + (size_t)row * NPA + PROJ_KROPE + 16 * grp); const u32x4 a = src[0], b = src[1];
            const int sq = row & (SEQ - 1), pos = grp ? (sq & 63) : (sq >> 6);
            const f32x4* tp = (const f32x4*)(tab + pos * 16); const f32x4 t0 = tp[0], t1 = tp[1], t2 = tp[2], t3 = tp[3];
            const float cs[8] = {t0[0], t0[2], t1[0], t1[2], t2[0], t2[2], t3[0], t3[2]}, sn[8] = {t0[1], t0[3], t1[1], t1[3], t2[1], t2[3], t3[1], t3[3]};
            const float x1[8] = {bf_lo(a.x), bf_hi(a.x), bf_lo(a.y), bf_hi(a.y), bf_lo(a.z), bf_hi(a.z), bf_lo(a.w), bf_hi(a.w)}, x2[8] = {bf_lo(b.x), bf_hi(b.x), bf_lo(b.y), bf_hi(b.y), bf_lo(b.z), bf_hi(b.z), bf_lo(b.w), bf_hi(b.w)};
            float o1[8], o2[8];
#pragma unroll
            for (int q = 0; q < 8; ++q) { o1[q] = x1[q] * cs[q] - x2[q] * sn[q]; o2[q] = x2[q] * cs[q] + x1[q] * sn[q]; }
            u32x4 w0, w1; w0.x = pkbf(o1[0], o1[1]); w0.y = pkbf(o1[2], o1[3]); w0.z = pkbf(o1[4], o1[5]); w0.w = pkbf(o1[6], o1[7]); w1.x = pkbf(o2[0], o2[1]); w1.y = pkbf(o2[2], o2[3]); w1.z = pkbf(o2[4], o2[5]); w1.w = pkbf(o2[6], o2[7]);
            u32x4* dst = (u32x4*)(KPE + (size_t)row * 32 + 16 * grp); dst[0] = w0; dst[1] = w1; }
    }
};
struct EpiGate {
    static constexpr bool WIDE = true;
    const bf16_t* Gt; bf16_t* O; int add;
    __device__ __forceinline__ void operator()(const Acc& acc, const Unit& u, int wr, int wc, int fr, int fq) const {
        const int col = u.pn * BM + wc * 64 + (fr >> 3) * 32 + 8 * fq, row0 = u.pm * BM + wr * 64 + (fr & 7);
#pragma unroll
        for (int ai = 0; ai < 2; ++ai)
#pragma unroll
            for (int m = 0; m < 4; ++m) { const size_t row = (size_t)(row0 + ai * HALF + m * 16);
                const FL f = fl_swap(acc[ai][0][m][0], acc[ai][0][m][1], acc[ai][1][m][0], acc[ai][1][m][1]);
#pragma unroll
                for (int hh = 0; hh < 2; ++hh) { const f32x4 v0 = hh ? f.hi0 : f.lo0, v1 = hh ? f.hi1 : f.lo1; const size_t r = row + 8 * hh;
                    const u32x4 g = *(const u32x4*)(Gt + r * NGATE + col);
                    u32x4 p = {0u, 0u, 0u, 0u}; if (add) p = *(const u32x4*)(O + r * DM + col);
                    u32x4 w;
                    w.x = pkbf(bf_lo(p.x) + bf_lo(g.x) * v0[0], bf_hi(p.x) + bf_hi(g.x) * v0[1]);
                    w.y = pkbf(bf_lo(p.y) + bf_lo(g.y) * v0[2], bf_hi(p.y) + bf_hi(g.y) * v0[3]);
                    w.z = pkbf(bf_lo(p.z) + bf_lo(g.z) * v1[0], bf_hi(p.z) + bf_hi(g.z) * v1[1]);
                    w.w = pkbf(bf_lo(p.w) + bf_lo(g.w) * v1[2], bf_hi(p.w) + bf_hi(g.w) * v1[3]);
                    *(u32x4*)(O + r * DM + col) = w; } }
    }
};
struct EpiResid {
    static constexpr bool WIDE = true;
    bf16_t* XB;
    __device__ __forceinline__ void operator()(const Acc& acc, const Unit& u, int wr, int wc, int fr, int fq) const {
        const int col = u.pn * BM + wc * 64 + (fr >> 3) * 32 + 8 * fq, row0 = u.pm * BM + wr * 64 + (fr & 7);
#pragma unroll
        for (int ai = 0; ai < 2; ++ai)
#pragma unroll
            for (int m = 0; m < 4; ++m) { bf16_t* rowp = XB + (size_t)(row0 + ai * HALF + m * 16) * DM + col;
                const FL f = fl_swap(acc[ai][0][m][0], acc[ai][0][m][1], acc[ai][1][m][0], acc[ai][1][m][1]);
#pragma unroll
                for (int hh = 0; hh < 2; ++hh) { const f32x4 v0 = hh ? f.hi0 : f.lo0, v1 = hh ? f.hi1 : f.lo1; const u32x4 p = *(const u32x4*)(rowp + hh * 8 * DM);
                    u32x4 w; w.x = pkbf(bf_lo(p.x) + v0[0], bf_hi(p.x) + v0[1]); w.y = pkbf(bf_lo(p.y) + v0[2], bf_hi(p.y) + v0[3]); w.z = pkbf(bf_lo(p.z) + v1[0], bf_hi(p.z) + v1[1]); w.w = pkbf(bf_lo(p.w) + v1[2], bf_hi(p.w) + v1[3]);
                    *(u32x4*)(rowp + hh * 8 * DM) = w; } }
    }
};
struct EpiSwiGLU {
    static constexpr bool WIDE = false;
    bf16_t* O; const float* rs; const LAS float* tab0;
    __device__ __forceinline__ void operator()(const Acc& acc, const Unit& u, int wr, int wc, int fr, int fq) const {
        const int col0 = (u.pn & 7) * HALF + wc * 32 + 8 * fq, row0 = u.pm * BM + wr * 64 + fr;
        float rsl[8];
        if (u.aux == 0) {
#pragma unroll
            for (int k = 0; k < 8; ++k) rsl[k] = tab0[wr * 64 + fr + (k >> 2) * HALF + (k & 3) * 16]; }
        else {
#pragma unroll
            for (int k = 0; k < 8; ++k) rsl[k] = rs[row0 + (k >> 2) * HALF + (k & 3) * 16]; }
#pragma unroll
        for (int ai = 0; ai < 2; ++ai)
#pragma unroll
            for (int m = 0; m < 4; ++m) { float r[8]; const float rsv = rsl[ai * 4 + m];
#pragma unroll
                for (int n = 0; n < 2; ++n)
#pragma unroll
                    for (int q = 0; q < 4; ++q) { const float a = acc[ai][0][m][n][q] * rsv, b = acc[ai][1][m][n][q] * rsv; r[n * 4 + q] = a * sigmoidf_(a) * b; }
                u32x4 w; w.x = pkbf(r[0], r[1]); w.y = pkbf(r[2], r[3]); w.z = pkbf(r[4], r[5]); w.w = pkbf(r[6], r[7]);
                *(u32x4*)(O + (size_t)(row0 + ai * HALF + m * 16) * 1024 + col0) = w; }
    }
};
struct EpiMoeDown {
    static constexpr bool WIDE = true;
    bf16_t* O; const float* val; const LAS float* tab0;
    __device__ __forceinline__ void operator()(const Acc& acc, const Unit& u, int wr, int wc, int fr, int fq) const {
        const int col = (u.pn & 3) * BM + wc * 64 + (fr >> 3) * 32 + 8 * fq, row0 = u.pm * BM + wr * 64 + (fr & 7), rowf = u.pm * BM + wr * 64 + fr;
        float vl[8];
        if (u.aux == 0) {
#pragma unroll
            for (int k = 0; k < 8; ++k) vl[k] = tab0[wr * 64 + fr + (k >> 2) * HALF + (k & 3) * 16]; }
        else {
#pragma unroll
            for (int k = 0; k < 8; ++k) vl[k] = val[rowf + (k >> 2) * HALF + (k & 3) * 16]; }
#pragma unroll
        for (int ai = 0; ai < 2; ++ai)
#pragma unroll
            for (int m = 0; m < 4; ++m) { const float sc = vl[ai * 4 + m]; bf16_t* rowp = O + (size_t)(row0 + ai * HALF + m * 16) * 1024 + col;
                const FL f = fl_swap(acc[ai][0][m][0] * sc, acc[ai][0][m][1] * sc, acc[ai][1][m][0] * sc, acc[ai][1][m][1] * sc);
                *(u32x4*)rowp = pk8(f.lo0, f.lo1); *(u32x4*)(rowp + 8 * 1024) = pk8(f.hi0, f.hi1); }
    }
};
struct EpiPle {
    static constexpr bool WIDE = true;
    const bf16_t* XB; bf16_t* XO; const bf16_t* PE; const float* rs;
    __device__ __forceinline__ void operator()(const Acc& acc, const Unit& u, int wr, int wc, int fr, int fq) const {
        const int col = u.pn * BM + wc * 64 + (fr >> 3) * 32 + 8 * fq, row0 = u.pm * BM + wr * 64 + (fr & 7), rowf = u.pm * BM + wr * 64 + fr;
#pragma unroll
        for (int ai = 0; ai < 2; ++ai)
#pragma unroll
            for (int m = 0; m < 4; ++m) { const size_t off0 = (size_t)(row0 + ai * HALF + m * 16) * DM + col; const float rsv = rs[rowf + ai * HALF + m * 16];
                const FL f = fl_swap(acc[ai][0][m][0] * rsv, acc[ai][0][m][1] * rsv, acc[ai][1][m][0] * rsv, acc[ai][1][m][1] * rsv);
#pragma unroll
                for (int hh = 0; hh < 2; ++hh) { const f32x4 v0 = hh ? f.hi0 : f.lo0, v1 = hh ? f.hi1 : f.lo1; const size_t off = off0 + hh * 8 * DM;
                    const u32x4 p = *(const u32x4*)(PE + off), x = *(const u32x4*)(XB + off);
                    u32x4 w;
                    w.x = pkbf(bf_lo(x.x) + sigmoidf_(v0[0]) * bf_lo(p.x), bf_hi(x.x) + sigmoidf_(v0[1]) * bf_hi(p.x)); w.y = pkbf(bf_lo(x.y) + sigmoidf_(v0[2]) * bf_lo(p.y), bf_hi(x.y) + sigmoidf_(v0[3]) * bf_hi(p.y));
                    w.z = pkbf(bf_lo(x.z) + sigmoidf_(v1[0]) * bf_lo(p.z), bf_hi(x.z) + sigmoidf_(v1[1]) * bf_hi(p.z)); w.w = pkbf(bf_lo(x.w) + sigmoidf_(v1[2]) * bf_lo(p.w), bf_hi(x.w) + sigmoidf_(v1[3]) * bf_hi(p.w));
                    *(u32x4*)(XO + off) = w; } }
    }
};

template <class Epi, class Sched, bool GATHER = false>
__device__ __forceinline__ void gemm_phase(LAS unsigned char* lds, const Gemm g, const Sched& S, const Epi& E, unsigned long long* ptq = nullptr) {
    int tid = threadIdx.x; asm volatile("" : "+v"(tid));
    const int wid = __builtin_amdgcn_readfirstlane(tid >> 6), lane = tid & 63, wr = wid >> 2, wc = wid & 3, fr = lane & 15, fq = lane >> 4;
    const int K = g.K, nt = K / BK;
    unsigned voffA[2], voffB[2];
    constexpr bool WIDE = Epi::WIDE;
#pragma unroll
    for (int i = 0; i < 2; ++i) { int R, C; stage_rc(tid * 16 + i * 8192, R, C); const int Rb = (WIDE ? 2 * (R & ~31) : (R & ~31)) + perm32(R & 31);
        voffA[i] = (unsigned)(R * g.lda + C) * 2u; voffB[i] = (unsigned)(Rb * g.ldb + C) * 2u; }
    const size_t kstep = (size_t)(BK * 2);
    const size_t hstepA = (size_t)HALF * g.lda * 2, hstepB = (size_t)(WIDE ? 32 : HALF) * g.ldb * 2;
    const size_t tstepA = 2 * hstepA, tstepB = (size_t)BM * g.ldb * 2;
    const unsigned ldsw = (unsigned)wid * 1024u;
    const int aoff = lds_byte(wr * 64 + fr, fq * 8), boff = lds_byte(wc * 32 + fr, fq * 8);
#define PG8_SA(b, h) (((b) * 2 + (h)) * HTB)
#define PG8_SB(b, h) ((4 + (b) * 2 + (h)) * HTB)
#define PG8_STAGE(bufoff, gbase, voff) do { _Pragma("unroll") for (int _i = 0; _i < 2; ++_i) \
        __builtin_amdgcn_global_load_lds((const unsigned*)((const char*)(gbase) + (voff)[_i]), (LAS unsigned*)(lds + (bufoff) + ldsw + _i * 8192), 16, 0, 0); } while (0)
#define PG8_LDA(dst, b, h) do { _Pragma("unroll") for (int m = 0; m < 4; ++m) _Pragma("unroll") for (int k = 0; k < 2; ++k) dst[m][k] = *(const LAS bf16x8*)(lds + PG8_SA(b, h) + aoff + m * 2048 + k * 1024); } while (0)
#define PG8_LDB(dst, b, h) do { _Pragma("unroll") for (int n = 0; n < 2; ++n) _Pragma("unroll") for (int k = 0; k < 2; ++k) dst[n][k] = *(const LAS bf16x8*)(lds + PG8_SB(b, h) + boff + n * 2048 + k * 1024); } while (0)
#define PG8_MMA(ai, bj, At, Bt) do { __builtin_amdgcn_s_setprio(1); _Pragma("unroll") for (int m = 0; m < 4; ++m) _Pragma("unroll") for (int n = 0; n < 2; ++n) _Pragma("unroll") for (int k = 0; k < 2; ++k) \
        acc[ai][bj][m][n] = __builtin_amdgcn_mfma_f32_16x16x32_bf16(Bt[n][k], At[m][k], acc[ai][bj][m][n], 0, 0, 0); __builtin_amdgcn_s_setprio(0); } while (0)
#define PG8_WAIT_V(n) asm volatile("s_waitcnt vmcnt(" #n ")" ::: "memory")
#define PG8_WAIT_L(n) asm volatile("s_waitcnt lgkmcnt(" #n ")" ::: "memory")
#define PG8_BAR __builtin_amdgcn_s_barrier()
#define PG8_SCHED __builtin_amdgcn_sched_barrier(0)
    Unit cur, nxt; int ui = 0;
    if (!S.next(0, cur)) return;
    unsigned gvA[2][2] = {{0u, 0u}, {0u, 0u}};
#define PG8_LOADGV(pm_) do { _Pragma("unroll") for (int _h = 0; _h < 2; ++_h) _Pragma("unroll") for (int _i = 0; _i < 2; ++_i) { int R_, C_; stage_rc(tid * 16 + _i * 8192, R_, C_); \
        gvA[_h][_i] = (unsigned)g.rowidx[(pm_) * BM + _h * HALF + R_] * (unsigned)(g.lda * 2) + (unsigned)(C_ * 2); } } while (0)
#define PG8_STAGE_A(b, h, ptr) do { if constexpr (GATHER) { PG8_STAGE(PG8_SA(b, h), ptr, gvA[h]); } else { PG8_STAGE(PG8_SA(b, h), (ptr) + (h) * hstepA, voffA); } } while (0)
    if constexpr (GATHER) PG8_LOADGV(cur.pm);
    f32x4 acc[2][2][4][2];
#pragma unroll
    for (int a = 0; a < 2; ++a)
#pragma unroll
        for (int b = 0; b < 2; ++b)
#pragma unroll
            for (int m = 0; m < 4; ++m)
#pragma unroll
                for (int n = 0; n < 2; ++n) acc[a][b][m][n] = (f32x4){0.f, 0.f, 0.f, 0.f};
    bf16x8 At[4][2], B0[2][2], B1[2][2];
    const char* cA = (const char*)g.A + (GATHER ? (size_t)0 : (size_t)cur.pm * tstepA); const char* cB = (const char*)g.Bt + (size_t)cur.pn * tstepB;
    PG8_STAGE(PG8_SB(0, 0), cB, voffB); PG8_STAGE(PG8_SB(0, 1), cB + hstepB, voffB); PG8_STAGE_A(0, 0, cA); PG8_STAGE_A(0, 1, cA);
    if (wr == 1) PG8_BAR;
    PG8_WAIT_V(2); PG8_BAR;
    PG8_STAGE(PG8_SB(1, 0), cB + kstep, voffB); PG8_STAGE_A(1, 0, cA + kstep); PG8_STAGE(PG8_SB(1, 1), cB + hstepB + kstep, voffB);
    PG8_WAIT_V(6); PG8_BAR;
    for (;;) {
        const bool has_next = S.next(ui + 1, nxt);
        const char* nA = (has_next && !GATHER) ? (const char*)g.A + (size_t)nxt.pm * tstepA : cA; const char* nB = has_next ? (const char*)g.Bt + (size_t)nxt.pn * tstepB : cB;
#pragma unroll 1
        for (int t = 0; t < nt; t += 2) {
            const bool last = (t == nt - 2);
            const char* a1 = cA + (size_t)(t + 1) * kstep;
            const char* a2 = last ? nA : cA + (size_t)(t + 2) * kstep; const char* b2 = last ? nB : cB + (size_t)(t + 2) * kstep;
            const char* a3 = a2 + kstep; const char* b3 = b2 + kstep;
            PG8_LDB(B0, 0, 0); PG8_LDB(B1, 0, 1); PG8_SCHED; PG8_LDA(At, 0, 0); PG8_STAGE_A(1, 1, a1);
            if constexpr (GATHER) { if (last && has_next && nxt.pm != cur.pm) PG8_LOADGV(nxt.pm); }
            PG8_WAIT_V(8); PG8_WAIT_L(0); PG8_BAR; PG8_MMA(0, 0, At, B0); PG8_MMA(0, 1, At, B1); PG8_BAR; PG8_SCHED;
            PG8_LDA(At, 0, 1); PG8_STAGE(PG8_SB(0, 0), b2, voffB); PG8_STAGE(PG8_SB(0, 1), b2 + hstepB, voffB); PG8_STAGE_A(0, 0, a2);
            PG8_WAIT_V(8); PG8_WAIT_L(0); PG8_BAR; PG8_MMA(1, 0, At, B0); PG8_MMA(1, 1, At, B1); PG8_BAR; PG8_SCHED;
            PG8_LDB(B0, 1, 0); PG8_LDB(B1, 1, 1); PG8_SCHED; PG8_LDA(At, 1, 0); PG8_STAGE_A(0, 1, a2);
            PG8_WAIT_V(8); PG8_WAIT_L(0); PG8_BAR; PG8_MMA(0, 0, At, B0); PG8_MMA(0, 1, At, B1); PG8_BAR; PG8_SCHED;
            PG8_LDA(At, 1, 1); PG8_STAGE(PG8_SB(1, 0), b3, voffB); PG8_STAGE(PG8_SB(1, 1), b3 + hstepB, voffB); PG8_STAGE_A(1, 0, a3);
            PG8_WAIT_V(8); PG8_WAIT_L(0); PG8_BAR; PG8_MMA(1, 0, At, B0); PG8_MMA(1, 1, At, B1); PG8_BAR; PG8_SCHED;
        }
#if PROBE_T == 200 || PROBE_T == 201
        if (ptq) { const unsigned long long now_ = __builtin_amdgcn_s_memrealtime(); if (PROBE_T == 201) ptq[0] += now_ - ptq[1]; ptq[1] = now_; }
#endif
        if (wr == 0) PG8_BAR;
        E(acc, cur, wr, wc, fr, fq);
#if PROBE_T == 200 || PROBE_T == 201
        if (ptq) { const unsigned long long now_ = __builtin_amdgcn_s_memrealtime(); if (PROBE_T == 200) ptq[0] += now_ - ptq[1]; ptq[1] = now_; }
#endif
        if (!has_next) break;
#pragma unroll
        for (int a = 0; a < 2; ++a)
#pragma unroll
            for (int b = 0; b < 2; ++b)
#pragma unroll
                for (int m = 0; m < 4; ++m)
#pragma unroll
                    for (int n = 0; n < 2; ++n) acc[a][b][m][n] = (f32x4){0.f, 0.f, 0.f, 0.f};
        cur = nxt; cA = nA; cB = nB; ++ui;
        if (wr == 1) PG8_BAR;
    }
    PG8_WAIT_V(0);
    PG8_BAR;
#undef PG8_SA
#undef PG8_SB
#undef PG8_STAGE
#undef PG8_STAGE_A
#undef PG8_LOADGV
#undef PG8_LDA
#undef PG8_LDB
#undef PG8_MMA
#undef PG8_WAIT_V
#undef PG8_WAIT_L
#undef PG8_BAR
#undef PG8_SCHED
}
}

namespace mla {
constexpr int NW = 8, QBLK = 32, KVBLK = 64;
constexpr float SCALE = 0.10206207261596575f;
constexpr float THR = 8.f;
constexpr int SHM_V = KVBLK * 64 * 2, SHM_K = KVBLK * 256;
constexpr int NSLOT = 3, OFF_V = 0, OFF_K = NSLOT * SHM_V, OFF_WS = OFF_K + NSLOT * SHM_K, LDS_NEED = OFF_WS + NW * 64 * 4;
#define KSWZ(row, colB) ((row) * 256 + ((colB) ^ (((row) & 15) << 4)))
#define SBAR() __builtin_amdgcn_sched_barrier(0)
__device__ __forceinline__ int crow(int r, int hi) { return (r & 3) + 8 * (r >> 2) + 4 * hi; }

constexpr float THRL = THR * 1.4426950408889634f;
template <bool FIRST>
__device__ __forceinline__ void partialSM(f32x16& p0, f32x16& p1, float& mhat, f32x16& negm, float& alpha) {
  float pmax = p0[0];
#pragma unroll
  for (int r = 1; r < 16; ++r) pmax = fmaxf(pmax, p0[r]);
#pragma unroll
  for (int r = 0; r < 16; ++r) pmax = fmaxf(pmax, p1[r]);
  { auto rr = __builtin_amdgcn_permlane32_swap(__float_as_uint(pmax), __float_as_uint(pmax), false, false);
    pmax = fmaxf(__uint_as_float(rr[0]), __uint_as_float(rr[1])); }
  alpha = 1.f;
  if (FIRST || __builtin_expect(!__all(pmax <= THRL), 0)) {
    const float dl = FIRST ? pmax : fmaxf(pmax, 0.f);
    mhat += dl; alpha = FIRST ? 1.f : __builtin_amdgcn_exp2f(-dl);
#pragma unroll
    for (int r = 0; r < 16; ++r) { p0[r] -= dl; p1[r] -= dl; }
#pragma unroll
    for (int r = 0; r < 16; ++r) negm[r] = -mhat;
  }
#pragma unroll
  for (int r = 0; r < 16; ++r) p0[r] = __builtin_amdgcn_exp2f(p0[r]);
}
__device__ __forceinline__ void finishSM(f32x16& p0, f32x16& p1, float alpha, float& l_reg, bf16x8& pa0, bf16x8& pa1, bf16x8& pa2, bf16x8& pa3) {
#pragma unroll
  for (int r = 0; r < 16; ++r) p1[r] = __builtin_amdgcn_exp2f(p1[r]);
  float ps = 0;
#pragma unroll
  for (int r = 0; r < 16; ++r) ps += p0[r];
#pragma unroll
  for (int r = 0; r < 16; ++r) ps += p1[r];
  { auto rr = __builtin_amdgcn_permlane32_swap(__float_as_uint(ps), __float_as_uint(ps), false, false);
    ps = __uint_as_float(rr[0]) + __uint_as_float(rr[1]); }
  l_reg = l_reg * alpha + ps;
#define PK8(P, BASE, OUT) do { const u32x4 w = {pkbf(P[BASE + 0], P[BASE + 1]), pkbf(P[BASE + 2], P[BASE + 3]), pkbf(P[BASE + 4], P[BASE + 5]), pkbf(P[BASE + 6], P[BASE + 7])}; OUT = __builtin_bit_cast(bf16x8, w); } while (0)
  PK8(p0, 0, pa0); PK8(p0, 8, pa1); PK8(p1, 0, pa2); PK8(p1, 8, pa3);
#undef PK8
}
__device__ __forceinline__ void qkt(f32x16& p0, f32x16& p1, const LAS unsigned char* Ks, const bf16x8* qr, const f32x16& negm, int r32, int hi) {
  p0 = negm; p1 = negm;
#pragma unroll
  for (int d0 = 0; d0 < 6; ++d0) { const int cb = (d0 * 16 + hi * 8) * 2;
    const bf16x8 b0 = *(const LAS bf16x8*)(Ks + KSWZ(r32, cb));
    const bf16x8 b1 = *(const LAS bf16x8*)(Ks + KSWZ(32 + r32, cb));
    p0 = __builtin_amdgcn_mfma_f32_32x32x16_bf16(b0, qr[d0], p0, 0, 0, 0);
    p1 = __builtin_amdgcn_mfma_f32_32x32x16_bf16(b1, qr[d0], p1, 0, 0, 0); }
}
__device__ __forceinline__ int v_st(int k, int c) { const int kk = k; return ((kk >> 3) * 2 + (c >> 5)) * 512 + ((kk & 7) * 32 + (c & 31)) * 2; }
__device__ __forceinline__ int v_rd_base(int lane) { return ((lane & 3) << 3) | (((lane >> 2) & 3) << 6) | (((lane >> 4) & 1) << 5) | (((lane >> 5) & 1) << 8); }
constexpr int v_rd_off(int d0, int ks, int half) { return d0 * 512 + ks * 2048 + half * 1024; }
template <int OFF> __device__ __forceinline__ s16x4 tr_read(int vb) {
  s16x4 r; asm volatile("ds_read_b64_tr_b16 %0, %1 offset:%2" : "=&v"(r) : "v"(vb), "i"(OFF) : "memory"); return r;
}
template <int D0> __device__ __forceinline__ void pv_one(f32x16& od, int vb, bf16x8 pa0, bf16x8 pa1, bf16x8 pa2, bf16x8 pa3) {
  const s16x4 l0 = tr_read<v_rd_off(D0, 0, 0)>(vb), h0 = tr_read<v_rd_off(D0, 0, 1)>(vb), l1 = tr_read<v_rd_off(D0, 1, 0)>(vb), h1 = tr_read<v_rd_off(D0, 1, 1)>(vb);
  const s16x4 l2 = tr_read<v_rd_off(D0, 2, 0)>(vb), h2 = tr_read<v_rd_off(D0, 2, 1)>(vb), l3 = tr_read<v_rd_off(D0, 3, 0)>(vb), h3 = tr_read<v_rd_off(D0, 3, 1)>(vb);
  asm volatile("s_waitcnt lgkmcnt(0)" ::: "memory"); SBAR();
#define PK(L, H) (bf16x8){L[0], L[1], L[2], L[3], H[0], H[1], H[2], H[3]}
  od = __builtin_amdgcn_mfma_f32_32x32x16_bf16(PK(l0, h0), pa0, od, 0, 0, 0);
  od = __builtin_amdgcn_mfma_f32_32x32x16_bf16(PK(l1, h1), pa1, od, 0, 0, 0);
  od = __builtin_amdgcn_mfma_f32_32x32x16_bf16(PK(l2, h2), pa2, od, 0, 0, 0);
  od = __builtin_amdgcn_mfma_f32_32x32x16_bf16(PK(l3, h3), pa3, od, 0, 0, 0);
#undef PK
}
__device__ __forceinline__ void pv_d0(f32x16* o, int vb, bf16x8 pa0, bf16x8 pa1, bf16x8 pa2, bf16x8 pa3) {
  pv_one<0>(o[0], vb, pa0, pa1, pa2, pa3); pv_one<1>(o[1], vb, pa0, pa1, pa2, pa3);
}
__device__ __forceinline__ void unit(int b, int h, int qb, const bf16_t* __restrict__ Qg, const bf16_t* __restrict__ KVg, const bf16_t* __restrict__ KPE, bf16_t* __restrict__ ATT, LAS unsigned char* lds) {
  int tid = threadIdx.x; asm volatile("" : "+v"(tid));
  const int wid = tid >> 6, lane = tid & 63, r32 = lane & 31, hi = lane >> 5;
  LAS unsigned char* V_lds = lds + OFF_V; LAS unsigned char* K_lds = lds + OFF_K;
  LAS float* ws = (LAS float*)(lds + OFF_WS) + wid * 64; LAS float* li_l = ws; LAS float* al_l = ws + 32;
  float m_reg = 0.f, l_reg = 0; f32x16 o[2] = {}; bf16x8 qr[6]; f32x16 negm = {};
  const size_t tok0 = (size_t)b * SEQ;
  const bf16_t* Qw = Qg + (tok0 + qb * 256 + wid * QBLK + r32) * 768 + h * 96 + hi * 8;
#pragma unroll
  for (int d0 = 0; d0 < 6; ++d0) qr[d0] = *(const bf16x8*)(Qw + d0 * 16);
  const int sk = tid >> 3, sc8 = tid & 7, skp = (tid & 255) >> 2, scp = tid & 3;
  const bf16_t* vsrc = KVg + (tok0 + sk) * 1024 + h * 128 + 64 + sc8 * 8;
  const bf16_t* ksrc = KVg + (tok0 + sk) * 1024 + h * 128 + sc8 * 8;
  const bf16_t* psrc = KPE + (tok0 + skp) * 32 + scp * 8;
  const int vst = v_st(sk, sc8 * 8), kst = KSWZ(sk, sc8 * 16), pst = KSWZ(skp, 128 + scp * 16);
  const int vb0 = (int)(unsigned)(uintptr_t)V_lds + v_rd_base(lane);
  struct { bf16x8 v, k, p; } sr_[2];
#define SLOAD(i, k0) do { sr_[i].v = *(const bf16x8*)(vsrc + (size_t)(k0) * 1024); sr_[i].k = *(const bf16x8*)(ksrc + (size_t)(k0) * 1024); sr_[i].p = *(const bf16x8*)(psrc + (size_t)(k0) * 32); } while (0)
#define SWRITE(bb, i) do { *(LAS bf16x8*)(V_lds + (bb) * SHM_V + vst) = sr_[i].v; *(LAS bf16x8*)(K_lds + (bb) * SHM_K + kst) = sr_[i].k; *(LAS bf16x8*)(K_lds + (bb) * SHM_K + pst) = sr_[i].p; } while (0)
#define SWAIT() asm volatile("s_waitcnt vmcnt(3)" ::: "memory")
#define RESC(a) do { if (__any((a) < 1.f)) { _Pragma("unroll") for (int d = 0; d < 2; ++d) _Pragma("unroll") for (int r = 0; r < 16; ++r) o[d][r] *= (a); } } while (0)
  f32x16 pA0, pA1, pB0, pB1; float alA, alB; bf16x8 pa0, pa1, pa2, pa3; constexpr int NT = SEQ / KVBLK;
#define STEP(X0, X1, Y0, Y1, ALX, ALY, T, SET) do { constexpr int sc_ = (T) % 3, sp_ = ((T) + 2) % 3, sn_ = ((T) + 1) % 3; \
    SWAIT(); SWRITE(sn_, SET); if (tb + (T) + 2 < NT) SLOAD(SET, (tb + (T) + 2) * KVBLK); \
    SBAR(); qkt(X0, X1, K_lds + sc_ * SHM_K, qr, negm, r32, hi); \
    finishSM(Y0, Y1, ALY, l_reg, pa0, pa1, pa2, pa3); SBAR(); \
    pv_d0(o, vb0 + sp_ * SHM_V, pa0, pa1, pa2, pa3); partialSM<false>(X0, X1, m_reg, negm, ALX); \
    RESC(ALX); __syncthreads(); } while (0)
  if (__builtin_amdgcn_readfirstlane(wid) >= 4) __builtin_amdgcn_s_setprio(1);
  SLOAD(0, 0); SLOAD(1, KVBLK);
  SWAIT(); SWRITE(0, 0); SLOAD(0, 2 * KVBLK);
  SWAIT(); SWRITE(1, 1); SLOAD(1, 3 * KVBLK);
  __syncthreads();
  qkt(pA0, pA1, K_lds, qr, negm, r32, hi); partialSM<true>(pA0, pA1, m_reg, negm, alA);
  static_assert((NT - 4) % 6 == 0, "tiles 1 .. NT-4 in trips of six, then three more, then the drain");
  int tb = 1;
  for (; tb + 5 < NT - 3; tb += 6) {
    STEP(pB0, pB1, pA0, pA1, alB, alA, 1, 0);
    STEP(pA0, pA1, pB0, pB1, alA, alB, 2, 1);
    STEP(pB0, pB1, pA0, pA1, alB, alA, 3, 0);
    STEP(pA0, pA1, pB0, pB1, alA, alB, 4, 1);
    STEP(pB0, pB1, pA0, pA1, alB, alA, 5, 0);
    STEP(pA0, pA1, pB0, pB1, alA, alB, 6, 1);
  }
  STEP(pB0, pB1, pA0, pA1, alB, alA, 1, 0);
  STEP(pA0, pA1, pB0, pB1, alA, alB, 2, 1);
  { constexpr int sc_ = 3 % 3, sp_ = (3 + 2) % 3;
    SBAR(); qkt(pB0, pB1, K_lds + sc_ * SHM_K, qr, negm, r32, hi);
    finishSM(pA0, pA1, alA, l_reg, pa0, pa1, pa2, pa3); SBAR();
    pv_d0(o, vb0 + sp_ * SHM_V, pa0, pa1, pa2, pa3); partialSM<false>(pB0, pB1, m_reg, negm, alB);
    RESC(alB);
    finishSM(pB0, pB1, alB, l_reg, pa0, pa1, pa2, pa3); SBAR();
    pv_d0(o, vb0 + sc_ * SHM_V, pa0, pa1, pa2, pa3); }
#undef STEP
  __builtin_amdgcn_s_setprio(0);
  const float rl = __builtin_amdgcn_rcpf(l_reg);
  bf16_t* Ow = ATT + (tok0 + qb * 256 + wid * QBLK + r32) * 1024 + 512 + h * 64 + 4 * hi;
#pragma unroll
  for (int d0 = 0; d0 < 2; ++d0)
#pragma unroll
    for (int a = 0; a < 4; ++a) { u32x2 w; w.x = pkbf(o[d0][4 * a] * rl, o[d0][4 * a + 1] * rl); w.y = pkbf(o[d0][4 * a + 2] * rl, o[d0][4 * a + 3] * rl); *(u32x2*)(Ow + d0 * 32 + a * 8) = w; }
  asm volatile("s_waitcnt lgkmcnt(0)" ::: "memory");
  __syncthreads();
#undef SLOAD
#undef SWRITE
#undef SWAIT
#undef RESC
}
#undef KSWZ
#undef SBAR
}

namespace na {
constexpr int NSL = 9, OFF_K = 0, OFF_V = NSL * 8192;
__device__ __forceinline__ void stage_load(int b, int h, int kr, const bf16_t* __restrict__ PA, const bf16_t* __restrict__ VT, int tid, u32x4& kreg, u32x4& vreg) {
  const int t = tid >> 3, ch = tid & 7;
  kreg = *(const u32x4*)(PA + ((size_t)b * SEQ + kr * 64 + t) * NPA + 512 + h * 64 + ch * 8);
  vreg = *(const u32x4*)(VT + (size_t)(h * 64 + t) * M + (size_t)b * SEQ + kr * 64 + ch * 8);
}
__device__ __forceinline__ void stage_write(LAS unsigned char* lds, int kr, int tid, u32x4 kreg, u32x4 vreg) {
  const int t = tid >> 3, ch = tid & 7, slot = kr % NSL;
  *(LAS u32x4*)(lds + OFF_K + slot * 8192 + t * 128 + ((ch ^ (t & 7)) << 4)) = kreg;
  LAS unsigned char* vb = lds + OFF_V + slot * 8192 + t * 128;
  *(LAS u32x2*)(vb + (((2 * ch) ^ (t & 15)) << 3)) = (u32x2){vreg.x, vreg.y};
  *(LAS u32x2*)(vb + (((2 * ch + 1) ^ (t & 15)) << 3)) = (u32x2){vreg.z, vreg.w};
}
__device__ __forceinline__ void unit(int b, int h, int seg, const bf16_t* __restrict__ PA, const bf16_t* __restrict__ VT, bf16_t* __restrict__ ATT, const float* __restrict__ rpb_g, LAS unsigned char* lds, LAS float* rb) {
  int tid = threadIdx.x; asm volatile("" : "+v"(tid));
  const int wid = tid >> 6, lane = tid & 63, l15 = lane & 15, g = lane >> 4;
  const int w4 = wid & 3, half = wid >> 2;
  const int bs = (w4 == 0) ? 0 : (w4 == 1) ? 8 : (w4 == 2) ? 24 : 32;
  const int c = 16 * w4 + l15, cs = min(max(c - 8, 0), 48);
  const int rs = seg * 16;
  constexpr float L2E = 1.4426950408889634f;
  for (int i = tid; i < 465; i += 512) rb[i] = rpb_g[h * 465 + i] * L2E;
  int top = min(max(rs + 1 - 4, 0), 56) + 7;
  { const int lo = min(max(rs - 4, 0), 56);
#pragma unroll 1
    for (int kr = lo; kr <= top; ++kr) { u32x4 kreg, vreg; stage_load(b, h, kr, PA, VT, tid, kreg, vreg); stage_write(lds, kr, tid, kreg, vreg); } }
  bf16x8 qf[2];
  { const size_t tokq = (size_t)b * SEQ + (rs + half) * 64 + c;
#pragma unroll
    for (int ks = 0; ks < 2; ++ks) qf[ks] = *(const bf16x8*)(PA + tokq * NPA + h * 64 + ks * 32 + g * 8); }
  f32x4 bz[16]; int drprev = -9999;
  __syncthreads();
  for (int ra = rs; ra < rs + 16; ra += 2) {
    const int r = ra + half, r0 = min(max(r - 4, 0), 56);
    const bool more = (ra + 2 < rs + 16);
    const int topn = more ? min(max(ra + 3 - 4, 0), 56) + 7 : top;
    u32x4 kreg0 = {0u, 0u, 0u, 0u}, vreg0 = {0u, 0u, 0u, 0u}, kreg1 = {0u, 0u, 0u, 0u}, vreg1 = {0u, 0u, 0u, 0u}; bf16x8 qn[2] = {qf[0], qf[1]};
    if (topn >= top + 1) stage_load(b, h, top + 1, PA, VT, tid, kreg0, vreg0);
    if (topn >= top + 2) stage_load(b, h, top + 2, PA, VT, tid, kreg1, vreg1);
    if (more) { const size_t tokn = (size_t)b * SEQ + (r + 2) * 64 + c;
#pragma unroll
      for (int ks = 0; ks < 2; ++ks) qn[ks] = *(const bf16x8*)(PA + tokn * NPA + h * 64 + ks * 32 + g * 8); }
    f32x4 s[16];
#pragma unroll
    for (int j = 0; j < 8; ++j) { const int slot = (r0 + j) % NSL;
#pragma unroll
      for (int hf = 0; hf < 2; ++hf) { const int tk = bs + 16 * hf + l15; const LAS unsigned char* kb = lds + OFF_K + slot * 8192 + tk * 128;
        const bf16x8 k0 = *(const LAS bf16x8*)(kb + ((g ^ (tk & 7)) << 4)), k1 = *(const LAS bf16x8*)(kb + (((4 + g) ^ (tk & 7)) << 4));
        f32x4 a = {0.f, 0.f, 0.f, 0.f};
        a = __builtin_amdgcn_mfma_f32_16x16x32_bf16(k0, qf[0], a, 0, 0, 0);
        a = __builtin_amdgcn_mfma_f32_16x16x32_bf16(k1, qf[1], a, 0, 0, 0);
        s[j * 2 + hf] = a; } }
    const int dr = r0 - r + 7;
    if (dr != drprev) { drprev = dr;
#pragma unroll
      for (int j = 0; j < 8; ++j)
#pragma unroll
        for (int hf = 0; hf < 2; ++hf)
#pragma unroll
          for (int i = 0; i < 4; ++i) { const int cp = bs + 16 * hf + 4 * g + i; const bool ok = (cp >= cs) && (cp < cs + 16);
            bz[j * 2 + hf][i] = ok ? rb[(dr + j) * 31 + (cp - c + 15)] : -1e30f; } }
    float mx = -1e30f;
#pragma unroll
    for (int q = 0; q < 16; ++q)
#pragma unroll
      for (int i = 0; i < 4; ++i) { const float v = fmaf(s[q][i], 0.125f * L2E, bz[q][i]); s[q][i] = v; mx = fmaxf(mx, v); }
    mx = fmaxf(mx, __shfl_xor(mx, 16)); mx = fmaxf(mx, __shfl_xor(mx, 32));
    float sum = 0.f;
#pragma unroll
    for (int q = 0; q < 16; ++q)
#pragma unroll
      for (int i = 0; i < 4; ++i) { const float p = __builtin_amdgcn_exp2f(s[q][i] - mx); s[q][i] = p; sum += p; }
    sum += __shfl_xor(sum, 16); sum += __shfl_xor(sum, 32);
    const float rl = __builtin_amdgcn_rcpf(sum);
    f32x4 o[4];
#pragma unroll
    for (int db = 0; db < 4; ++db) o[db] = (f32x4){0.f, 0.f, 0.f, 0.f};
#pragma unroll
    for (int j = 0; j < 8; ++j) { const int slot = (r0 + j) % NSL;
      u32x4 pw; pw.x = pkbf(s[2 * j][0], s[2 * j][1]); pw.y = pkbf(s[2 * j][2], s[2 * j][3]); pw.z = pkbf(s[2 * j + 1][0], s[2 * j + 1][1]); pw.w = pkbf(s[2 * j + 1][2], s[2 * j + 1][3]);
      const bf16x8 pb = __builtin_bit_cast(bf16x8, pw);
      const int c8 = (bs >> 2) + g;
#pragma unroll
      for (int db = 0; db < 4; ++db) { const int d = db * 16 + l15; const LAS unsigned char* vb = lds + OFF_V + slot * 8192 + d * 128;
        const u32x2 lo = *(const LAS u32x2*)(vb + ((c8 ^ l15) << 3)), hi2 = *(const LAS u32x2*)(vb + (((c8 + 4) ^ l15) << 3));
        const u32x4 vw = {lo.x, lo.y, hi2.x, hi2.y};
        o[db] = __builtin_amdgcn_mfma_f32_16x16x32_bf16(__builtin_bit_cast(bf16x8, vw), pb, o[db], 0, 0, 0); } }
    bf16_t* op = ATT + ((size_t)b * SEQ + r * 64 + c) * 1024 + h * 64 + 4 * g;
#pragma unroll
    for (int db = 0; db < 4; ++db) { u32x2 w; w.x = pkbf(o[db][0] * rl, o[db][1] * rl); w.y = pkbf(o[db][2] * rl, o[db][3] * rl); *(u32x2*)(op + db * 16) = w; }
    __syncthreads();
    if (topn >= top + 1) stage_write(lds, top + 1, tid, kreg0, vreg0);
    if (topn >= top + 2) stage_write(lds, top + 2, tid, kreg1, vreg1);
    top = topn; qf[0] = qn[0]; qf[1] = qn[1];
    __syncthreads();
  }
}
}

#define XB_TMO      128
#define XB_XCNT(j)  (256  + 64 * (j))
#define XB_XSUB(j)  (1280 + 64 * (j))
#define XB_XGEN(j)  (2304 + 64 * (j))
#define XB_TOP      3328
#define XB_TOPGEN   3392
#define XCD_BAR_WORDS 3456
#define XB_SPIN_CAP (1u << 22)
__device__ __forceinline__ unsigned xb_ld(unsigned* p)              { return __hip_atomic_load(p, __ATOMIC_RELAXED, __HIP_MEMORY_SCOPE_AGENT); }
__device__ __forceinline__ unsigned xb_add(unsigned* p, unsigned v) { return __hip_atomic_fetch_add(p, v, __ATOMIC_RELAXED, __HIP_MEMORY_SCOPE_AGENT); }
__device__ __forceinline__ unsigned xb_xcc_id() { return (unsigned)__builtin_amdgcn_s_getreg((3 << 11) | 20) & 0xFu; }
#define XB_SPIN(cond, bar) do { unsigned _sp = 0; while (cond) { __builtin_amdgcn_s_sleep(1); \
    if ((++_sp & 255u) == 0u) { if (xb_ld(&(bar)[XB_TMO])) break; if (_sp > XB_SPIN_CAP) { atomicAdd(&(bar)[XB_TMO], 1u); break; } } } } while (0)
struct XcdBarrier { unsigned* bar; unsigned x; volatile LAS unsigned* st; };
__device__ __forceinline__ XcdBarrier xcd_barrier_post(unsigned* bar, volatile LAS unsigned* st) {
    XcdBarrier b; b.bar = bar; b.x = xb_xcc_id(); b.st = st;
    if (threadIdx.x == 0) (void)xb_add(&bar[XB_XCNT(b.x)], 1u);
    return b;
}
__device__ __forceinline__ void xcd_barrier_complete(unsigned* bar, unsigned x, unsigned& nloc, unsigned& nx) {
    const unsigned G = gridDim.x * gridDim.y * gridDim.z;
    unsigned sum, cnt, mine, sp = 0u;
    for (;;) {
        sum = 0u; cnt = 0u; mine = 0u;
#pragma unroll
        for (unsigned j = 0; j < 16; ++j) { const unsigned c = xb_ld(&bar[XB_XCNT(j)]); sum += c; cnt += (c > 0u) ? 1u : 0u; mine = (j == x) ? c : mine; }
        if (sum == G) break;
        __builtin_amdgcn_s_sleep(1);
        if ((++sp & 255u) == 0u) { if (xb_ld(&bar[XB_TMO])) break; if (sp > XB_SPIN_CAP) { atomicAdd(&bar[XB_TMO], 1u); break; } }
    }
    nloc = mine > 0u ? mine : 1u; nx = cnt > 0u ? cnt : 1u;
}
__device__ __forceinline__ void xcd_barrier(const XcdBarrier& b) {
    asm volatile("s_waitcnt vmcnt(0)" ::: "memory");
    __syncthreads();
    if (threadIdx.x == 0) {
        unsigned* bar = b.bar;
        __builtin_amdgcn_s_waitcnt(0);
        unsigned nloc = b.st[0], nx = b.st[1];
        if (nloc == 0u) { xcd_barrier_complete(bar, b.x, nloc, nx); b.st[0] = nloc; b.st[1] = nx; }
        const unsigned old = xb_add(&bar[XB_XSUB(b.x)], 1u);
        const unsigned gen = old / nloc;
        if (old + 1u == (gen + 1u) * nloc) {
            __builtin_amdgcn_fence(__ATOMIC_RELEASE, "agent");
            asm volatile("s_waitcnt vmcnt(0)" ::: "memory");
            const unsigned og = xb_add(&bar[XB_TOP], 1u);
            const unsigned tg = og / nx;
            if (og + 1u == (tg + 1u) * nx) xb_add(&bar[XB_TOPGEN], 1u);
            else XB_SPIN(xb_ld(&bar[XB_TOPGEN]) == tg, bar);
            __builtin_amdgcn_fence(__ATOMIC_ACQUIRE, "agent");
            xb_add(&bar[XB_XGEN(b.x)], 1u);
            asm volatile("s_waitcnt vmcnt(0)" ::: "memory");
        } else {
            XB_SPIN(xb_ld(&bar[XB_XGEN(b.x)]) == gen, bar);
            __builtin_amdgcn_fence(__ATOMIC_ACQUIRE, "agent");
            asm volatile("s_waitcnt vmcnt(0)" ::: "memory");
        }
    }
    __syncthreads();
}

struct TrTile { f32x4 v[8]; };
__device__ __forceinline__ void tr_load(const float* __restrict__ W, int ldw, int k0, int n0, int lane, TrTile& t, const float* __restrict__ gain = nullptr) {
#pragma unroll
    for (int i = 0; i < 8; ++i) { t.v[i] = *(const f32x4*)(W + (size_t)(k0 + (lane >> 3) + 8 * i) * ldw + n0 + 4 * (lane & 7)); if (gain) t.v[i] = t.v[i] * gain[k0 + (lane >> 3) + 8 * i]; }
}
__device__ __forceinline__ void tr_store(const TrTile& t, int k0, bf16_t* __restrict__ WT, int ldt, int drow0, LAS float* scr, int lane) {
#pragma unroll
    for (int i = 0; i < 8; ++i) { LAS float* d = scr + ((lane >> 3) + 8 * i) * 33 + 4 * (lane & 7); d[0] = t.v[i][0]; d[1] = t.v[i][1]; d[2] = t.v[i][2]; d[3] = t.v[i][3]; }
    LDS_WAIT(); asm volatile("" ::: "memory");
    const int c = lane & 7;
#pragma unroll
    for (int j = 0; j < 4; ++j) { const int n = (lane >> 3) + 8 * j; const LAS float* s = scr + (8 * c) * 33 + n;
        u32x4 o; o.x = pkbf(s[0 * 33], s[1 * 33]); o.y = pkbf(s[2 * 33], s[3 * 33]); o.z = pkbf(s[4 * 33], s[5 * 33]); o.w = pkbf(s[6 * 33], s[7 * 33]);
        *(u32x4*)(WT + (size_t)(drow0 + n) * ldt + k0 + 8 * c) = o; }
    LDS_WAIT(); asm volatile("" ::: "memory");
}
__device__ __forceinline__ void tr_item(const float* __restrict__ W, int ldw, int k0, int n0, bf16_t* __restrict__ WT, int ldt, int drow0, LAS float* scr, int lane, const float* __restrict__ gain = nullptr) {
    TrTile t; tr_load(W, ldw, k0, n0, lane, t, gain); tr_store(t, k0, WT, ldt, drow0, scr, lane);
}
template <int MODE>
__device__ __forceinline__ void row_pass(const float* xbase, bf16_t* xbbase, float* rsbase, const float* gain, float* obase, int m0, int NGW, int lane) {
    constexpr int R = 4;
    for (int m = m0; m < M; m += R * NGW) {
        f32x4 v[R][4]; float s[R];
#pragma unroll
        for (int r = 0; r < R; ++r) { const int mm = min(m + r * NGW, M - 1);
#pragma unroll
            for (int j = 0; j < 4; ++j) {
                if (MODE == 0) v[r][j] = ((const f32x4*)(xbase + (size_t)mm * DM) + lane)[64 * j];
                else { const u32x2 w = ((const u32x2*)(xbbase + (size_t)mm * DM) + lane)[64 * j]; v[r][j] = (f32x4){bf_lo(w.x), bf_hi(w.x), bf_lo(w.y), bf_hi(w.y)}; } } }
#pragma unroll
        for (int r = 0; r < R; ++r) { const int mm = min(m + r * NGW, M - 1); float a = 0.f;
#pragma unroll
            for (int j = 0; j < 4; ++j) {
                if (MODE == 0) { u32x2 w; w.x = pkbf(v[r][j][0], v[r][j][1]); w.y = pkbf(v[r][j][2], v[r][j][3]); ((u32x2*)(xbbase + (size_t)mm * DM) + lane)[64 * j] = w; }
                a += (v[r][j][0] * v[r][j][0] + v[r][j][1] * v[r][j][1]) + (v[r][j][2] * v[r][j][2] + v[r][j][3] * v[r][j][3]); }
            s[r] = a; }
#pragma unroll
        for (int r = 0; r < R; ++r) { const int mm = min(m + r * NGW, M - 1); const float rstd = 1.f / sqrtf(wave_sum(s[r]) * (1.f / DM) + RMS_EPS);
            if (MODE != 2) { if (lane == 0) rsbase[mm] = rstd; }
            else {
#pragma unroll
                for (int j = 0; j < 4; ++j) ((f32x4*)(obase + (size_t)mm * DM) + lane)[64 * j] = v[r][j] * rstd * ((const f32x4*)gain + lane)[64 * j]; } }
    }
}

__device__ __forceinline__ void topk_item(int b, int e, const float* __restrict__ AFF, int* __restrict__ IDXR, float* __restrict__ VALR, int* __restrict__ SLOT, const float* __restrict__ RS2, float* __restrict__ RSR, LAS unsigned* sh, int tid, int lane, int wave) {
    unsigned u[8];
    const float* src = AFF + ((size_t)(b * SEQ + tid * 8)) * 16 + e;
#pragma unroll
    for (int i = 0; i < 8; ++i) u[i] = __float_as_uint(src[i * 16]);
    LAS unsigned* hist = sh; LAS unsigned* misc = sh + 256;
    unsigned prefix = 0u, mask = 0u, kth = CAP;
    for (int pass = 0; pass < 4; ++pass) {
        const int shift = 24 - 8 * pass;
        if (tid < 256) hist[tid] = 0u;
        __syncthreads();
#pragma unroll
        for (int i = 0; i < 8; ++i) if ((u[i] & mask) == prefix) (void)__hip_atomic_fetch_add(&hist[(u[i] >> shift) & 255u], 1u, __ATOMIC_RELAXED, __HIP_MEMORY_SCOPE_WORKGROUP);
        __syncthreads();
        if (wave == 0) {
            const unsigned h0 = hist[4 * lane], h1 = hist[4 * lane + 1], h2 = hist[4 * lane + 2], h3 = hist[4 * lane + 3];
            const unsigned sl = h0 + h1 + h2 + h3;
            unsigned inc = sl;
#pragma unroll
            for (int o = 1; o < 64; o <<= 1) { const unsigned t = __shfl_down(inc, o); if (lane + o < 64) inc += t; }
            const unsigned exc = inc - sl;
            if (exc < kth && kth <= inc) {
                unsigned cc = exc; int dsel;
                if (cc + h3 >= kth) dsel = 3; else { cc += h3; if (cc + h2 >= kth) dsel = 2; else { cc += h2; if (cc + h1 >= kth) dsel = 1; else { cc += h1; dsel = 0; } } }
                misc[0] = (unsigned)(4 * lane + dsel); misc[1] = kth - cc;
            }
        }
        __syncthreads();
        prefix |= misc[0] << shift; mask |= 255u << shift; kth = misc[1];
    }
    const unsigned T = prefix, need = kth;
    unsigned ng = 0u, neq = 0u;
#pragma unroll
    for (int i = 0; i < 8; ++i) { ng += (u[i] > T) ? 1u : 0u; neq += (u[i] == T) ? 1u : 0u; }
    const unsigned packed = ng | (neq << 16);
    unsigned inc = packed;
#pragma unroll
    for (int o = 1; o < 64; o <<= 1) { const unsigned t = __shfl_up(inc, o); if (lane >= o) inc += t; }
    __syncthreads();
    if (lane == 63) misc[2 + wave] = inc;
    __syncthreads();
    unsigned woff = 0u;
#pragma unroll
    for (int w = 0; w < 8; ++w) if (w < wave) woff += misc[2 + w];
    const unsigned exc = woff + inc - packed;
    unsigned gpos = exc & 0xffffu, epos = exc >> 16;
    const unsigned total_gt = CAP - need;
#pragma unroll
    for (int i = 0; i < 8; ++i) { const int t = tid * 8 + i; int slot = -1;
        if (u[i] > T) slot = (int)(gpos++);
        else if (u[i] == T) { if (epos < need) slot = (int)(total_gt + epos); epos++; }
        SLOT[(size_t)(b * SEQ + t) * 16 + e] = slot;
        if (slot >= 0) { const int rr = (e * NB + b) * CAP + slot; IDXR[rr] = b * SEQ + t; VALR[rr] = __uint_as_float(u[i]); RSR[rr] = RS2[b * SEQ + t]; } }
    __syncthreads();
}

struct Args { const float* in[24]; int ph_lo, ph_hi; };
constexpr int NPH = 14, NPHASES = 1 + NLAYER * NPH;

__global__ void __launch_bounds__(512, 2) fwd(Args a) {
    extern __shared__ __attribute__((aligned(16))) unsigned char lds_raw[];
    LAS unsigned char* lds = (LAS unsigned char*)lds_raw;
    const int G = gridDim.x, bx = blockIdx.x;
    const int vcu = (G % 8 == 0) ? (bx % 8) * (G / 8) + bx / 8 : bx;
    const int NGW = G * 8;
    const __attribute__((address_space(4))) char* kargs = (const __attribute__((address_space(4))) char*)__builtin_amdgcn_kernarg_segment_ptr();
    unsigned char* ws = (unsigned char*)a.in[22];
    volatile LAS unsigned* MISC = (volatile LAS unsigned*)(lds + LDSCTL_OFF);
    for (int u = threadIdx.x; u < (LDS_BYTES - LDSCTL_OFF) / 4; u += 512) ((LAS unsigned*)(lds + LDSCTL_OFF))[u] = 0u;
    __syncthreads();
    const int lo = a.ph_lo, hi = a.ph_hi;
    XcdBarrier bar; bar.bar = (unsigned*)(ws + WS_CTL) + CW_BAR; bar.x = 0; bar.st = nullptr;
    if (hi - lo > 1) bar = xcd_barrier_post((unsigned*)(ws + WS_CTL) + CW_BAR, MISC + 8);
#define IN(k) (lo <= (k) && (k) < hi)
    unsigned long long pt_acc = 0ull, pt_t0 = 0ull;
#define PT_BEGIN(k) do { if (PROBE_T == (k)) { pt_t0 = __builtin_amdgcn_s_memrealtime(); } } while (0)
#define PT_END(k) do { if (PROBE_T == (k)) { pt_acc += __builtin_amdgcn_s_memrealtime() - pt_t0; } } while (0)
#define SEAM(k) do { if (IN(k) && IN((k) + 1)) xcd_barrier(bar); } while (0)

#define ARGP(k) ({ const __attribute__((address_space(4))) char* kq_ = kargs; asm volatile("" : "+s"(kq_)); (const float*)(GAS const float*)(*(const float* const __attribute__((address_space(4)))*)(kq_ + 8 * (k))); })
#define WSP(T, off) ((T*)(wsq + (off)))
#define REP(k) for (int rep_ = 0, nrep_ = ({ int n_ = (PROBE_PH == (k)) ? 2 : 1; asm volatile("" : "+s"(n_)); n_; }); rep_ < nrep_; ++rep_)
#define PHASE_PTRS() int tid = threadIdx.x; asm volatile("" : "+v"(tid)); const int lane = tid & 63, wave = __builtin_amdgcn_readfirstlane(tid >> 6); const int gw = vcu * 8 + wave; (void)lane; (void)gw; \
    unsigned char* wsq = (unsigned char*)ARGP(22); float* X = (float*)ARGP(21); \
    bf16_t* H = (l & 1) ? (bf16_t*)X : WSP(bf16_t, WS_H); bf16_t* Hn = (l & 1) ? WSP(bf16_t, WS_H) : (bf16_t*)X; (void)Hn;     \
    float* RSR = WSP(float, WS_RSR); float* RS1 = WSP(float, WS_RS1); float* RS2 = WSP(float, WS_RS2); float* RS3 = WSP(float, WS_RS3); (void)RSR; (void)RS1; (void)RS2; (void)RS3; float* TAB = WSP(float, WS_TAB); float* AFF = WSP(float, WS_AFF); int* SLOT = WSP(int, WS_SLOT); int* IDXR = WSP(int, WS_IDXR); float* VALR = WSP(float, WS_VALR); \
    bf16_t* KPE = WSP(bf16_t, WS_KPE); bf16_t* PROJA = WSP(bf16_t, R_PROJA); bf16_t* GATES = WSP(bf16_t, R_GATES); bf16_t* VT = WSP(bf16_t, R_VT); bf16_t* Qb = WSP(bf16_t, R_Q); bf16_t* KVb = WSP(bf16_t, R_KV); \
    bf16_t* ATT = WSP(bf16_t, R_ATT); bf16_t* MERGED = WSP(bf16_t, R_MERGED); bf16_t* XG = WSP(bf16_t, R_XG); bf16_t* MOEOUT = WSP(bf16_t, R_MOEOUT); bf16_t* ACT = WSP(bf16_t, R_ACT); \
    bf16_t* W13 = WSP(bf16_t, R_W13); bf16_t* W2T = WSP(bf16_t, R_W2T); bf16_t* PBF = WSP(bf16_t, R_PBF); bf16_t* PE = WSP(bf16_t, R_PE); \
    const bf16_t* wl = (const bf16_t*)(wsq + WS_WSM + (size_t)l * WSM_STRIDE); \
    (void)H; (void)TAB; (void)AFF; (void)SLOT; (void)IDXR; (void)VALR; (void)KPE; (void)PROJA; (void)GATES; (void)VT; (void)Qb; (void)KVb; (void)ATT; (void)MERGED; (void)XG; (void)MOEOUT; (void)ACT; (void)W13; (void)W2T; (void)PBF; (void)PE; (void)wl; (void)X

    PT_BEGIN(100);
    if (IN(0)) {
        const int l = 0; PHASE_PTRS(); const float* x_in = ARGP(0);
        LAS float* scr = (LAS float*)(lds + wave * 16384);
        for (int it = gw; it < 2 * 4064; it += NGW) {
            const int l = it / 4064; int r = it % 4064;
            bf16_t* wl = (bf16_t*)(wsq + WS_WSM + (size_t)l * WSM_STRIDE);
            if (r < 2128) { const int kb = r / 133, nb = r % 133, n0 = nb * 32; bf16_t* dst; int dr;
                if (n0 < 1024) { dst = wl + OFF_WIN; dr = n0; } else if (n0 < 1536) { dst = wl + OFF_WV; dr = n0 - 1024; } else if (n0 < 2208) { dst = wl + OFF_WIN; dr = n0 - 512; } else { dst = wl + OFF_WIN; dr = n0 - 416; }
                tr_item(ARGP(3) + (size_t)l * 1024 * IN_COLS, IN_COLS, kb * 64, n0, dst, 1024, dr, scr, lane, ARGP(2) + l * 1024); continue; } r -= 2128;
            if (r < 144) { tr_item(ARGP(6) + (size_t)l * 384 * 768, 768, (r / 24) * 64, (r % 24) * 32, wl + OFF_WQ, 384, (r % 24) * 32, scr, lane, ARGP(5) + l * 384); continue; } r -= 144;
            if (r < 128) { tr_item(ARGP(8) + (size_t)l * 256 * 1024, 1024, (r / 32) * 64, (r % 32) * 32, wl + OFF_WKV, 256, (r % 32) * 32, scr, lane, ARGP(7) + l * 256); continue; } r -= 128;
            if (r < 256) { tr_item(ARGP(9) + (size_t)l * 512 * 1024, 1024, (r / 32) * 64, (r % 32) * 32, wl + OFF_WNAO, 512, (r % 32) * 32, scr, lane); continue; } r -= 256;
            if (r < 256) { tr_item(ARGP(10) + (size_t)l * 512 * 1024, 1024, (r / 32) * 64, (r % 32) * 32, wl + OFF_WMLAO, 512, (r % 32) * 32, scr, lane); continue; } r -= 256;
            if (r < 512) { tr_item(ARGP(11) + (size_t)l * 1024 * 1024, 1024, (r / 32) * 64, (r % 32) * 32, wl + OFF_WOUT, 1024, (r % 32) * 32, scr, lane); continue; } r -= 512;
            if (r < 512) { tr_item(ARGP(18) + (size_t)l * 1024 * 1024, 1024, (r / 32) * 64, (r % 32) * 32, wl + OFF_WPG, 1024, (r % 32) * 32, scr, lane, ARGP(17) + l * 1024); continue; } r -= 512;
            tr_item(ARGP(19) + (size_t)l * 256 * 1024, 1024, (r / 32) * 64, (r % 32) * 32, wl + OFF_WPW, 256, (r % 32) * 32, scr, lane);
        }
        for (int i = bx * 512 + tid; i < 2 * 96 * 128; i += G * 512) { const int l = i / (96 * 128), r = i % (96 * 128);
            bf16_t* wl = (bf16_t*)(wsq + WS_WSM + (size_t)l * WSM_STRIDE) + OFF_WIN + (size_t)1696 * 1024; *(u32x4*)(wl + (size_t)r * 8) = (u32x4){0u, 0u, 0u, 0u}; }
        if (bx == 0) { const int pos = tid >> 3, j = tid & 7; const float f = exp2f(-(float)j * 1.6609640474436813f); const float rev = (float)pos * f * 0.15915494309189535f; const float fr = rev - floorf(rev);
            TAB[tid * 2] = __builtin_amdgcn_cosf(fr); TAB[tid * 2 + 1] = __builtin_amdgcn_sinf(fr); }
        row_pass<0>(x_in, H, RS1, nullptr, nullptr, gw, NGW, lane);
    }
    SEAM(0);
    PT_END(100);

    for (int l = 0; l < NLAYER; ++l) {
        const int pb = 1 + l * NPH;
        PT_BEGIN(0);
        if (IN(pb + 0)) { PHASE_PTRS();
            REP(0)
            { pg8::Gemm g{H, wl + OFF_WIN, 1024, 1024, 1024}; pg8::StaticOrder S; S.init(M, NINP, G, bx); pg8::EpiInProj E{PROJA, GATES, RS1};
              pg8::gemm_phase(lds, g, S, E); }
            { pg8::Gemm g{wl + OFF_WV, H, 1024, 1024, 1024}; pg8::StaticOrder S; S.init(512, M, G, bx); pg8::EpiPlain E{VT, M, 1 << 20, RS1};
              pg8::gemm_phase(lds, g, S, E); }
        }
        SEAM(pb + 0);
        PT_END(0);
        PT_BEGIN(2);
        if (IN(pb + 2)) { PHASE_PTRS();
            REP(2) {
#define RS_FILL(I, TG, NCOL, COFF) do { pg8::Unit u_; if (S.next(I, u_)) { TG = u_.pm; pg8::panel_rstd_lds<NCOL>(PROJA + (COFF), NPA, u_.pm, rtab + 256 * (I), tid); } } while (0)
            { pg8::StaticOrder S; S.init(M, 768, G, bx); LAS float* rtab = (LAS float*)(lds + LDSCTL_OFF + 1024); int t0 = -1, t1 = -1, t2 = -1, t3 = -1;
              RS_FILL(0, t0, 384, PROJ_QLAT); RS_FILL(1, t1, 384, PROJ_QLAT); RS_FILL(2, t2, 384, PROJ_QLAT); RS_FILL(3, t3, 384, PROJ_QLAT);
              __syncthreads();
              pg8::Gemm g{PROJA + PROJ_QLAT, wl + OFF_WQ, NPA, 384, 384}; pg8::EpiQRope E{Qb, TAB, pg8::RsTab{rtab, t0, t1, t2, t3}};
              pg8::gemm_phase(lds, g, S, E); }
            { pg8::StaticOrder S; S.init(M, 1024, G, G - 1 - bx); LAS float* rtab = (LAS float*)(lds + LDSCTL_OFF + 5120); int t0 = -1, t1 = -1, t2 = -1, t3 = -1;
              RS_FILL(0, t0, 256, PROJ_KVLAT); RS_FILL(1, t1, 256, PROJ_KVLAT); RS_FILL(2, t2, 256, PROJ_KVLAT); RS_FILL(3, t3, 256, PROJ_KVLAT);
              __syncthreads();
              pg8::Gemm g{PROJA + PROJ_KVLAT, wl + OFF_WKV, NPA, 256, 256}; pg8::EpiKV E{KVb, PROJA, KPE, TAB, pg8::RsTab{rtab, t0, t1, t2, t3}};
              pg8::gemm_phase(lds, g, S, E); }
#undef RS_FILL
            }
        }
        SEAM(pb + 2);
        PT_END(2);
        PT_BEGIN(3);
        if (IN(pb + 3)) { PHASE_PTRS();
            REP(100)
            { const int upb = (1024 + G - 1) / G;
              for (int i = 0; i < upb; ++i) { const int grp = vcu >> 4, ngrp = (G + 15) >> 4; const int bh = grp + i * ngrp, qb = vcu & 15; if (bh >= 64) break; mla::unit(bh >> 3, bh & 7, qb, Qb, KVb, KPE, ATT, lds); } }
            { LAS float* rb = (LAS float*)(lds + LDSCTL_OFF + 1024); const float* rpb_g = ARGP(4) + l * 8 * 465;
              REP(101)
              for (int u = vcu; u < 256; u += G) na::unit(u >> 5, (u >> 2) & 7, u & 3, PROJA, VT, ATT, rpb_g, lds, rb); }
        }
        SEAM(pb + 3);
        PT_END(3);
        PT_BEGIN(4);
        if (IN(pb + 4)) { PHASE_PTRS();
            REP(4) {
            { pg8::Gemm g{ATT, wl + OFF_WNAO, 1024, 512, 512}; pg8::StaticOrder S; S.init(M, 1024, G, bx); pg8::EpiGate E{GATES, MERGED, 0};
              pg8::gemm_phase(lds, g, S, E); }
            { pg8::Gemm g{ATT + 512, wl + OFF_WMLAO, 1024, 512, 512}; pg8::StaticOrder S; S.init(M, 1024, G, bx); pg8::EpiGate E{GATES + 1024, MERGED, 1};
              pg8::gemm_phase(lds, g, S, E); }
            }
        }
        SEAM(pb + 4);
        PT_END(4);
        PT_BEGIN(5);
        if (IN(pb + 5)) { PHASE_PTRS();
            pg8::Gemm g{MERGED, wl + OFF_WOUT, 1024, 1024, 1024}; pg8::StaticOrder S; S.init(M, 1024, G, bx); pg8::EpiResid E{H};
            pg8::gemm_phase(lds, g, S, E);
        }
        SEAM(pb + 5);
        PT_END(5);
        PT_BEGIN(6);
        if (IN(pb + 6)) { PHASE_PTRS();
            REP(6) {
            LAS bf16_t* WH = (LAS bf16_t*)lds; LAS bf16_t* WL = (LAS bf16_t*)(lds + 16 * 2064);
            const float* wrg = ARGP(13) + (size_t)l * 1024 * 16; const float* gain = ARGP(12) + l * 1024;
            for (int i = tid; i < 1024 * 16; i += 512) { const int k = i >> 4, e = i & 15; const float w = wrg[i] * gain[k];
                const unsigned hb = pkbf(w, 0.f) & 0xffffu; const float rem = w - __uint_as_float(hb << 16);
                WH[e * 1032 + k] = (bf16_t)hb; WL[e * 1032 + k] = (bf16_t)(pkbf(rem, 0.f) & 0xffffu); }
            __syncthreads();
            const int l15 = lane & 15, g = lane >> 4;
            for (int rb = gw; rb < M / 16; rb += NGW) {
                const bf16_t* xp = H + (size_t)(rb * 16 + l15) * DM + 8 * g;
                const LAS unsigned char* whp = (const LAS unsigned char*)WH + l15 * 2064 + 16 * g; const LAS unsigned char* wlp = (const LAS unsigned char*)WL + l15 * 2064 + 16 * g;
                f32x4 ah = {0.f, 0.f, 0.f, 0.f}, al = {0.f, 0.f, 0.f, 0.f}; float ss = 0.f;
#pragma unroll 1
                for (int s0 = 0; s0 < 32; s0 += 8) {
                    u32x4 xa[8];
#pragma unroll
                    for (int q = 0; q < 8; ++q) xa[q] = *(const u32x4*)(xp + (s0 + q) * 32);
#pragma unroll
                    for (int q = 0; q < 8; ++q) { const u32x4 w = xa[q];
                        ss += bf_lo(w.x) * bf_lo(w.x) + bf_hi(w.x) * bf_hi(w.x) + bf_lo(w.y) * bf_lo(w.y) + bf_hi(w.y) * bf_hi(w.y) + bf_lo(w.z) * bf_lo(w.z) + bf_hi(w.z) * bf_hi(w.z) + bf_lo(w.w) * bf_lo(w.w) + bf_hi(w.w) * bf_hi(w.w);
                        const bf16x8 bh = *(const LAS bf16x8*)(whp + (s0 + q) * 64), bl = *(const LAS bf16x8*)(wlp + (s0 + q) * 64);
                        ah = __builtin_amdgcn_mfma_f32_16x16x32_bf16(__builtin_bit_cast(bf16x8, w), bh, ah, 0, 0, 0);
                        al = __builtin_amdgcn_mfma_f32_16x16x32_bf16(__builtin_bit_cast(bf16x8, w), bl, al, 0, 0, 0); } }
                ss += __shfl_xor(ss, 16); ss += __shfl_xor(ss, 32);
                const float rstd = 1.f / sqrtf(ss * (1.f / DM) + RMS_EPS);
                if (g == 0) RS2[rb * 16 + l15] = rstd;
#pragma unroll
                for (int i = 0; i < 4; ++i) { const float rr = __shfl(rstd, 4 * g + i); const float lg = (ah[i] + al[i]) * rr;
                    float mx = lg;
#pragma unroll
                    for (int o = 1; o < 16; o <<= 1) mx = fmaxf(mx, __shfl_xor(mx, o));
                    const float ex = __expf(lg - mx); float se = ex;
#pragma unroll
                    for (int o = 1; o < 16; o <<= 1) se += __shfl_xor(se, o);
                    AFF[(size_t)(rb * 16 + 4 * g + i) * 16 + l15] = ex / se; }
            }
            __syncthreads();
            }
        }
        SEAM(pb + 6);
        PT_END(6);
        PT_BEGIN(7);
        if (IN(pb + 7)) { PHASE_PTRS();
            REP(7) {
            LAS unsigned* sh = (LAS unsigned*)(lds + 9216);
            for (int it = bx; it < NB * NE; it += G) topk_item(it >> 4, it & 15, AFF, IDXR, VALR, SLOT, RS2, RSR, sh, tid, lane, wave);
            LAS float* scr = (LAS float*)(lds + wave * 16384);
            { const float* w1g = ARGP(14); const float* w3g = ARGP(15); const float* w2g = ARGP(16); const float* gmoe = ARGP(12) + l * 1024;
#define MOE_SRC(it_) ((((it_) >> 13) == 0 ? w1g : ((it_) >> 13) == 1 ? w3g : w2g) + (size_t)(l * 16 + (((it_) & 8191) >> 9)) * 1024 * 1024)
#define MOE_LOAD(T_, it_) tr_load(MOE_SRC(it_), 1024, (((it_) >> 5) & 15) * 64, ((it_) & 31) * 32, lane, T_, ((it_) >> 13) == 2 ? (const float*)nullptr : gmoe)
#define MOE_STORE(T_, it_) do { const int which_ = (it_) >> 13, e_ = ((it_) & 8191) >> 9, k0_ = (((it_) >> 5) & 15) * 64, n0_ = ((it_) & 31) * 32; \
                  if (which_ == 2) tr_store(T_, k0_, W2T + (size_t)e_ * 1024 * 1024, 1024, n0_, scr, lane); \
                  else tr_store(T_, k0_, W13 + (size_t)e_ * 2048 * 1024, 1024, (n0_ >> 7) * 256 + which_ * 128 + (n0_ & 127), scr, lane); } while (0)
              if (G == 256) { const bool tk = bx < 128; const int wv = (bx & 127) * 8 + wave, lo_ = tk ? 0 : 10752, hi_ = tk ? 10752 : 3 * 8192;
                  for (int it = lo_ + wv; it < hi_; it += 1024) { TrTile ta; MOE_LOAD(ta, it); MOE_STORE(ta, it); } }
              else for (int it = gw; it < 3 * 8192; it += NGW) { TrTile ta; MOE_LOAD(ta, it); MOE_STORE(ta, it); }
#undef MOE_LOAD
#undef MOE_STORE
#undef MOE_SRC
            }
            const float* pl = ARGP(1) + (size_t)l * M * 256;
            for (size_t i = (size_t)bx * 512 + tid; i < (size_t)M * 256 / 8; i += (size_t)G * 512) { const f32x4 a0 = *(const f32x4*)(pl + i * 8), a1 = *(const f32x4*)(pl + i * 8 + 4);
                u32x4 w; w.x = pkbf(a0[0], a0[1]); w.y = pkbf(a0[2], a0[3]); w.z = pkbf(a1[0], a1[1]); w.w = pkbf(a1[2], a1[3]); *(u32x4*)(PBF + i * 8) = w; }
            }
        }
        SEAM(pb + 7);
        PT_END(7);
        PT_BEGIN(9);
        if (IN(pb + 9)) { PHASE_PTRS();
            if ((vcu & 1) == 0) { pg8::Gemm g{PBF, wl + OFF_WPW, 256, 256, 256}; pg8::StaticOrder S; S.init(M, 1024, G, bx); pg8::EpiPlain E{PE, 1024, 1 << 20, nullptr};
              pg8::gemm_phase(lds, g, S, E); }
            REP(9) {
            LAS float* tabr = (LAS float*)(lds + LDSCTL_OFF + 1024);
            if (tid < 256 && vcu < MR / 256) { tabr[tid] = RSR[vcu * 256 + tid]; tabr[256 + tid] = VALR[vcu * 256 + tid]; }
            __syncthreads();
            { pg8::Gemm g{H, W13, 1024, 1024, 1024, IDXR}; pg8::PanelOrder S; S.init(3, G, vcu, MR / 256); pg8::EpiSwiGLU E{ACT, RSR, tabr};
#if PROBE_T == 200 || PROBE_T == 201
              unsigned long long ptv[2] = {pt_acc, __builtin_amdgcn_s_memrealtime()};
              pg8::gemm_phase<pg8::EpiSwiGLU, pg8::PanelOrder, true>(lds, g, S, E, ptv); pt_acc = ptv[0]; }
#else
              pg8::gemm_phase<pg8::EpiSwiGLU, pg8::PanelOrder, true>(lds, g, S, E); }
#endif
            __builtin_amdgcn_fence(__ATOMIC_RELEASE, "workgroup"); __syncthreads(); __builtin_amdgcn_fence(__ATOMIC_ACQUIRE, "workgroup");
            { pg8::Gemm g{ACT, W2T, 1024, 1024, 1024}; pg8::PanelOrder S; S.init(2, G, vcu, MR / 256); pg8::EpiMoeDown E{MOEOUT, VALR, tabr + 256};
              pg8::gemm_phase(lds, g, S, E); }
            }
            if ((vcu & 1) == 1) { pg8::Gemm g{PBF, wl + OFF_WPW, 256, 256, 256}; pg8::StaticOrder S; S.init(M, 1024, G, bx); pg8::EpiPlain E{PE, 1024, 1 << 20, nullptr};
              pg8::gemm_phase(lds, g, S, E); }
        }
        SEAM(pb + 9);
        PT_END(9);
        PT_BEGIN(11);
        if (IN(pb + 11)) { PHASE_PTRS();
            int ns0 = (gw < M) ? SLOT[(size_t)gw * 16 + (lane & 15)] : -1, ns1 = (gw + NGW < M) ? SLOT[(size_t)(gw + NGW) * 16 + (lane & 15)] : -1;
            for (int m = gw; m < M; m += 2 * NGW) {
                const int sl0 = ns0, sl1 = ns1; const bool has1 = (m + NGW < M); const int m1 = has1 ? m + NGW : m;
                if (m + 2 * NGW < M) ns0 = SLOT[(size_t)(m + 2 * NGW) * 16 + (lane & 15)];
                if (m + 3 * NGW < M) ns1 = SLOT[(size_t)(m + 3 * NGW) * 16 + (lane & 15)];
                u32x2* xr0 = (u32x2*)(H + (size_t)m * DM) + lane; u32x2* xr1 = (u32x2*)(H + (size_t)m1 * DM) + lane;
                u32x2 xw0[4], xw1[4];
#pragma unroll
                for (int j = 0; j < 4; ++j) { xw0[j] = xr0[64 * j]; xw1[j] = xr1[64 * j]; }
                unsigned bal0 = (unsigned)(__ballot(sl0 >= 0) & 0xffffull), bal1 = has1 ? (unsigned)(__ballot(sl1 >= 0) & 0xffffull) : 0u;
                const int b0 = m >> 12, b1 = m1 >> 12;
                const u32x2* rp0[4]; const u32x2* rp1[4]; float wg0[4], wg1[4];
#pragma unroll
                for (int k = 0; k < 4; ++k) { int e = 0, c = 0; wg0[k] = 0.f;
                    if (bal0) { e = __builtin_ctz(bal0); bal0 &= bal0 - 1u; c = __builtin_amdgcn_readlane(sl0, e); wg0[k] = 1.f; }
                    rp0[k] = (const u32x2*)(MOEOUT + (size_t)((e * NB + b0) * CAP + c) * DM) + lane;
                    e = 0; c = 0; wg1[k] = 0.f;
                    if (bal1) { e = __builtin_ctz(bal1); bal1 &= bal1 - 1u; c = __builtin_amdgcn_readlane(sl1, e); wg1[k] = 1.f; }
                    rp1[k] = (const u32x2*)(MOEOUT + (size_t)((e * NB + b1) * CAP + c) * DM) + lane; }
                u32x2 w0[4][4], w1[4][4];
#pragma unroll
                for (int k = 0; k < 4; ++k)
#pragma unroll
                    for (int j = 0; j < 4; ++j) { w0[k][j] = rp0[k][64 * j]; w1[k][j] = rp1[k][64 * j]; }
                f32x4 v0[4], v1[4];
#pragma unroll
                for (int j = 0; j < 4; ++j) { v0[j] = (f32x4){bf_lo(xw0[j].x), bf_hi(xw0[j].x), bf_lo(xw0[j].y), bf_hi(xw0[j].y)}; v1[j] = (f32x4){bf_lo(xw1[j].x), bf_hi(xw1[j].x), bf_lo(xw1[j].y), bf_hi(xw1[j].y)}; }
#pragma unroll
                for (int k = 0; k < 4; ++k)
#pragma unroll
                    for (int j = 0; j < 4; ++j) {
                        v0[j][0] += wg0[k] * bf_lo(w0[k][j].x); v0[j][1] += wg0[k] * bf_hi(w0[k][j].x); v0[j][2] += wg0[k] * bf_lo(w0[k][j].y); v0[j][3] += wg0[k] * bf_hi(w0[k][j].y);
                        v1[j][0] += wg1[k] * bf_lo(w1[k][j].x); v1[j][1] += wg1[k] * bf_hi(w1[k][j].x); v1[j][2] += wg1[k] * bf_lo(w1[k][j].y); v1[j][3] += wg1[k] * bf_hi(w1[k][j].y); }
#pragma unroll 1
                while (bal0) { const int e = __builtin_ctz(bal0); bal0 &= bal0 - 1u; const int c = __builtin_amdgcn_readlane(sl0, e);
                    const u32x2* mr = (const u32x2*)(MOEOUT + (size_t)((e * NB + b0) * CAP + c) * DM) + lane;
#pragma unroll
                    for (int j = 0; j < 4; ++j) { const u32x2 w = mr[64 * j]; v0[j][0] += bf_lo(w.x); v0[j][1] += bf_hi(w.x); v0[j][2] += bf_lo(w.y); v0[j][3] += bf_hi(w.y); } }
#pragma unroll 1
                while (bal1) { const int e = __builtin_ctz(bal1); bal1 &= bal1 - 1u; const int c = __builtin_amdgcn_readlane(sl1, e);
                    const u32x2* mr = (const u32x2*)(MOEOUT + (size_t)((e * NB + b1) * CAP + c) * DM) + lane;
#pragma unroll
                    for (int j = 0; j < 4; ++j) { const u32x2 w = mr[64 * j]; v1[j][0] += bf_lo(w.x); v1[j][1] += bf_hi(w.x); v1[j][2] += bf_lo(w.y); v1[j][3] += bf_hi(w.y); } }
                float s0 = 0.f, s1 = 0.f;
#pragma unroll
                for (int j = 0; j < 4; ++j) { u32x2 w; w.x = pkbf(v0[j][0], v0[j][1]); w.y = pkbf(v0[j][2], v0[j][3]); xr0[64 * j] = w;
                    const f32x4 r = (f32x4){bf_lo(w.x), bf_hi(w.x), bf_lo(w.y), bf_hi(w.y)}; s0 += (r[0] * r[0] + r[1] * r[1]) + (r[2] * r[2] + r[3] * r[3]); }
                if (has1) {
#pragma unroll
                    for (int j = 0; j < 4; ++j) { u32x2 w; w.x = pkbf(v1[j][0], v1[j][1]); w.y = pkbf(v1[j][2], v1[j][3]); xr1[64 * j] = w;
                        const f32x4 r = (f32x4){bf_lo(w.x), bf_hi(w.x), bf_lo(w.y), bf_hi(w.y)}; s1 += (r[0] * r[0] + r[1] * r[1]) + (r[2] * r[2] + r[3] * r[3]); } }
                const float rs0 = 1.f / sqrtf(wave_sum(s0) * (1.f / DM) + RMS_EPS), rs1 = 1.f / sqrtf(wave_sum(s1) * (1.f / DM) + RMS_EPS);
                if (lane == 0) { RS3[m] = rs0; if (has1) RS3[m1] = rs1; }
            }
        }
        SEAM(pb + 11);
        PT_END(11);
        PT_BEGIN(12);
        if (IN(pb + 12)) { PHASE_PTRS();
            pg8::Gemm g{H, wl + OFF_WPG, 1024, 1024, 1024}; pg8::StaticOrder S; S.init(M, 1024, G, bx); pg8::EpiPle E{H, Hn, PE, RS3};
            pg8::gemm_phase(lds, g, S, E);
        }
        SEAM(pb + 12);
        PT_END(12);
        PT_BEGIN(13);
        if (IN(pb + 13)) { PHASE_PTRS();
            if (l + 1 < NLAYER) row_pass<1>(nullptr, Hn, RS1, nullptr, nullptr, gw, NGW, lane);
            else row_pass<2>(nullptr, Hn, nullptr, ARGP(20), X, gw, NGW, lane);
        }
        if (l + 1 < NLAYER) SEAM(pb + 13);
        PT_END(13);
    }
    if (PROBE_T >= 0 && blockIdx.x == 0) { const unsigned long long t1 = __builtin_amdgcn_s_memrealtime() + (unsigned long long)PROBE_MULT * pt_acc; while (__builtin_amdgcn_s_memrealtime() < t1) __builtin_amdgcn_s_sleep(32); }
#undef IN
#undef SEAM
}

extern "C" void kernel_launch(void* const* d_in, const int* in_sizes, int n_in, void* d_out, int out_size, void* d_ws, size_t ws_size, hipStream_t stream) {
    static int grid = 0;
    if (grid == 0) {
        if (n_in != 21 || out_size != M * DM || ws_size < WS_END) { fprintf(stderr, "kernel_launch: unexpected shapes (n_in %d out %d ws %zu, need ws >= %zu)\n", n_in, out_size, ws_size, (size_t)WS_END); grid = -1; return; }
        int dev = 0, cus = 0, per_cu = 0;
        if (hipGetDevice(&dev) != hipSuccess || hipDeviceGetAttribute(&cus, hipDeviceAttributeMultiprocessorCount, dev) != hipSuccess) { grid = -1; return; }
        if (hipFuncSetAttribute((const void*)fwd, hipFuncAttributeMaxDynamicSharedMemorySize, LDS_BYTES) != hipSuccess) { fprintf(stderr, "kernel_launch: hipFuncSetAttribute failed\n"); grid = -1; return; }
        if (hipOccupancyMaxActiveBlocksPerMultiprocessor(&per_cu, (const void*)fwd, 512, LDS_BYTES) != hipSuccess || per_cu < 1) { fprintf(stderr, "kernel_launch: occupancy query reports %d blocks per CU\n", per_cu); }
        (void)hipGetLastError();
        grid = cus;
    }
    if (grid < 0) return;
    (void)hipMemsetAsync((char*)d_ws + WS_CTL, 0, CTL_ZERO_BYTES, stream);
    Args a{};
    for (int i = 0; i < 21; ++i) a.in[i] = (const float*)d_in[i];
    a.in[21] = (const float*)d_out; a.in[22] = (const float*)d_ws; a.in[23] = nullptr;
#if MK_ONE_LAUNCH
    a.ph_lo = 0; a.ph_hi = NPHASES;
    hipLaunchKernelGGL(fwd, dim3(grid), dim3(512), LDS_BYTES, stream, a);
#else
    for (int p = 0; p < NPHASES; ++p) { a.ph_lo = p; a.ph_hi = p + 1; hipLaunchKernelGGL(fwd, dim3(grid), dim3(512), LDS_BYTES, stream, a); }
#endif
}
```

```cpp
#include <hip/hip_runtime.h>
#include <cstdio>
#include <cstdint>

#ifndef PROBE_PH
#define PROBE_PH -1
#endif
#ifndef PROBE_T
#define PROBE_T -1
#endif
#define PROBE_MULT 4
#ifndef MK_ONE_LAUNCH
#define MK_ONE_LAUNCH 1
#endif

#define GAS __attribute__((address_space(1)))
#define LAS __attribute__((address_space(3)))
typedef unsigned short bf16_t;
typedef short bf16x8 __attribute__((ext_vector_type(8)));
typedef short s16x4 __attribute__((ext_vector_type(4)));
typedef float f32x2 __attribute__((ext_vector_type(2)));
typedef float f32x4 __attribute__((ext_vector_type(4)));
typedef float f32x16 __attribute__((ext_vector_type(16)));
typedef unsigned u32x2 __attribute__((ext_vector_type(2)));
typedef unsigned u32x4 __attribute__((ext_vector_type(4)));
typedef __bf16 bf16x2_t __attribute__((ext_vector_type(2)));

constexpr int NB = 8, SEQ = 4096, DM = 1024, M = NB * SEQ, NLAYER = 2;
constexpr int IN_COLS = 4256, NPA = 1792, NGATE = 2048, NINP = 3840;
constexpr int NE = 16, CAP = 512, MR = NB * NE * CAP;
constexpr float RMS_EPS = 1e-6f;
constexpr int PROJ_QLAT = 1024, PROJ_KVLAT = 1408, PROJ_KROPE = 1664;

constexpr size_t MiB = 1u << 20;
constexpr size_t WS_CTL = 0, CTL_ZERO_BYTES = 64 * 1024;
constexpr size_t WS_TAB = 1 * MiB;
constexpr size_t WS_RSR = 1 * MiB + 256 * 1024, WS_RS1 = 1 * MiB + 512 * 1024, WS_RS2 = 1 * MiB + 640 * 1024, WS_RS3 = 1 * MiB + 768 * 1024;
constexpr size_t WS_AFF = 2 * MiB;
constexpr size_t WS_SLOT = 4 * MiB;
constexpr size_t WS_IDXR = 6 * MiB;
constexpr size_t WS_VALR = 6 * MiB + 512 * 1024;
constexpr size_t WS_KPE = 7 * MiB;
constexpr size_t WS_WSM = 9 * MiB;
constexpr size_t WSM_STRIDE = 17 * MiB;
constexpr size_t WS_H = 44 * MiB;
constexpr size_t WS_R1 = 108 * MiB;
constexpr size_t R_PROJA = WS_R1 + 0, R_GATES = WS_R1 + 112 * MiB, R_VT = WS_R1 + 240 * MiB, R_Q = WS_R1 + 272 * MiB, R_KV = WS_R1 + 320 * MiB, R_ATT = WS_R1 + 384 * MiB;
constexpr size_t R_MERGED = WS_R1 + 0;
constexpr size_t R_XG = WS_R1 + 0, R_MOEOUT = WS_R1 + 0, R_ACT = WS_R1 + 128 * MiB, R_W13 = WS_R1 + 256 * MiB, R_W2T = WS_R1 + 320 * MiB, R_PBF = WS_R1 + 352 * MiB, R_PE = WS_R1 + 368 * MiB;
constexpr size_t WS_END = WS_R1 + 448 * MiB;
constexpr size_t OFF_WIN = 0, OFF_WV = 3932160, OFF_WQ = 4456448, OFF_WKV = 4751360, OFF_WNAO = 5013504, OFF_WMLAO = 5537792, OFF_WOUT = 6062080, OFF_WPG = 7110656, OFF_WPW = 8159232;
static_assert(8421376 * 2 <= WSM_STRIDE, "small weights fit");
constexpr int CW_BAR = 1024;

constexpr int RING_BYTES = 131072, LDSCTL_OFF = 147456, LDS_BYTES = 163840;

#define LDS_WAIT() asm volatile("s_waitcnt lgkmcnt(0)" ::: "memory")
__device__ __forceinline__ unsigned pkbf(float lo, float hi) { f32x2 v = {lo, hi}; bf16x2_t b = __builtin_convertvector(v, bf16x2_t); return __builtin_bit_cast(unsigned, b); }
__device__ __forceinline__ float bf_lo(unsigned w) { return __uint_as_float(w << 16); }
__device__ __forceinline__ float bf_hi(unsigned w) { return __uint_as_float(w & 0xffff0000u); }
__device__ __forceinline__ float bf1(bf16_t h) { return __uint_as_float(((unsigned)h) << 16); }
__device__ __forceinline__ float sigmoidf_(float x) { return __builtin_amdgcn_rcpf(1.f + __expf(-x)); }
__device__ __forceinline__ float wave_sum(float v) {
#pragma unroll
    for (int o = 1; o < 64; o <<= 1) v += __shfl_xor(v, o);
    return v;
}

namespace pg8 {
constexpr int BM = 256, BK = 64, HALF = 128, HTB = HALF * BK * 2, STAGE_BYTES = 8 * HTB, NXCD = 8, WGM = 8;
__host__ __device__ __forceinline__ int lds_byte(int r, int c) { const int st = (r >> 4) * 2 + (c >> 5), rr = r & 15, cc = c & 31, ob = rr * 64 + cc * 2; return st * 1024 + (ob ^ (((ob >> 9) & 1) << 5)); }
__host__ __device__ __forceinline__ void stage_rc(int b, int& R, int& C) { const int st = b / 1024, sb = b % 1024, swz = sb ^ (((sb >> 9) & 1) << 5); R = (st >> 1) * 16 + swz / 64; C = (st & 1) * 32 + (swz % 64) / 2; }
__host__ __device__ __forceinline__ int perm32(int rho) { const int n = rho >> 4, i = rho & 15; return 8 * (i >> 2) + 4 * n + (i & 3); }

struct Unit { int pm, pn, aux; };
struct Gemm { const bf16_t* A; const bf16_t* Bt; int lda, ldb, K; const int* rowidx; };

struct StaticOrder {
    int nM, nN, nwg, G, c;
    __host__ __device__ __forceinline__ void init(int M_, int N_, int G_, int c_) { nM = M_ / BM; nN = N_ / BM; nwg = nM * nN; G = G_; c = c_; }
    __host__ __device__ __forceinline__ bool next(int i, Unit& u) const { return unit_of((long)i * G + c, u); }
    __host__ __device__ __forceinline__ bool unit_of(long L, Unit& u) const {
        if (L < 0 || L >= nwg) return false;
        int wgid = (int)L; { const int q = nwg / NXCD, r = nwg % NXCD, xcd = wgid % NXCD, off = wgid / NXCD; wgid = (xcd < r ? xcd * (q + 1) : r * (q + 1) + (xcd - r) * q) + off; }
        const int nig = WGM * nN, gid = wgid / nig, fm = gid * WGM, gsz = (nM - fm) < WGM ? (nM - fm) : WGM;
        u.pm = fm + ((wgid % nig) % gsz); u.pn = (wgid % nig) / gsz; u.aux = 0; return true;
    }
};
struct PickOrder {
    StaticOrder S; int L0, stride, cnt;
    __device__ __forceinline__ bool next(int i, Unit& u) const { if (i >= cnt) return false; int Lq = L0 + i * stride; asm volatile("" : "+s"(Lq)); return S.unit_of(Lq, u); }
};
struct G1Order {
    int c;
    __device__ __forceinline__ static bool type_a(int c_) { return ((c_ >> 3) & 1) == 0; }
    __device__ __forceinline__ static int idx(int c_) { return (c_ >> 4) * 8 + (c_ & 7); }
    __device__ __forceinline__ bool next(int i, Unit& u) const {
        int L; u.aux = 0;
        if (type_a(c)) { if (i < 3) { u.pm = idx(c); u.pn = 4 + i; return true; } if (i >= 6) return false; L = (i - 3) * 256 + c; }
        else { if (i < 3) L = i * 256 + c; else if (i < 9) L = 768 + (i - 3) * 128 + idx(c); else return false; }
        constexpr int nwg = 1536, nN = 12; const int xcd = L % NXCD, off = L / NXCD, wgid = xcd * (nwg / NXCD) + off;
        const int nig = WGM * nN, gid = wgid / nig, rem = wgid % nig, pnp = rem / WGM;
        u.pm = gid * WGM + rem % WGM; u.pn = pnp < 4 ? pnp : pnp + 3; return true;
    }
};
struct G1vTOrder {
    G1Order A; StaticOrder V;
    __device__ __forceinline__ bool next(int i, Unit& u) const { const int n1 = G1Order::type_a(A.c) ? 6 : 9; const bool isA = i < n1;
        Unit a, v; const bool okA = A.next(isA ? i : 0, a), okV = V.next(0, v);
        u.pm = isA ? a.pm : v.pm; u.pn = isA ? a.pn : v.pn; u.aux = isA ? 0 : 1;
        return isA ? okA : (i == n1 && okV); }
};
struct SliceOrder {
    int pm, pn0, cnt;
    __device__ __forceinline__ bool next(int i, Unit& u) const { if (i >= cnt) return false; int pmq = pm; asm volatile("" : "+s"(pmq)); u.pm = pmq; u.pn = pn0 + i; u.aux = i; return true; }
};
struct MoeOrder {
    StaticOrder S; int shift;
    __device__ __forceinline__ void init(int M_, int N_, int G_, int c_, int shift_) { S.init(M_, N_, G_, c_); shift = shift_; }
    __device__ __forceinline__ bool next(int i, Unit& u) const { if (!S.next(i, u)) return false; u.pn += (u.pm >> 4) << shift; return true; }
};
struct PanelOrder {
    int sh, G, c, npan;
    __device__ __forceinline__ void init(int sh_, int G_, int c_, int npan_) { sh = sh_; G = G_; c = c_; npan = npan_; }
    __device__ __forceinline__ bool next(int i, Unit& u) const { const int pm = c + (i >> sh) * G; if (pm >= npan) return false; u.pm = pm; u.pn = ((pm >> 4) << sh) + (i & ((1 << sh) - 1)); u.aux = i >> sh; return true; }
};

typedef f32x4 Acc[2][2][4][2];

template <int NC>
__device__ __forceinline__ void panel_rstd_lds(const bf16_t* __restrict__ A, int lda, int pm, LAS float* tab, int tid) {
    const int row = tid >> 1, half = tid & 1;
    const u32x4* p = (const u32x4*)(A + (size_t)(pm * BM + row) * lda + half * (NC / 2)); float s = 0.f;
#pragma unroll
    for (int i = 0; i < NC / 16; ++i) { const u32x4 w = p[i];
        s += bf_lo(w.x) * bf_lo(w.x) + bf_hi(w.x) * bf_hi(w.x) + bf_lo(w.y) * bf_lo(w.y) + bf_hi(w.y) * bf_hi(w.y) + bf_lo(w.z) * bf_lo(w.z) + bf_hi(w.z) * bf_hi(w.z) + bf_lo(w.w) * bf_lo(w.w) + bf_hi(w.w) * bf_hi(w.w); }
    s += __shfl_xor(s, 1);
    int rowq = row; asm volatile("" : "+v"(rowq));
    if (half == 0) tab[rowq] = 1.f / sqrtf(s * (1.f / NC) + RMS_EPS);
}
__device__ __forceinline__ float sumsq8(const u32x4 w) { return bf_lo(w.x) * bf_lo(w.x) + bf_hi(w.x) * bf_hi(w.x) + bf_lo(w.y) * bf_lo(w.y) + bf_hi(w.y) * bf_hi(w.y) + bf_lo(w.z) * bf_lo(w.z) + bf_hi(w.z) * bf_hi(w.z) + bf_lo(w.w) * bf_lo(w.w) + bf_hi(w.w) * bf_hi(w.w); }
template <int NC1, int NC2>
__device__ __forceinline__ void panel_rstd2_lds(const bf16_t* __restrict__ A, int lda, int c1, int c2, int pm, LAS float* tab1, LAS float* tab2, int tid) {
    const int row = tid >> 1, half = tid & 1;
    const u32x4* p1 = (const u32x4*)(A + (size_t)(pm * BM + row) * lda + c1 + half * (NC1 / 2)); const u32x4* p2 = (const u32x4*)(A + (size_t)(pm * BM + row) * lda + c2 + half * (NC2 / 2));
    u32x4 w1[NC1 / 16], w2[NC2 / 16];
#pragma unroll
    for (int i = 0; i < NC1 / 16; ++i) w1[i] = p1[i];
#pragma unroll
    for (int i = 0; i < NC2 / 16; ++i) w2[i] = p2[i];
    float s1 = 0.f, s2 = 0.f;
#pragma unroll
    for (int i = 0; i < NC1 / 16; ++i) s1 += sumsq8(w1[i]);
#pragma unroll
    for (int i = 0; i < NC2 / 16; ++i) s2 += sumsq8(w2[i]);
    s1 += __shfl_xor(s1, 1); s2 += __shfl_xor(s2, 1);
    int rowq = row; asm volatile("" : "+v"(rowq));
    if (half == 0) { tab1[rowq] = 1.f / sqrtf(s1 * (1.f / NC1) + RMS_EPS); tab2[rowq] = 1.f / sqrtf(s2 * (1.f / NC2) + RMS_EPS); }
}
struct RsTab { const LAS float* tab; int t0, t1, t2, t3;
    __device__ __forceinline__ const LAS float* find(int pm) const { return tab + ((pm == t0) ? 0 : (pm == t1) ? 256 : (pm == t2) ? 512 : 768); } };
struct EpiPlain {
    bf16_t* O; int ldc; int pn_mod; const float* cs;
    __device__ __forceinline__ void operator()(const Acc& acc, const Unit& u, int wr, int wc, int fr, int fq) const {
        const int col0 = (u.pn % pn_mod) * BM + wc * 32 + 8 * fq, row0 = u.pm * BM + wr * 64 + fr;
        f32x4 c0[2] = {{1.f, 1.f, 1.f, 1.f}, {1.f, 1.f, 1.f, 1.f}}, c1[2] = {{1.f, 1.f, 1.f, 1.f}, {1.f, 1.f, 1.f, 1.f}};
        if (cs) {
#pragma unroll
            for (int bj = 0; bj < 2; ++bj) { c0[bj] = *(const f32x4*)(cs + col0 + bj * HALF); c1[bj] = *(const f32x4*)(cs + col0 + bj * HALF + 4); } }
#pragma unroll
        for (int ai = 0; ai < 2; ++ai)
#pragma unroll
            for (int m = 0; m < 4; ++m) { bf16_t* rowp = O + (size_t)(row0 + ai * HALF + m * 16) * ldc + col0;
#pragma unroll
                for (int bj = 0; bj < 2; ++bj) { const f32x4 v0 = acc[ai][bj][m][0] * c0[bj], v1 = acc[ai][bj][m][1] * c1[bj];
                    u32x4 w; w.x = pkbf(v0[0], v0[1]); w.y = pkbf(v0[2], v0[3]); w.z = pkbf(v1[0], v1[1]); w.w = pkbf(v1[2], v1[3]);
                    *(u32x4*)(rowp + bj * HALF) = w; } }
    }
};
__device__ __forceinline__ unsigned pk_u8x4(float a, float b, float c, float d) { unsigned w = 0u;
    w = __builtin_amdgcn_cvt_pk_u8_f32(__builtin_rintf(a * 255.f), 0, w); w = __builtin_amdgcn_cvt_pk_u8_f32(__builtin_rintf(b * 255.f), 1, w);
    w = __builtin_amdgcn_cvt_pk_u8_f32(__builtin_rintf(c * 255.f), 2, w); w = __builtin_amdgcn_cvt_pk_u8_f32(__builtin_rintf(d * 255.f), 3, w); return w; }
__device__ __forceinline__ unsigned pk_gate_u8x4(float x0, float x1, float x2, float x3, float rsn) { unsigned w = 0u; constexpr float c = 1.f / 255.f;
    w = __builtin_amdgcn_cvt_pk_u8_f32(__builtin_rintf(__builtin_amdgcn_rcpf(__builtin_fmaf(__builtin_amdgcn_exp2f(x0 * rsn), c, c))), 0, w);
    w = __builtin_amdgcn_cvt_pk_u8_f32(__builtin_rintf(__builtin_amdgcn_rcpf(__builtin_fmaf(__builtin_amdgcn_exp2f(x1 * rsn), c, c))), 1, w);
    w = __builtin_amdgcn_cvt_pk_u8_f32(__builtin_rintf(__builtin_amdgcn_rcpf(__builtin_fmaf(__builtin_amdgcn_exp2f(x2 * rsn), c, c))), 2, w);
    w = __builtin_amdgcn_cvt_pk_u8_f32(__builtin_rintf(__builtin_amdgcn_rcpf(__builtin_fmaf(__builtin_amdgcn_exp2f(x3 * rsn), c, c))), 3, w); return w; }
__device__ __forceinline__ float ub8(unsigned w, int k) { return (float)((w >> (8 * k)) & 0xffu); }
struct EpiInProj {
    bf16_t* PA; bf16_t* GT; const float* rs;
    __device__ __forceinline__ void operator()(const Acc& acc, const Unit& u, int wr, int wc, int fr, int fq) const {
        const bool gate = u.pn >= 7;
        const int col0 = (gate ? (u.pn - 7) : u.pn) * BM + wc * 32 + 8 * fq, row0 = u.pm * BM + wr * 64 + fr;
        float rsl[8];
#pragma unroll
        for (int k = 0; k < 8; ++k) rsl[k] = rs[row0 + (k >> 2) * HALF + (k & 3) * 16];
        if (gate) { unsigned char* G8 = (unsigned char*)GT;
#pragma unroll
            for (int ai = 0; ai < 2; ++ai)
#pragma unroll
                for (int m = 0; m < 4; ++m) { unsigned char* rowp = G8 + (size_t)(row0 + ai * HALF + m * 16) * NGATE + col0; const float rsv = rsl[ai * 4 + m];
#pragma unroll
                    for (int bj = 0; bj < 2; ++bj) { const f32x4 v0 = acc[ai][bj][m][0], v1 = acc[ai][bj][m][1]; const float rsn = rsv * -1.4426950408889634f;
                        u32x2 w; w.x = pk_gate_u8x4(v0[0], v0[1], v0[2], v0[3], rsn); w.y = pk_gate_u8x4(v1[0], v1[1], v1[2], v1[3], rsn);
                        *(u32x2*)(rowp + bj * HALF) = w; } }
        } else {
#pragma unroll
            for (int ai = 0; ai < 2; ++ai)
#pragma unroll
                for (int m = 0; m < 4; ++m) { bf16_t* rowp = PA + (size_t)(row0 + ai * HALF + m * 16) * NPA + col0; const float rsv = rsl[ai * 4 + m];
#pragma unroll
                    for (int bj = 0; bj < 2; ++bj) { const f32x4 v0 = acc[ai][bj][m][0] * rsv, v1 = acc[ai][bj][m][1] * rsv;
                        u32x4 w; w.x = pkbf(v0[0], v0[1]); w.y = pkbf(v0[2], v0[3]); w.z = pkbf(v1[0], v1[1]); w.w = pkbf(v1[2], v1[3]);
                        *(u32x4*)(rowp + bj * HALF) = w; } }
        }
    }
};
struct EpiQRope {
    bf16_t* O; const LAS float* tab; RsTab rt;
    __device__ __forceinline__ void operator()(const Acc& acc, const Unit& u, int wr, int wc, int fr, int fq) const {
        const int row0 = u.pm * BM + wr * 64 + fr;
        constexpr float QC = 0.10206207261596575f * 1.4426950408889634f;
        float rs[8]; { const LAS float* rp = rt.find(u.pm) + wr * 64 + fr;
#pragma unroll
            for (int k = 0; k < 8; ++k) rs[k] = rp[(k >> 2) * HALF + (k & 3) * 16] * QC; }
#pragma unroll
        for (int bj = 0; bj < 2; ++bj) {
            const int col = u.pn * BM + bj * HALF + wc * 32 + 8 * fq;
            const int dl = col % 96;
            const bool pe = __builtin_amdgcn_readfirstlane((int)(dl >= 64)) != 0; const int grp = (dl - 64) >> 4;
#pragma unroll
            for (int ai = 0; ai < 2; ++ai)
#pragma unroll
                for (int m = 0; m < 4; ++m) { const int row = row0 + ai * HALF + m * 16;
                    const f32x4 v0 = acc[ai][bj][m][0] * rs[ai * 4 + m], v1 = acc[ai][bj][m][1] * rs[ai * 4 + m];
                    float x[8] = {v0[0], v0[1], v0[2], v0[3], v1[0], v1[1], v1[2], v1[3]};
                    if (pe) { float y[8];
#pragma unroll
                        for (int q = 0; q < 8; ++q) y[q] = __shfl_xor(x[q], 16);
                        const int s = row & (SEQ - 1); const int pos = grp ? (s & 63) : (s >> 6);
                        const LAS f32x4* tp = (const LAS f32x4*)(tab + pos * 16);
                        const f32x4 t0 = tp[0], t1 = tp[1], t2 = tp[2], t3 = tp[3];
                        const float cs[8] = {t0[0], t0[2], t1[0], t1[2], t2[0], t2[2], t3[0], t3[2]}, sn[8] = {t0[1], t0[3], t1[1], t1[3], t2[1], t2[3], t3[1], t3[3]};
                        const float sg = (fq & 1) ? 1.f : -1.f;
#pragma unroll
                        for (int q = 0; q < 8; ++q) x[q] = x[q] * cs[q] + sg * y[q] * sn[q]; }
                    u32x4 w; w.x = pkbf(x[0], x[1]); w.y = pkbf(x[2], x[3]); w.z = pkbf(x[4], x[5]); w.w = pkbf(x[6], x[7]);
                    *(u32x4*)(O + (size_t)row * 768 + col) = w; } }
    }
};
struct EpiKV {
    bf16_t* O; const bf16_t* PA; bf16_t* KPE; const LAS float* tab; RsTab rt;
    __device__ __forceinline__ void operator()(const Acc& acc, const Unit& u, int wr, int wc, int fr, int fq) const {
        const int col0 = u.pn * BM + wc * 32 + 8 * fq, row0 = u.pm * BM + wr * 64 + fr;
        float rs[8]; { const LAS float* rp = rt.find(u.pm) + wr * 64 + fr;
#pragma unroll
            for (int k = 0; k < 8; ++k) rs[k] = rp[(k >> 2) * HALF + (k & 3) * 16]; }
        if (u.pn == 0) {
            const int t = ((wr * 4 + wc) << 6) | (fq << 4) | fr, row = u.pm * BM + (t >> 1), grp = t & 1;
            const u32x4* src = (const u32x4*)(PA + (size_t)row * NPA + PROJ_KROPE + 16 * grp); const u32x4 a = src[0], b = src[1];
            const int sq = row & (SEQ - 1), pos = grp ? (sq & 63) : (sq >> 6);
            const LAS f32x4* tp = (const LAS f32x4*)(tab + pos * 16); const f32x4 t0 = tp[0], t1 = tp[1], t2 = tp[2], t3 = tp[3];
            const float cs[8] = {t0[0], t0[2], t1[0], t1[2], t2[0], t2[2], t3[0], t3[2]}, sn[8] = {t0[1], t0[3], t1[1], t1[3], t2[1], t2[3], t3[1], t3[3]};
            const float x1[8] = {bf_lo(a.x), bf_hi(a.x), bf_lo(a.y), bf_hi(a.y), bf_lo(a.z), bf_hi(a.z), bf_lo(a.w), bf_hi(a.w)}, x2[8] = {bf_lo(b.x), bf_hi(b.x), bf_lo(b.y), bf_hi(b.y), bf_lo(b.z), bf_hi(b.z), bf_lo(b.w), bf_hi(b.w)};
            float o1[8], o2[8];
#pragma unroll
            for (int q = 0; q < 8; ++q) { o1[q] = x1[q] * cs[q] - x2[q] * sn[q]; o2[q] = x2[q] * cs[q] + x1[q] * sn[q]; }
            u32x4 w0, w1; w0.x = pkbf(o1[0], o1[1]); w0.y = pkbf(o1[2], o1[3]); w0.z = pkbf(o1[4], o1[5]); w0.w = pkbf(o1[6], o1[7]); w1.x = pkbf(o2[0], o2[1]); w1.y = pkbf(o2[2], o2[3]); w1.z = pkbf(o2[4], o2[5]); w1.w = pkbf(o2[6], o2[7]);
            u32x4* dst = (u32x4*)(KPE + (size_t)row * 32 + 16 * grp); dst[0] = w0; dst[1] = w1; }
#pragma unroll
        for (int ai = 0; ai < 2; ++ai)
#pragma unroll
            for (int m = 0; m < 4; ++m) { bf16_t* rowp = O + (size_t)(row0 + ai * HALF + m * 16) * 1024 + col0; const float r = rs[ai * 4 + m];
#pragma unroll
                for (int bj = 0; bj < 2; ++bj) { const f32x4 v0 = acc[ai][bj][m][0] * r, v1 = acc[ai][bj][m][1] * r;
                    u32x4 w; w.x = pkbf(v0[0], v0[1]); w.y = pkbf(v0[2], v0[3]); w.z = pkbf(v1[0], v1[1]); w.w = pkbf(v1[2], v1[3]);
                    *(u32x4*)(rowp + bj * HALF) = w; } }
    }
};
#define EPI_GOFF(i, pitchB) ((size_t)((((i) >> 3) * HALF + (((i) >> 1) & 3) * 16)) * (pitchB) + ((i) & 1) * (HALF * 2))
#define EPI_ACC0(i) acc[(i) >> 3][(i) & 1][((i) >> 1) & 3][0]
#define EPI_ACC1(i) acc[(i) >> 3][(i) & 1][((i) >> 1) & 3][1]
__device__ __forceinline__ u32x4 gate_mix(const u32x4 p, const u32x4 g, const f32x4 v0, const f32x4 v1) { u32x4 w;
    w.x = pkbf(bf_lo(p.x) + bf_lo(g.x) * v0[0], bf_hi(p.x) + bf_hi(g.x) * v0[1]); w.y = pkbf(bf_lo(p.y) + bf_lo(g.y) * v0[2], bf_hi(p.y) + bf_hi(g.y) * v0[3]);
    w.z = pkbf(bf_lo(p.z) + bf_lo(g.z) * v1[0], bf_hi(p.z) + bf_hi(g.z) * v1[1]); w.w = pkbf(bf_lo(p.w) + bf_lo(g.w) * v1[2], bf_hi(p.w) + bf_hi(g.w) * v1[3]); return w; }
template <int ADD>
struct EpiGate {
    const bf16_t* Gt; bf16_t* O;
    __device__ __forceinline__ void operator()(const Acc& acc, const Unit& u, int wr, int wc, int fr, int fq) const {
        const char* gb = (const char*)(Gt + (size_t)u.pm * BM * NGATE + u.pn * BM) + (unsigned)(((wr * 64 + fr) * NGATE + wc * 32 + 8 * fq) * 2);
        char* ob = (char*)(O + (size_t)u.pm * BM * DM + u.pn * BM) + (unsigned)(((wr * 64 + fr) * DM + wc * 32 + 8 * fq) * 2);
        if constexpr (!ADD) {
            u32x4 gq[16];
#pragma unroll
            for (int i = 0; i < 16; ++i) gq[i] = *(const u32x4*)(gb + EPI_GOFF(i, NGATE * 2));
            __builtin_amdgcn_sched_barrier(0);
#pragma unroll
            for (int i = 0; i < 16; ++i) *(u32x4*)(ob + EPI_GOFF(i, DM * 2)) = gate_mix((u32x4){0u, 0u, 0u, 0u}, gq[i], EPI_ACC0(i), EPI_ACC1(i));
        } else {
            u32x4 ga[8], pa[8], wa[8], g2[8], p2[8];
#pragma unroll
            for (int i = 0; i < 8; ++i) { ga[i] = *(const u32x4*)(gb + EPI_GOFF(i, NGATE * 2)); pa[i] = *(const u32x4*)(ob + EPI_GOFF(i, DM * 2)); }
            __builtin_amdgcn_sched_barrier(0);
#pragma unroll
            for (int i = 0; i < 8; ++i) wa[i] = gate_mix(pa[i], ga[i], EPI_ACC0(i), EPI_ACC1(i));
            __builtin_amdgcn_sched_barrier(0);
#pragma unroll
            for (int i = 0; i < 8; ++i) { g2[i] = *(const u32x4*)(gb + EPI_GOFF(8 + i, NGATE * 2)); p2[i] = *(const u32x4*)(ob + EPI_GOFF(8 + i, DM * 2)); }
            __builtin_amdgcn_sched_barrier(0);
#pragma unroll
            for (int i = 0; i < 8; ++i) *(u32x4*)(ob + EPI_GOFF(i, DM * 2)) = wa[i];
            __builtin_amdgcn_sched_barrier(0);
#pragma unroll
            for (int i = 0; i < 8; ++i) *(u32x4*)(ob + EPI_GOFF(8 + i, DM * 2)) = gate_mix(p2[i], g2[i], EPI_ACC0(8 + i), EPI_ACC1(8 + i));
        }
    }
};
#define EPI_GOFF8(i) ((size_t)((((i) >> 3) * HALF + (((i) >> 1) & 3) * 16)) * NGATE + ((i) & 1) * HALF)
struct EpiGate2 {
    static constexpr int NST = 16;
    const bf16_t* Gt; bf16_t* O;
    static __device__ __forceinline__ float rt(float qa, float qb) { return qa * __builtin_amdgcn_rcpf(fmaxf(qb, 255e-12f)); }
    static __device__ __forceinline__ float gbe(float qb) { return fmaxf(qb * (1.f / 255.f), 1e-12f); }
    __device__ __forceinline__ void mid(Acc& acc, const Unit& u, int wr, int wc, int fr, int fq, u32x2* keep) const {
        int z = 0; asm volatile("" : "+v"(z));
        const unsigned char* gb = (const unsigned char*)Gt + (size_t)u.pm * BM * NGATE + u.pn * BM + (unsigned)((wr * 64 + fr + z) * NGATE + wc * 32 + 8 * fq);
#pragma unroll
        for (int i0 = 0; i0 < 16; i0 += 8) {
            u32x2 a[8], b[8];
#pragma unroll
            for (int k = 0; k < 8; ++k) { a[k] = *(const u32x2*)(gb + EPI_GOFF8(i0 + k)); b[k] = *(const u32x2*)(gb + EPI_GOFF8(i0 + k) + 1024); }
#pragma unroll
            for (int k = 0; k < 8; ++k) { const int i = i0 + k; f32x4& v0 = acc[i >> 3][i & 1][(i >> 1) & 3][0]; f32x4& v1 = acc[i >> 3][i & 1][(i >> 1) & 3][1];
#pragma unroll
                for (int j = 0; j < 4; ++j) { v0[j] *= rt(ub8(a[k].x, j), ub8(b[k].x, j)); v1[j] *= rt(ub8(a[k].y, j), ub8(b[k].y, j)); }
                if (i >= 8) keep[i - 8] = b[k]; }
            __builtin_amdgcn_sched_barrier(0); }
    }
    __device__ __forceinline__ void fin(const Acc& acc, const Unit& u, int wr, int wc, int fr, int fq, const u32x2* keep) const {
        const unsigned char* gb = (const unsigned char*)Gt + (size_t)u.pm * BM * NGATE + 1024 + u.pn * BM + (unsigned)((wr * 64 + fr) * NGATE + wc * 32 + 8 * fq);
        char* ob = (char*)(O + (size_t)u.pm * BM * DM + u.pn * BM) + (unsigned)(((wr * 64 + fr) * DM + wc * 32 + 8 * fq) * 2);
        u32x2 gq[16];
#pragma unroll
        for (int i = 0; i < 8; ++i) gq[i] = *(const u32x2*)(gb + EPI_GOFF8(i));
#pragma unroll
        for (int i = 8; i < 16; ++i) gq[i] = keep[i - 8];
        __builtin_amdgcn_sched_barrier(0);
#pragma unroll
        for (int ii = 0; ii < 16; ++ii) { const int i = ii ^ 8;
            const u32x2 g = gq[i]; const f32x4 v0 = EPI_ACC0(i), v1 = EPI_ACC1(i); u32x4 w;
            w.x = pkbf(gbe(ub8(g.x, 0)) * v0[0], gbe(ub8(g.x, 1)) * v0[1]); w.y = pkbf(gbe(ub8(g.x, 2)) * v0[2], gbe(ub8(g.x, 3)) * v0[3]);
            w.z = pkbf(gbe(ub8(g.y, 0)) * v1[0], gbe(ub8(g.y, 1)) * v1[1]); w.w = pkbf(gbe(ub8(g.y, 2)) * v1[2], gbe(ub8(g.y, 3)) * v1[3]);
            *(u32x4*)(ob + EPI_GOFF(i, DM * 2)) = w; }
    }
};
struct EpiResid {
    bf16_t* XB;
    __device__ __forceinline__ void operator()(const Acc& acc, const Unit& u, int wr, int wc, int fr, int fq) const {
        char* ob = (char*)(XB + (size_t)u.pm * BM * DM + u.pn * BM) + (unsigned)(((wr * 64 + fr) * DM + wc * 32 + 8 * fq) * 2);
        u32x4 pq[16];
#pragma unroll
        for (int i = 0; i < 16; ++i) pq[i] = *(const u32x4*)(ob + EPI_GOFF(i, DM * 2));
        __builtin_amdgcn_sched_barrier(0);
#pragma unroll
        for (int i = 0; i < 16; ++i) { const f32x4 v0 = EPI_ACC0(i), v1 = EPI_ACC1(i); const u32x4 p = pq[i];
            u32x4 w; w.x = pkbf(bf_lo(p.x) + v0[0], bf_hi(p.x) + v0[1]); w.y = pkbf(bf_lo(p.y) + v0[2], bf_hi(p.y) + v0[3]); w.z = pkbf(bf_lo(p.z) + v1[0], bf_hi(p.z) + v1[1]); w.w = pkbf(bf_lo(p.w) + v1[2], bf_hi(p.w) + v1[3]);
            *(u32x4*)(ob + EPI_GOFF(i, DM * 2)) = w; }
    }
};
struct EpiSwiGLU {
    bf16_t* O; const float* rs; const LAS float* tab0;
    __device__ __forceinline__ void operator()(const Acc& acc, const Unit& u, int wr, int wc, int fr, int fq) const {
        const int col0 = (u.pn & 7) * HALF + wc * 32 + 8 * fq, row0 = u.pm * BM + wr * 64 + fr;
        float rsl[8];
        if (u.aux == 0) {
#pragma unroll
            for (int k = 0; k < 8; ++k) rsl[k] = tab0[wr * 64 + fr + (k >> 2) * HALF + (k & 3) * 16]; }
        else {
#pragma unroll
            for (int k = 0; k < 8; ++k) rsl[k] = rs[row0 + (k >> 2) * HALF + (k & 3) * 16]; }
#pragma unroll
        for (int ai = 0; ai < 2; ++ai)
#pragma unroll
            for (int m = 0; m < 4; ++m) { float r[8]; const float rsv = rsl[ai * 4 + m], rs2 = rsv * rsv, rsn = rsv * -1.4426950408889634f;
#pragma unroll
                for (int n = 0; n < 2; ++n)
#pragma unroll
                    for (int q = 0; q < 4; ++q) { const float x1 = acc[ai][0][m][n][q], x3 = acc[ai][1][m][n][q];
                        r[n * 4 + q] = (x1 * x3) * rs2 * __builtin_amdgcn_rcpf(1.f + __builtin_amdgcn_exp2f(x1 * rsn)); }
                u32x4 w; w.x = pkbf(r[0], r[1]); w.y = pkbf(r[2], r[3]); w.z = pkbf(r[4], r[5]); w.w = pkbf(r[6], r[7]);
                *(u32x4*)(O + (size_t)(row0 + ai * HALF + m * 16) * 1024 + col0) = w; }
    }
};
struct EpiMoeDown {
    bf16_t* O; const float* val; const LAS float* tab0;
    __device__ __forceinline__ void operator()(const Acc& acc, const Unit& u, int wr, int wc, int fr, int fq) const {
        const int col0 = (u.pn & 3) * BM + wc * 32 + 8 * fq, row0 = u.pm * BM + wr * 64 + fr;
        float vl[8];
        if (u.aux == 0) {
#pragma unroll
            for (int k = 0; k < 8; ++k) vl[k] = tab0[wr * 64 + fr + (k >> 2) * HALF + (k & 3) * 16]; }
        else {
#pragma unroll
            for (int k = 0; k < 8; ++k) vl[k] = val[row0 + (k >> 2) * HALF + (k & 3) * 16]; }
#pragma unroll
        for (int ai = 0; ai < 2; ++ai)
#pragma unroll
            for (int m = 0; m < 4; ++m) { const int row = row0 + ai * HALF + m * 16; const float s = vl[ai * 4 + m]; bf16_t* rowp = O + (size_t)row * 1024 + col0;
#pragma unroll
                for (int bj = 0; bj < 2; ++bj) { const f32x4 v0 = acc[ai][bj][m][0] * s, v1 = acc[ai][bj][m][1] * s;
                    u32x4 w; w.x = pkbf(v0[0], v0[1]); w.y = pkbf(v0[2], v0[3]); w.z = pkbf(v1[0], v1[1]); w.w = pkbf(v1[2], v1[3]);
                    *(u32x4*)(rowp + bj * HALF) = w; } }
    }
};
__device__ __forceinline__ u32x4 ple_mix(const u32x4 x, const u32x4 p, const f32x4 v0, const f32x4 v1) { u32x4 w;
    w.x = pkbf(bf_lo(x.x) + sigmoidf_(v0[0]) * bf_lo(p.x), bf_hi(x.x) + sigmoidf_(v0[1]) * bf_hi(p.x)); w.y = pkbf(bf_lo(x.y) + sigmoidf_(v0[2]) * bf_lo(p.y), bf_hi(x.y) + sigmoidf_(v0[3]) * bf_hi(p.y));
    w.z = pkbf(bf_lo(x.z) + sigmoidf_(v1[0]) * bf_lo(p.z), bf_hi(x.z) + sigmoidf_(v1[1]) * bf_hi(p.z)); w.w = pkbf(bf_lo(x.w) + sigmoidf_(v1[2]) * bf_lo(p.w), bf_hi(x.w) + sigmoidf_(v1[3]) * bf_hi(p.w)); return w; }
struct EpiPle {
    const bf16_t* XB; bf16_t* XO; const bf16_t* PE; const float* rs;
    __device__ __forceinline__ void operator()(const Acc& acc, const Unit& u, int wr, int wc, int fr, int fq) const {
        const size_t ub = (size_t)u.pm * BM * DM + u.pn * BM; const unsigned lo = (unsigned)(((wr * 64 + fr) * DM + wc * 32 + 8 * fq) * 2);
        const char* xb = (const char*)(XB + ub) + lo; const char* pb = (const char*)(PE + ub) + lo; char* ob = (char*)(XO + ub) + lo;
        float rsl[8]; { const float* rp = rs + u.pm * BM + wr * 64 + fr;
#pragma unroll
            for (int k = 0; k < 8; ++k) rsl[k] = rp[(k >> 2) * HALF + (k & 3) * 16]; }
        u32x4 pa[8], xa[8], wa[8], p2[8], x2[8];
#pragma unroll
        for (int i = 0; i < 8; ++i) { pa[i] = *(const u32x4*)(pb + EPI_GOFF(i, DM * 2)); xa[i] = *(const u32x4*)(xb + EPI_GOFF(i, DM * 2)); }
        __builtin_amdgcn_sched_barrier(0);
#pragma unroll
        for (int i = 0; i < 8; ++i) wa[i] = ple_mix(xa[i], pa[i], EPI_ACC0(i) * rsl[i >> 1], EPI_ACC1(i) * rsl[i >> 1]);
        __builtin_amdgcn_sched_barrier(0);
#pragma unroll
        for (int i = 0; i < 8; ++i) { p2[i] = *(const u32x4*)(pb + EPI_GOFF(8 + i, DM * 2)); x2[i] = *(const u32x4*)(xb + EPI_GOFF(8 + i, DM * 2)); }
        __builtin_amdgcn_sched_barrier(0);
#pragma unroll
        for (int i = 0; i < 8; ++i) *(u32x4*)(ob + EPI_GOFF(i, DM * 2)) = wa[i];
        __builtin_amdgcn_sched_barrier(0);
#pragma unroll
        for (int i = 0; i < 8; ++i) *(u32x4*)(ob + EPI_GOFF(8 + i, DM * 2)) = ple_mix(x2[i], p2[i], EPI_ACC0(8 + i) * rsl[4 + (i >> 1)], EPI_ACC1(8 + i) * rsl[4 + (i >> 1)]);
    }
};

struct NoEpi { static constexpr int NST = 16; __device__ __forceinline__ void operator()(const Acc&, const Unit&, int, int, int, int) const {} };
template <class Epi, class Sched, bool GATHER = false, bool MIDHOOK = false, bool DUAL = false, class Epi2 = NoEpi>
__device__ __forceinline__ void gemm_phase(LAS unsigned char* lds, const Gemm g, const Sched& S, const Epi& E, unsigned long long* ptq = nullptr, const Gemm g2 = Gemm{}, const Epi2& E2 = Epi2{}) {
    int tid = threadIdx.x; asm volatile("" : "+v"(tid));
    const int wid = __builtin_amdgcn_readfirstlane(tid >> 6), lane = tid & 63, wr = wid >> 2, wc = wid & 3, fr = lane & 15, fq = lane >> 4;
    const int K = g.K, nt = K / BK;
    unsigned voffA[2], voffB[2];
#pragma unroll
    for (int i = 0; i < 2; ++i) { int R, C; stage_rc(tid * 16 + i * 8192, R, C); const int Rb = (R & ~31) + perm32(R & 31);
        voffA[i] = (unsigned)(R * g.lda + C) * 2u; voffB[i] = (unsigned)(Rb * g.ldb + C) * 2u; }
    const size_t kstep = (size_t)(BK * 2);
    const size_t hstepA = (size_t)HALF * g.lda * 2, hstepB = (size_t)HALF * g.ldb * 2;
    const size_t tstepA = 2 * hstepA, tstepB = 2 * hstepB;
    const unsigned ldsw = (unsigned)wid * 1024u;
    const int aoff = lds_byte(wr * 64 + fr, fq * 8), boff = lds_byte(wc * 32 + fr, fq * 8);
#define PG8_SA(b, h) (((b) * 2 + (h)) * HTB)
#define PG8_SB(b, h) ((4 + (b) * 2 + (h)) * HTB)
#define PG8_STAGE(bufoff, gbase, voff) do { _Pragma("unroll") for (int _i = 0; _i < 2; ++_i) \
        __builtin_amdgcn_global_load_lds((const unsigned*)((const char*)(gbase) + (voff)[_i]), (LAS unsigned*)(lds + (bufoff) + ldsw + _i * 8192), 16, 0, 0); } while (0)
#define PG8_LDA(dst, b, h) do { _Pragma("unroll") for (int m = 0; m < 4; ++m) _Pragma("unroll") for (int k = 0; k < 2; ++k) dst[m][k] = *(const LAS bf16x8*)(lds + PG8_SA(b, h) + aoff + m * 2048 + k * 1024); } while (0)
#define PG8_LDB(dst, b, h) do { _Pragma("unroll") for (int n = 0; n < 2; ++n) _Pragma("unroll") for (int k = 0; k < 2; ++k) dst[n][k] = *(const LAS bf16x8*)(lds + PG8_SB(b, h) + boff + n * 2048 + k * 1024); } while (0)
#define PG8_MMA(ai, bj, At, Bt) do { __builtin_amdgcn_s_setprio(1); _Pragma("unroll") for (int m = 0; m < 4; ++m) _Pragma("unroll") for (int n = 0; n < 2; ++n) _Pragma("unroll") for (int k = 0; k < 2; ++k) \
        acc[ai][bj][m][n] = __builtin_amdgcn_mfma_f32_16x16x32_bf16(Bt[n][k], At[m][k], acc[ai][bj][m][n], 0, 0, 0); __builtin_amdgcn_s_setprio(0); } while (0)
#define PG8_WAIT_V(n) asm volatile("s_waitcnt vmcnt(" #n ")" ::: "memory")
#define PG8_WAIT_L(n) asm volatile("s_waitcnt lgkmcnt(" #n ")" ::: "memory")
#define PG8_BAR __builtin_amdgcn_s_barrier()
#define PG8_SCHED __builtin_amdgcn_sched_barrier(0)
    Unit cur, nxt; int ui = 0;
    if (!S.next(0, cur)) return;
    unsigned gvA[2][2] = {{0u, 0u}, {0u, 0u}};
#define PG8_LOADGV(pm_) do { _Pragma("unroll") for (int _h = 0; _h < 2; ++_h) _Pragma("unroll") for (int _i = 0; _i < 2; ++_i) { int R_, C_; stage_rc(tid * 16 + _i * 8192, R_, C_); \
        gvA[_h][_i] = (unsigned)g.rowidx[(pm_) * BM + _h * HALF + R_] * (unsigned)(g.lda * 2) + (unsigned)(C_ * 2); } } while (0)
#define PG8_STAGE_A(b, h, ptr) do { if constexpr (GATHER) { PG8_STAGE(PG8_SA(b, h), ptr, gvA[h]); } else { PG8_STAGE(PG8_SA(b, h), (ptr) + (h) * hstepA, voffA); } } while (0)
    if constexpr (GATHER) PG8_LOADGV(cur.pm);
    f32x4 acc[2][2][4][2];
#pragma unroll
    for (int a = 0; a < 2; ++a)
#pragma unroll
        for (int b = 0; b < 2; ++b)
#pragma unroll
            for (int m = 0; m < 4; ++m)
#pragma unroll
                for (int n = 0; n < 2; ++n) acc[a][b][m][n] = (f32x4){0.f, 0.f, 0.f, 0.f};
    bf16x8 At[4][2], B0[2][2], B1[2][2];
    u32x2 keep[MIDHOOK ? 8 : 1];
    const char* cA = (const char*)((DUAL && cur.aux) ? g2.A : g.A) + (GATHER ? (size_t)0 : (size_t)cur.pm * tstepA); const char* cB = (const char*)((DUAL && cur.aux) ? g2.Bt : g.Bt) + (size_t)cur.pn * tstepB;
    PG8_STAGE(PG8_SB(0, 0), cB, voffB); PG8_STAGE(PG8_SB(0, 1), cB + hstepB, voffB); PG8_STAGE_A(0, 0, cA); PG8_STAGE_A(0, 1, cA);
    if (wr == 1) PG8_BAR;
    PG8_WAIT_V(2); PG8_BAR;
    PG8_STAGE(PG8_SB(1, 0), cB + kstep, voffB); PG8_STAGE_A(1, 0, cA + kstep); PG8_STAGE(PG8_SB(1, 1), cB + hstepB + kstep, voffB);
    PG8_WAIT_V(6); PG8_BAR;
    for (;;) {
        const bool has_next = S.next(ui + 1, nxt);
        const char* nA = (has_next && !GATHER) ? (const char*)((DUAL && nxt.aux) ? g2.A : g.A) + (size_t)nxt.pm * tstepA : cA; const char* nB = has_next ? (const char*)((DUAL && nxt.aux) ? g2.Bt : g.Bt) + (size_t)nxt.pn * tstepB : cB;
#pragma unroll 1
        for (int t = 0; t < nt; t += 2) {
            const bool last = (t == nt - 2);
            if constexpr (MIDHOOK) { if (t == (nt >> 1)) E.mid(acc, cur, wr, wc, fr, fq, keep); }
            const char* a1 = cA + (size_t)(t + 1) * kstep;
            const char* a2 = last ? nA : cA + (size_t)(t + 2) * kstep; const char* b2 = last ? nB : cB + (size_t)(t + 2) * kstep;
            const char* a3 = a2 + kstep; const char* b3 = b2 + kstep;
            PG8_LDB(B0, 0, 0); PG8_LDB(B1, 0, 1); PG8_SCHED; PG8_LDA(At, 0, 0); PG8_STAGE_A(1, 1, a1);
            if constexpr (GATHER) { if (last && has_next && nxt.pm != cur.pm) PG8_LOADGV(nxt.pm); }
            PG8_WAIT_V(8); PG8_WAIT_L(0); PG8_BAR; PG8_MMA(0, 0, At, B0); PG8_MMA(0, 1, At, B1); PG8_BAR; PG8_SCHED;
            PG8_LDA(At, 0, 1); PG8_STAGE(PG8_SB(0, 0), b2, voffB); PG8_STAGE(PG8_SB(0, 1), b2 + hstepB, voffB); PG8_STAGE_A(0, 0, a2);
            PG8_WAIT_V(8); PG8_WAIT_L(0); PG8_BAR; PG8_MMA(1, 0, At, B0); PG8_MMA(1, 1, At, B1); PG8_BAR; PG8_SCHED;
            PG8_LDB(B0, 1, 0); PG8_LDB(B1, 1, 1); PG8_SCHED; PG8_LDA(At, 1, 0); PG8_STAGE_A(0, 1, a2);
            PG8_WAIT_V(8); PG8_WAIT_L(0); PG8_BAR; PG8_MMA(0, 0, At, B0); PG8_MMA(0, 1, At, B1); PG8_BAR; PG8_SCHED;
            PG8_LDA(At, 1, 1); PG8_STAGE(PG8_SB(1, 0), b3, voffB); PG8_STAGE(PG8_SB(1, 1), b3 + hstepB, voffB); PG8_STAGE_A(1, 0, a3);
            PG8_WAIT_V(8); PG8_WAIT_L(0); PG8_BAR; PG8_MMA(1, 0, At, B0); PG8_MMA(1, 1, At, B1); PG8_BAR; PG8_SCHED;
        }
#if PROBE_T == 200 || PROBE_T == 201
        if (ptq) { const unsigned long long now_ = __builtin_amdgcn_s_memrealtime(); if (PROBE_T == 201) ptq[0] += now_ - ptq[1]; ptq[1] = now_; }
#endif
        if (wr == 0) PG8_BAR;
        if constexpr (MIDHOOK) E.fin(acc, cur, wr, wc, fr, fq, keep); else if constexpr (DUAL) { if (cur.aux) E2(acc, cur, wr, wc, fr, fq); else E(acc, cur, wr, wc, fr, fq); } else E(acc, cur, wr, wc, fr, fq);
#if PROBE_T == 200 || PROBE_T == 201
        if (ptq) { const unsigned long long now_ = __builtin_amdgcn_s_memrealtime(); if (PROBE_T == 200) ptq[0] += now_ - ptq[1]; ptq[1] = now_; }
#endif
        if (!has_next) break;
#pragma unroll
        for (int a = 0; a < 2; ++a)
#pragma unroll
            for (int b = 0; b < 2; ++b)
#pragma unroll
                for (int m = 0; m < 4; ++m)
#pragma unroll
                    for (int n = 0; n < 2; ++n) acc[a][b][m][n] = (f32x4){0.f, 0.f, 0.f, 0.f};
        cur = nxt; cA = nA; cB = nB; ++ui;
        if (wr == 1) PG8_BAR;
    }
    PG8_WAIT_V(0);
    PG8_BAR;
#undef PG8_SA
#undef PG8_SB
#undef PG8_STAGE
#undef PG8_STAGE_A
#undef PG8_LOADGV
#undef PG8_LDA
#undef PG8_LDB
#undef PG8_MMA
#undef PG8_WAIT_V
#undef PG8_WAIT_L
#undef PG8_BAR
#undef PG8_SCHED
}
}

namespace mla {
constexpr int NW = 8, QBLK = 32, KVBLK = 64;
constexpr float SCALE = 0.10206207261596575f;
constexpr float THR = 8.f;
constexpr int SHM_V = KVBLK * 64 * 2, SHM_K = KVBLK * 256;
constexpr int NSLOT = 3, OFF_V = 0, OFF_K = NSLOT * SHM_V, OFF_WS = OFF_K + NSLOT * SHM_K, LDS_NEED = OFF_WS + NW * 64 * 4;
#define KSWZ(row, colB) ((row) * 256 + ((colB) ^ (((row) & 15) << 4)))
#define SBAR() __builtin_amdgcn_sched_barrier(0)
__device__ __forceinline__ int crow(int r, int hi) { return (r & 3) + 8 * (r >> 2) + 4 * hi; }

constexpr float THRL = THR * 1.4426950408889634f;
template <bool FIRST>
__device__ __forceinline__ void partialSM(f32x16& p0, f32x16& p1, float& mhat, f32x16& negm, float& alpha) {
  float pmax = p0[0];
#pragma unroll
  for (int r = 1; r < 16; ++r) pmax = fmaxf(pmax, p0[r]);
#pragma unroll
  for (int r = 0; r < 16; ++r) pmax = fmaxf(pmax, p1[r]);
  { auto rr = __builtin_amdgcn_permlane32_swap(__float_as_uint(pmax), __float_as_uint(pmax), false, false);
    pmax = fmaxf(__uint_as_float(rr[0]), __uint_as_float(rr[1])); }
  alpha = 1.f;
  if (FIRST || __builtin_expect(!__all(pmax <= THRL), 0)) {
    const float dl = FIRST ? pmax : fmaxf(pmax, 0.f);
    mhat += dl; alpha = FIRST ? 1.f : __builtin_amdgcn_exp2f(-dl);
#pragma unroll
    for (int r = 0; r < 16; ++r) { p0[r] -= dl; p1[r] -= dl; }
#pragma unroll
    for (int r = 0; r < 16; ++r) negm[r] = -mhat;
  }
#pragma unroll
  for (int r = 0; r < 16; ++r) p0[r] = __builtin_amdgcn_exp2f(p0[r]);
}
__device__ __forceinline__ void finishSM(f32x16& p0, f32x16& p1, float alpha, float& l_reg, bf16x8& pa0, bf16x8& pa1, bf16x8& pa2, bf16x8& pa3) {
#pragma unroll
  for (int r = 0; r < 16; ++r) p1[r] = __builtin_amdgcn_exp2f(p1[r]);
  float ps = 0;
#pragma unroll
  for (int r = 0; r < 16; ++r) ps += p0[r];
#pragma unroll
  for (int r = 0; r < 16; ++r) ps += p1[r];
  { auto rr = __builtin_amdgcn_permlane32_swap(__float_as_uint(ps), __float_as_uint(ps), false, false);
    ps = __uint_as_float(rr[0]) + __uint_as_float(rr[1]); }
  l_reg = l_reg * alpha + ps;
#define PK8(P, BASE, OUT) do { const u32x4 w = {pkbf(P[BASE + 0], P[BASE + 1]), pkbf(P[BASE + 2], P[BASE + 3]), pkbf(P[BASE + 4], P[BASE + 5]), pkbf(P[BASE + 6], P[BASE + 7])}; OUT = __builtin_bit_cast(bf16x8, w); } while (0)
  PK8(p0, 0, pa0); PK8(p0, 8, pa1); PK8(p1, 0, pa2); PK8(p1, 8, pa3);
#undef PK8
}
__device__ __forceinline__ void qkt(f32x16& p0, f32x16& p1, const LAS unsigned char* Ks, const bf16x8* qr, const f32x16& negm, int r32, int hi) {
  p0 = negm; p1 = negm;
#pragma unroll
  for (int d0 = 0; d0 < 6; ++d0) { const int cb = (d0 * 16 + hi * 8) * 2;
    const bf16x8 b0 = *(const LAS bf16x8*)(Ks + KSWZ(r32, cb));
    const bf16x8 b1 = *(const LAS bf16x8*)(Ks + KSWZ(32 + r32, cb));
    p0 = __builtin_amdgcn_mfma_f32_32x32x16_bf16(b0, qr[d0], p0, 0, 0, 0);
    p1 = __builtin_amdgcn_mfma_f32_32x32x16_bf16(b1, qr[d0], p1, 0, 0, 0); }
}
__device__ __forceinline__ int v_st(int k, int c) { const int kk = k; return ((kk >> 3) * 2 + (c >> 5)) * 512 + ((kk & 7) * 32 + (c & 31)) * 2; }
__device__ __forceinline__ int v_rd_base(int lane) { return ((lane & 3) << 3) | (((lane >> 2) & 3) << 6) | (((lane >> 4) & 1) << 5) | (((lane >> 5) & 1) << 8); }
constexpr int v_rd_off(int d0, int ks, int half) { return d0 * 512 + ks * 2048 + half * 1024; }
template <int OFF> __device__ __forceinline__ s16x4 tr_read(int vb) {
  s16x4 r; asm volatile("ds_read_b64_tr_b16 %0, %1 offset:%2" : "=&v"(r) : "v"(vb), "i"(OFF) : "memory"); return r;
}
template <int D0> __device__ __forceinline__ void pv_one(f32x16& od, int vb, bf16x8 pa0, bf16x8 pa1, bf16x8 pa2, bf16x8 pa3) {
  const s16x4 l0 = tr_read<v_rd_off(D0, 0, 0)>(vb), h0 = tr_read<v_rd_off(D0, 0, 1)>(vb), l1 = tr_read<v_rd_off(D0, 1, 0)>(vb), h1 = tr_read<v_rd_off(D0, 1, 1)>(vb);
  const s16x4 l2 = tr_read<v_rd_off(D0, 2, 0)>(vb), h2 = tr_read<v_rd_off(D0, 2, 1)>(vb), l3 = tr_read<v_rd_off(D0, 3, 0)>(vb), h3 = tr_read<v_rd_off(D0, 3, 1)>(vb);
  asm volatile("s_waitcnt lgkmcnt(0)" ::: "memory"); SBAR();
#define PK(L, H) (bf16x8){L[0], L[1], L[2], L[3], H[0], H[1], H[2], H[3]}
  od = __builtin_amdgcn_mfma_f32_32x32x16_bf16(PK(l0, h0), pa0, od, 0, 0, 0);
  od = __builtin_amdgcn_mfma_f32_32x32x16_bf16(PK(l1, h1), pa1, od, 0, 0, 0);
  od = __builtin_amdgcn_mfma_f32_32x32x16_bf16(PK(l2, h2), pa2, od, 0, 0, 0);
  od = __builtin_amdgcn_mfma_f32_32x32x16_bf16(PK(l3, h3), pa3, od, 0, 0, 0);
#undef PK
}
__device__ __forceinline__ void pv_d0(f32x16* o, int vb, bf16x8 pa0, bf16x8 pa1, bf16x8 pa2, bf16x8 pa3) {
  pv_one<0>(o[0], vb, pa0, pa1, pa2, pa3); pv_one<1>(o[1], vb, pa0, pa1, pa2, pa3);
}
__device__ __forceinline__ void unit(int b, int h, int qb, const bf16_t* __restrict__ Qg, const bf16_t* __restrict__ KVg, const bf16_t* __restrict__ KPE, bf16_t* __restrict__ ATT, LAS unsigned char* lds) {
  int tid = threadIdx.x; asm volatile("" : "+v"(tid));
  const int wid = tid >> 6, lane = tid & 63, r32 = lane & 31, hi = lane >> 5;
  LAS unsigned char* V_lds = lds + OFF_V; LAS unsigned char* K_lds = lds + OFF_K;
  LAS float* ws = (LAS float*)(lds + OFF_WS) + wid * 64; LAS float* li_l = ws; LAS float* al_l = ws + 32;
  float m_reg = 0.f, l_reg = 0; f32x16 o[2] = {}; bf16x8 qr[6]; f32x16 negm = {};
  const size_t tok0 = (size_t)b * SEQ;
  const bf16_t* Qw = Qg + (tok0 + qb * 256 + wid * QBLK + r32) * 768 + h * 96 + hi * 8;
#pragma unroll
  for (int d0 = 0; d0 < 6; ++d0) qr[d0] = *(const bf16x8*)(Qw + d0 * 16);
  const int sk = tid >> 3, sc8 = tid & 7, skp = (tid & 255) >> 2, scp = tid & 3;
  const bf16_t* vsrc = KVg + (tok0 + sk) * 1024 + h * 128 + 64 + sc8 * 8;
  const bf16_t* ksrc = KVg + (tok0 + sk) * 1024 + h * 128 + sc8 * 8;
  const bf16_t* psrc = KPE + (tok0 + skp) * 32 + scp * 8;
  const int vst = v_st(sk, sc8 * 8), kst = KSWZ(sk, sc8 * 16), pst = KSWZ(skp, 128 + scp * 16);
  const int vb0 = (int)(unsigned)(uintptr_t)V_lds + v_rd_base(lane);
  struct { bf16x8 v, k, p; } sr_[2];
#define SLOAD(i, k0) do { sr_[i].v = *(const bf16x8*)(vsrc + (size_t)(k0) * 1024); sr_[i].k = *(const bf16x8*)(ksrc + (size_t)(k0) * 1024); sr_[i].p = *(const bf16x8*)(psrc + (size_t)(k0) * 32); } while (0)
#define SWRITE(bb, i) do { *(LAS bf16x8*)(V_lds + (bb) * SHM_V + vst) = sr_[i].v; *(LAS bf16x8*)(K_lds + (bb) * SHM_K + kst) = sr_[i].k; *(LAS bf16x8*)(K_lds + (bb) * SHM_K + pst) = sr_[i].p; } while (0)
#define SWAIT() asm volatile("s_waitcnt vmcnt(3)" ::: "memory")
#define RESC(a) do { if (__any((a) < 1.f)) { _Pragma("unroll") for (int d = 0; d < 2; ++d) _Pragma("unroll") for (int r = 0; r < 16; ++r) o[d][r] *= (a); } } while (0)
  f32x16 pA0, pA1, pB0, pB1; float alA, alB; bf16x8 pa0, pa1, pa2, pa3; constexpr int NT = SEQ / KVBLK;
#define STEP(X0, X1, Y0, Y1, ALX, ALY, T, SET) do { constexpr int sc_ = (T) % 3, sp_ = ((T) + 2) % 3, sn_ = ((T) + 1) % 3; \
    SWAIT(); SWRITE(sn_, SET); if (tb + (T) + 2 < NT) SLOAD(SET, (tb + (T) + 2) * KVBLK); \
    SBAR(); qkt(X0, X1, K_lds + sc_ * SHM_K, qr, negm, r32, hi); \
    finishSM(Y0, Y1, ALY, l_reg, pa0, pa1, pa2, pa3); SBAR(); \
    pv_d0(o, vb0 + sp_ * SHM_V, pa0, pa1, pa2, pa3); partialSM<false>(X0, X1, m_reg, negm, ALX); \
    RESC(ALX); __syncthreads(); } while (0)
  if (__builtin_amdgcn_readfirstlane(wid) >= 4) __builtin_amdgcn_s_setprio(1);
  SLOAD(0, 0); SLOAD(1, KVBLK);
  SWAIT(); SWRITE(0, 0); SLOAD(0, 2 * KVBLK);
  SWAIT(); SWRITE(1, 1); SLOAD(1, 3 * KVBLK);
  __syncthreads();
  qkt(pA0, pA1, K_lds, qr, negm, r32, hi); partialSM<true>(pA0, pA1, m_reg, negm, alA);
  static_assert((NT - 4) % 6 == 0, "tiles 1 .. NT-4 in trips of six, then three more, then the drain");
  int tb = 1;
  for (; tb + 5 < NT - 3; tb += 6) {
    STEP(pB0, pB1, pA0, pA1, alB, alA, 1, 0);
    STEP(pA0, pA1, pB0, pB1, alA, alB, 2, 1);
    STEP(pB0, pB1, pA0, pA1, alB, alA, 3, 0);
    STEP(pA0, pA1, pB0, pB1, alA, alB, 4, 1);
    STEP(pB0, pB1, pA0, pA1, alB, alA, 5, 0);
    STEP(pA0, pA1, pB0, pB1, alA, alB, 6, 1);
  }
  STEP(pB0, pB1, pA0, pA1, alB, alA, 1, 0);
  STEP(pA0, pA1, pB0, pB1, alA, alB, 2, 1);
  { constexpr int sc_ = 3 % 3, sp_ = (3 + 2) % 3;
    SBAR(); qkt(pB0, pB1, K_lds + sc_ * SHM_K, qr, negm, r32, hi);
    finishSM(pA0, pA1, alA, l_reg, pa0, pa1, pa2, pa3); SBAR();
    pv_d0(o, vb0 + sp_ * SHM_V, pa0, pa1, pa2, pa3); partialSM<false>(pB0, pB1, m_reg, negm, alB);
    RESC(alB);
    finishSM(pB0, pB1, alB, l_reg, pa0, pa1, pa2, pa3); SBAR();
    pv_d0(o, vb0 + sc_ * SHM_V, pa0, pa1, pa2, pa3); }
#undef STEP
  __builtin_amdgcn_s_setprio(0);
  const float rl = __builtin_amdgcn_rcpf(l_reg);
  bf16_t* Ow = ATT + (tok0 + qb * 256 + wid * QBLK + r32) * 1024 + 512 + h * 64 + 4 * hi;
#pragma unroll
  for (int d0 = 0; d0 < 2; ++d0)
#pragma unroll
    for (int a = 0; a < 4; ++a) { u32x2 w; w.x = pkbf(o[d0][4 * a] * rl, o[d0][4 * a + 1] * rl); w.y = pkbf(o[d0][4 * a + 2] * rl, o[d0][4 * a + 3] * rl); *(u32x2*)(Ow + d0 * 32 + a * 8) = w; }
  asm volatile("s_waitcnt lgkmcnt(0)" ::: "memory");
  __syncthreads();
#undef SLOAD
#undef SWRITE
#undef SWAIT
#undef RESC
}
#undef KSWZ
#undef SBAR
}

namespace na {
constexpr int NSL = 9, OFF_K = 0, OFF_V = NSL * 8192;
__device__ __forceinline__ void stage_load(int b, int h, int kr, const bf16_t* __restrict__ PA, const bf16_t* __restrict__ VT, int tid, u32x4& kreg, u32x4& vreg) {
  const int t = tid >> 3, ch = tid & 7;
  kreg = *(const u32x4*)(PA + ((size_t)b * SEQ + kr * 64 + t) * NPA + 512 + h * 64 + ch * 8);
  vreg = *(const u32x4*)(VT + (size_t)(h * 64 + t) * M + (size_t)b * SEQ + kr * 64 + ch * 8);
}
__device__ __forceinline__ void stage_write(LAS unsigned char* lds, int kr, int tid, u32x4 kreg, u32x4 vreg) {
  const int t = tid >> 3, ch = tid & 7, slot = kr % NSL;
  *(LAS u32x4*)(lds + OFF_K + slot * 8192 + t * 128 + ((ch ^ (t & 7)) << 4)) = kreg;
  LAS unsigned char* vb = lds + OFF_V + slot * 8192 + t * 128;
  *(LAS u32x2*)(vb + (((2 * ch) ^ (t & 15)) << 3)) = (u32x2){vreg.x, vreg.y};
  *(LAS u32x2*)(vb + (((2 * ch + 1) ^ (t & 15)) << 3)) = (u32x2){vreg.z, vreg.w};
}
__device__ __forceinline__ void unit(int b, int h, int seg, const bf16_t* __restrict__ PA, const bf16_t* __restrict__ VT, bf16_t* __restrict__ ATT, const float* __restrict__ rpb_g, LAS unsigned char* lds, LAS float* rb) {
  int tid = threadIdx.x; asm volatile("" : "+v"(tid));
  const int wid = tid >> 6, lane = tid & 63, l15 = lane & 15, g = lane >> 4;
  const int w4 = wid & 3, half = wid >> 2;
  const int bs = (w4 == 0) ? 0 : (w4 == 1) ? 8 : (w4 == 2) ? 24 : 32;
  const int c = 16 * w4 + l15, cs = min(max(c - 8, 0), 48);
  const int rs = seg * 16;
  constexpr float L2E = 1.4426950408889634f;
  for (int i = tid; i < 465; i += 512) rb[i] = rpb_g[h * 465 + i] * L2E;
  int top = min(max(rs + 1 - 4, 0), 56) + 7;
  { const int lo = min(max(rs - 4, 0), 56);
#pragma unroll 1
    for (int kr = lo; kr <= top; ++kr) { u32x4 kreg, vreg; stage_load(b, h, kr, PA, VT, tid, kreg, vreg); stage_write(lds, kr, tid, kreg, vreg); } }
  bf16x8 qf[2];
  { const size_t tokq = (size_t)b * SEQ + (rs + half) * 64 + c;
#pragma unroll
    for (int ks = 0; ks < 2; ++ks) qf[ks] = *(const bf16x8*)(PA + tokq * NPA + h * 64 + ks * 32 + g * 8); }
  f32x4 bz[16]; int drprev = -9999;
  __syncthreads();
  for (int ra = rs; ra < rs + 16; ra += 2) {
    const int r = ra + half, r0 = min(max(r - 4, 0), 56);
    const bool more = (ra + 2 < rs + 16);
    const int topn = more ? min(max(ra + 3 - 4, 0), 56) + 7 : top;
    u32x4 kreg0 = {0u, 0u, 0u, 0u}, vreg0 = {0u, 0u, 0u, 0u}, kreg1 = {0u, 0u, 0u, 0u}, vreg1 = {0u, 0u, 0u, 0u}; bf16x8 qn[2] = {qf[0], qf[1]};
    if (topn >= top + 1) stage_load(b, h, top + 1, PA, VT, tid, kreg0, vreg0);
    if (topn >= top + 2) stage_load(b, h, top + 2, PA, VT, tid, kreg1, vreg1);
    if (more) { const size_t tokn = (size_t)b * SEQ + (r + 2) * 64 + c;
#pragma unroll
      for (int ks = 0; ks < 2; ++ks) qn[ks] = *(const bf16x8*)(PA + tokn * NPA + h * 64 + ks * 32 + g * 8); }
    f32x4 s[16];
#pragma unroll
    for (int j = 0; j < 8; ++j) { const int slot = (r0 + j) % NSL;
#pragma unroll
      for (int hf = 0; hf < 2; ++hf) { const int tk = bs + 16 * hf + l15; const LAS unsigned char* kb = lds + OFF_K + slot * 8192 + tk * 128;
        const bf16x8 k0 = *(const LAS bf16x8*)(kb + ((g ^ (tk & 7)) << 4)), k1 = *(const LAS bf16x8*)(kb + (((4 + g) ^ (tk & 7)) << 4));
        f32x4 a = {0.f, 0.f, 0.f, 0.f};
        a = __builtin_amdgcn_mfma_f32_16x16x32_bf16(k0, qf[0], a, 0, 0, 0);
        a = __builtin_amdgcn_mfma_f32_16x16x32_bf16(k1, qf[1], a, 0, 0, 0);
        s[j * 2 + hf] = a; } }
    const int dr = r0 - r + 7;
    if (dr != drprev) { drprev = dr;
#pragma unroll
      for (int j = 0; j < 8; ++j)
#pragma unroll
        for (int hf = 0; hf < 2; ++hf)
#pragma unroll
          for (int i = 0; i < 4; ++i) { const int cp = bs + 16 * hf + 4 * g + i; const bool ok = (cp >= cs) && (cp < cs + 16);
            bz[j * 2 + hf][i] = ok ? rb[(dr + j) * 31 + (cp - c + 15)] : -1e30f; } }
    float mx = -1e30f;
#pragma unroll
    for (int q = 0; q < 16; ++q)
#pragma unroll
      for (int i = 0; i < 4; ++i) { const float v = fmaf(s[q][i], 0.125f * L2E, bz[q][i]); s[q][i] = v; mx = fmaxf(mx, v); }
    mx = fmaxf(mx, __shfl_xor(mx, 16)); mx = fmaxf(mx, __shfl_xor(mx, 32));
    float sum = 0.f;
#pragma unroll
    for (int q = 0; q < 16; ++q)
#pragma unroll
      for (int i = 0; i < 4; ++i) { const float p = __builtin_amdgcn_exp2f(s[q][i] - mx); s[q][i] = p; sum += p; }
    sum += __shfl_xor(sum, 16); sum += __shfl_xor(sum, 32);
    const float rl = __builtin_amdgcn_rcpf(sum);
    f32x4 o[4];
#pragma unroll
    for (int db = 0; db < 4; ++db) o[db] = (f32x4){0.f, 0.f, 0.f, 0.f};
#pragma unroll
    for (int j = 0; j < 8; ++j) { const int slot = (r0 + j) % NSL;
      u32x4 pw; pw.x = pkbf(s[2 * j][0], s[2 * j][1]); pw.y = pkbf(s[2 * j][2], s[2 * j][3]); pw.z = pkbf(s[2 * j + 1][0], s[2 * j + 1][1]); pw.w = pkbf(s[2 * j + 1][2], s[2 * j + 1][3]);
      const bf16x8 pb = __builtin_bit_cast(bf16x8, pw);
      const int c8 = (bs >> 2) + g;
#pragma unroll
      for (int db = 0; db < 4; ++db) { const int d = db * 16 + l15; const LAS unsigned char* vb = lds + OFF_V + slot * 8192 + d * 128;
        const u32x2 lo = *(const LAS u32x2*)(vb + ((c8 ^ l15) << 3)), hi2 = *(const LAS u32x2*)(vb + (((c8 + 4) ^ l15) << 3));
        const u32x4 vw = {lo.x, lo.y, hi2.x, hi2.y};
        o[db] = __builtin_amdgcn_mfma_f32_16x16x32_bf16(__builtin_bit_cast(bf16x8, vw), pb, o[db], 0, 0, 0); } }
    bf16_t* op = ATT + ((size_t)b * SEQ + r * 64 + c) * 1024 + h * 64 + 4 * g;
#pragma unroll
    for (int db = 0; db < 4; ++db) { u32x2 w; w.x = pkbf(o[db][0] * rl, o[db][1] * rl); w.y = pkbf(o[db][2] * rl, o[db][3] * rl); *(u32x2*)(op + db * 16) = w; }
    __syncthreads();
    if (topn >= top + 1) stage_write(lds, top + 1, tid, kreg0, vreg0);
    if (topn >= top + 2) stage_write(lds, top + 2, tid, kreg1, vreg1);
    top = topn; qf[0] = qn[0]; qf[1] = qn[1];
    __syncthreads();
  }
}
}

#define XB_TMO      128
#define XB_XCNT(j)  (256  + 64 * (j))
#define XB_XSUB(j)  (1280 + 64 * (j))
#define XB_XGEN(j)  (2304 + 64 * (j))
#define XB_TOP      3328
#define XB_TOPGEN   3392
#define XCD_BAR_WORDS 3456
#define XB_SPIN_CAP (1u << 22)
__device__ __forceinline__ unsigned xb_ld(unsigned* p)              { return __hip_atomic_load(p, __ATOMIC_RELAXED, __HIP_MEMORY_SCOPE_AGENT); }
__device__ __forceinline__ unsigned xb_add(unsigned* p, unsigned v) { return __hip_atomic_fetch_add(p, v, __ATOMIC_RELAXED, __HIP_MEMORY_SCOPE_AGENT); }
__device__ __forceinline__ unsigned xb_xcc_id() { return (unsigned)__builtin_amdgcn_s_getreg((3 << 11) | 20) & 0xFu; }
#define XB_SPIN(cond, bar) do { unsigned _sp = 0; while (cond) { __builtin_amdgcn_s_sleep(1); \
    if ((++_sp & 255u) == 0u) { if (xb_ld(&(bar)[XB_TMO])) break; if (_sp > XB_SPIN_CAP) { atomicAdd(&(bar)[XB_TMO], 1u); break; } } } } while (0)
struct XcdBarrier { unsigned* bar; unsigned x; volatile LAS unsigned* st; };
__device__ __forceinline__ XcdBarrier xcd_barrier_post(unsigned* bar, volatile LAS unsigned* st) {
    XcdBarrier b; b.bar = bar; b.x = xb_xcc_id(); b.st = st;
    if (threadIdx.x == 0) (void)xb_add(&bar[XB_XCNT(b.x)], 1u);
    return b;
}
__device__ __forceinline__ void xcd_barrier_complete(unsigned* bar, unsigned x, unsigned& nloc, unsigned& nx) {
    const unsigned G = gridDim.x * gridDim.y * gridDim.z;
    unsigned sum, cnt, mine, sp = 0u;
    for (;;) {
        sum = 0u; cnt = 0u; mine = 0u;
#pragma unroll
        for (unsigned j = 0; j < 16; ++j) { const unsigned c = xb_ld(&bar[XB_XCNT(j)]); sum += c; cnt += (c > 0u) ? 1u : 0u; mine = (j == x) ? c : mine; }
        if (sum == G) break;
        __builtin_amdgcn_s_sleep(1);
        if ((++sp & 255u) == 0u) { if (xb_ld(&bar[XB_TMO])) break; if (sp > XB_SPIN_CAP) { atomicAdd(&bar[XB_TMO], 1u); break; } }
    }
    nloc = mine > 0u ? mine : 1u; nx = cnt > 0u ? cnt : 1u;
}
__device__ __forceinline__ void xcd_barrier(const XcdBarrier& b) {
    asm volatile("s_waitcnt vmcnt(0)" ::: "memory");
    __syncthreads();
    if (threadIdx.x == 0) {
        unsigned* bar = b.bar;
        __builtin_amdgcn_s_waitcnt(0);
        unsigned nloc = b.st[0], nx = b.st[1];
        if (nloc == 0u) { xcd_barrier_complete(bar, b.x, nloc, nx); b.st[0] = nloc; b.st[1] = nx; }
        const unsigned old = xb_add(&bar[XB_XSUB(b.x)], 1u);
        const unsigned gen = old / nloc;
        if (old + 1u == (gen + 1u) * nloc) {
            __builtin_amdgcn_fence(__ATOMIC_RELEASE, "agent");
            asm volatile("s_waitcnt vmcnt(0)" ::: "memory");
            const unsigned og = xb_add(&bar[XB_TOP], 1u);
            const unsigned tg = og / nx;
            if (og + 1u == (tg + 1u) * nx) xb_add(&bar[XB_TOPGEN], 1u);
            else XB_SPIN(xb_ld(&bar[XB_TOPGEN]) == tg, bar);
            __builtin_amdgcn_fence(__ATOMIC_ACQUIRE, "agent");
            xb_add(&bar[XB_XGEN(b.x)], 1u);
            asm volatile("s_waitcnt vmcnt(0)" ::: "memory");
        } else {
            XB_SPIN(xb_ld(&bar[XB_XGEN(b.x)]) == gen, bar);
            __builtin_amdgcn_fence(__ATOMIC_ACQUIRE, "agent");
            asm volatile("s_waitcnt vmcnt(0)" ::: "memory");
        }
    }
    __syncthreads();
}

struct TrTile { f32x4 v[8]; };
__device__ __forceinline__ void tr_load(const float* __restrict__ W, int ldw, int k0, int n0, int lane, TrTile& t, const float* __restrict__ gain = nullptr) {
#pragma unroll
    for (int i = 0; i < 8; ++i) { t.v[i] = *(const f32x4*)(W + (size_t)(k0 + (lane >> 3) + 8 * i) * ldw + n0 + 4 * (lane & 7)); if (gain) t.v[i] = t.v[i] * gain[k0 + (lane >> 3) + 8 * i]; }
}
__device__ __forceinline__ void tr_store(const TrTile& t, int k0, bf16_t* __restrict__ WT, int ldt, int drow0, LAS float* scr, int lane) {
#pragma unroll
    for (int i = 0; i < 8; ++i) { LAS float* d = scr + ((lane >> 3) + 8 * i) * 33 + 4 * (lane & 7); d[0] = t.v[i][0]; d[1] = t.v[i][1]; d[2] = t.v[i][2]; d[3] = t.v[i][3]; }
    LDS_WAIT(); asm volatile("" ::: "memory");
    const int c = lane & 7;
#pragma unroll
    for (int j = 0; j < 4; ++j) { const int n = (lane >> 3) + 8 * j; const LAS float* s = scr + (8 * c) * 33 + n;
        u32x4 o; o.x = pkbf(s[0 * 33], s[1 * 33]); o.y = pkbf(s[2 * 33], s[3 * 33]); o.z = pkbf(s[4 * 33], s[5 * 33]); o.w = pkbf(s[6 * 33], s[7 * 33]);
        *(u32x4*)(WT + (size_t)(drow0 + n) * ldt + k0 + 8 * c) = o; }
    LDS_WAIT(); asm volatile("" ::: "memory");
}
__device__ __forceinline__ void tr_item(const float* __restrict__ W, int ldw, int k0, int n0, bf16_t* __restrict__ WT, int ldt, int drow0, LAS float* scr, int lane, const float* __restrict__ gain = nullptr) {
    TrTile t; tr_load(W, ldw, k0, n0, lane, t, gain); tr_store(t, k0, WT, ldt, drow0, scr, lane);
}
template <int MODE>
__device__ __forceinline__ void row_pass(const float* xbase, bf16_t* xbbase, float* rsbase, const float* gain, float* obase, int m0, int NGW, int lane) {
    constexpr int R = 4;
    for (int m = m0; m < M; m += R * NGW) {
        f32x4 v[R][4]; float s[R];
#pragma unroll
        for (int r = 0; r < R; ++r) { const int mm = min(m + r * NGW, M - 1);
#pragma unroll
            for (int j = 0; j < 4; ++j) {
                if (MODE == 0) v[r][j] = ((const f32x4*)(xbase + (size_t)mm * DM) + lane)[64 * j];
                else { const u32x2 w = ((const u32x2*)(xbbase + (size_t)mm * DM) + lane)[64 * j]; v[r][j] = (f32x4){bf_lo(w.x), bf_hi(w.x), bf_lo(w.y), bf_hi(w.y)}; } } }
#pragma unroll
        for (int r = 0; r < R; ++r) { const int mm = min(m + r * NGW, M - 1); float a = 0.f;
#pragma unroll
            for (int j = 0; j < 4; ++j) {
                if (MODE == 0) { u32x2 w; w.x = pkbf(v[r][j][0], v[r][j][1]); w.y = pkbf(v[r][j][2], v[r][j][3]); ((u32x2*)(xbbase + (size_t)mm * DM) + lane)[64 * j] = w; }
                a += (v[r][j][0] * v[r][j][0] + v[r][j][1] * v[r][j][1]) + (v[r][j][2] * v[r][j][2] + v[r][j][3] * v[r][j][3]); }
            s[r] = a; }
#pragma unroll
        for (int r = 0; r < R; ++r) { const int mm = min(m + r * NGW, M - 1); const float rstd = 1.f / sqrtf(wave_sum(s[r]) * (1.f / DM) + RMS_EPS);
            if (MODE != 2) { if (lane == 0) rsbase[mm] = rstd; }
            else {
#pragma unroll
                for (int j = 0; j < 4; ++j) ((f32x4*)(obase + (size_t)mm * DM) + lane)[64 * j] = v[r][j] * rstd * ((const f32x4*)gain + lane)[64 * j]; } }
    }
}

__device__ __forceinline__ void topk_item(int b, int e, const float* __restrict__ AFF, int* __restrict__ IDXR, float* __restrict__ VALR, int* __restrict__ SLOT, const float* __restrict__ RS2, float* __restrict__ RSR, LAS unsigned* sh, int tid, int lane, int wave) {
    unsigned u[8];
    const float* src = AFF + ((size_t)(b * SEQ + tid * 8)) * 16 + e;
#pragma unroll
    for (int i = 0; i < 8; ++i) u[i] = __float_as_uint(src[i * 16]);
    LAS unsigned* hist = sh; LAS unsigned* misc = sh + 256;
    unsigned prefix = 0u, mask = 0u, kth = CAP;
    for (int pass = 0; pass < 4; ++pass) {
        const int shift = 24 - 8 * pass;
        if (tid < 256) hist[tid] = 0u;
        __syncthreads();
#pragma unroll
        for (int i = 0; i < 8; ++i) if ((u[i] & mask) == prefix) (void)__hip_atomic_fetch_add(&hist[(u[i] >> shift) & 255u], 1u, __ATOMIC_RELAXED, __HIP_MEMORY_SCOPE_WORKGROUP);
        __syncthreads();
        if (wave == 0) {
            const unsigned h0 = hist[4 * lane], h1 = hist[4 * lane + 1], h2 = hist[4 * lane + 2], h3 = hist[4 * lane + 3];
            const unsigned sl = h0 + h1 + h2 + h3;
            unsigned inc = sl;
#pragma unroll
            for (int o = 1; o < 64; o <<= 1) { const unsigned t = __shfl_down(inc, o); if (lane + o < 64) inc += t; }
            const unsigned exc = inc - sl;
            if (exc < kth && kth <= inc) {
                unsigned cc = exc; int dsel;
                if (cc + h3 >= kth) dsel = 3; else { cc += h3; if (cc + h2 >= kth) dsel = 2; else { cc += h2; if (cc + h1 >= kth) dsel = 1; else { cc += h1; dsel = 0; } } }
                misc[0] = (unsigned)(4 * lane + dsel); misc[1] = kth - cc;
            }
        }
        __syncthreads();
        prefix |= misc[0] << shift; mask |= 255u << shift; kth = misc[1];
    }
    const unsigned T = prefix, need = kth;
    unsigned ng = 0u, neq = 0u;
#pragma unroll
    for (int i = 0; i < 8; ++i) { ng += (u[i] > T) ? 1u : 0u; neq += (u[i] == T) ? 1u : 0u; }
    const unsigned packed = ng | (neq << 16);
    unsigned inc = packed;
#pragma unroll
    for (int o = 1; o < 64; o <<= 1) { const unsigned t = __shfl_up(inc, o); if (lane >= o) inc += t; }
    __syncthreads();
    if (lane == 63) misc[2 + wave] = inc;
    __syncthreads();
    unsigned woff = 0u;
#pragma unroll
    for (int w = 0; w < 8; ++w) if (w < wave) woff += misc[2 + w];
    const unsigned exc = woff + inc - packed;
    unsigned gpos = exc & 0xffffu, epos = exc >> 16;
    const unsigned total_gt = CAP - need;
#pragma unroll
    for (int i = 0; i < 8; ++i) { const int t = tid * 8 + i; int slot = -1;
        if (u[i] > T) slot = (int)(gpos++);
        else if (u[i] == T) { if (epos < need) slot = (int)(total_gt + epos); epos++; }
        SLOT[(size_t)(b * SEQ + t) * 16 + e] = slot;
        if (slot >= 0) { const int rr = (e * NB + b) * CAP + slot; IDXR[rr] = b * SEQ + t; VALR[rr] = __uint_as_float(u[i]); RSR[rr] = RS2[b * SEQ + t]; } }
    __syncthreads();
}

struct Args { const float* in[24]; int ph_lo, ph_hi; };
constexpr int NPH = 14, NPHASES = 1 + NLAYER * NPH;

__global__ void __launch_bounds__(512, 2) fwd(Args a) {
    extern __shared__ __attribute__((aligned(16))) unsigned char lds_raw[];
    LAS unsigned char* lds = (LAS unsigned char*)lds_raw;
    const int G = gridDim.x, bx = blockIdx.x;
    const int vcu = (G % 8 == 0) ? (bx % 8) * (G / 8) + bx / 8 : bx;
    const int NGW = G * 8;
    const __attribute__((address_space(4))) char* kargs = (const __attribute__((address_space(4))) char*)__builtin_amdgcn_kernarg_segment_ptr();
    unsigned char* ws = (unsigned char*)a.in[22];
    volatile LAS unsigned* MISC = (volatile LAS unsigned*)(lds + LDSCTL_OFF);
    for (int u = threadIdx.x; u < (LDS_BYTES - LDSCTL_OFF) / 4; u += 512) ((LAS unsigned*)(lds + LDSCTL_OFF))[u] = 0u;
    __syncthreads();
    const int lo = a.ph_lo, hi = a.ph_hi;
    XcdBarrier bar; bar.bar = (unsigned*)(ws + WS_CTL) + CW_BAR; bar.x = 0; bar.st = nullptr;
    if (hi - lo > 1) bar = xcd_barrier_post((unsigned*)(ws + WS_CTL) + CW_BAR, MISC + 8);
#define IN(k) (lo <= (k) && (k) < hi)
    unsigned long long pt_acc = 0ull, pt_t0 = 0ull;
#define PT_BEGIN(k) do { if (PROBE_T == (k)) { pt_t0 = __builtin_amdgcn_s_memrealtime(); } } while (0)
#define PT_END(k) do { if (PROBE_T == (k)) { pt_acc += __builtin_amdgcn_s_memrealtime() - pt_t0; } } while (0)
#define SEAM(k) do { if (IN(k) && IN((k) + 1)) xcd_barrier(bar); } while (0)

#define ARGP(k) ({ const __attribute__((address_space(4))) char* kq_ = kargs; asm volatile("" : "+s"(kq_)); (const float*)(GAS const float*)(*(const float* const __attribute__((address_space(4)))*)(kq_ + 8 * (k))); })
#define WSP(T, off) ((T*)(wsq + (off)))
#define REP(k) for (int rep_ = 0, nrep_ = ({ int n_ = (PROBE_PH == (k)) ? 2 : 1; asm volatile("" : "+s"(n_)); n_; }); rep_ < nrep_; ++rep_)
#define PHASE_PTRS() int tid = threadIdx.x; asm volatile("" : "+v"(tid)); const int lane = tid & 63, wave = __builtin_amdgcn_readfirstlane(tid >> 6); const int gw = vcu * 8 + wave; (void)lane; (void)gw; \
    unsigned char* wsq = (unsigned char*)ARGP(22); float* X = (float*)ARGP(21); \
    bf16_t* H = (l & 1) ? (bf16_t*)X : WSP(bf16_t, WS_H); bf16_t* Hn = (l & 1) ? WSP(bf16_t, WS_H) : (bf16_t*)X; (void)Hn;     \
    float* RSR = WSP(float, WS_RSR); float* RS1 = WSP(float, WS_RS1); float* RS2 = WSP(float, WS_RS2); float* RS3 = WSP(float, WS_RS3); (void)RSR; (void)RS1; (void)RS2; (void)RS3; float* TAB = WSP(float, WS_TAB); float* AFF = WSP(float, WS_AFF); int* SLOT = WSP(int, WS_SLOT); int* IDXR = WSP(int, WS_IDXR); float* VALR = WSP(float, WS_VALR); \
    bf16_t* KPE = WSP(bf16_t, WS_KPE); bf16_t* PROJA = WSP(bf16_t, R_PROJA); bf16_t* GATES = WSP(bf16_t, R_GATES); bf16_t* VT = WSP(bf16_t, R_VT); bf16_t* Qb = WSP(bf16_t, R_Q); bf16_t* KVb = WSP(bf16_t, R_KV); \
    bf16_t* ATT = WSP(bf16_t, R_ATT); bf16_t* MERGED = WSP(bf16_t, R_MERGED); bf16_t* XG = WSP(bf16_t, R_XG); bf16_t* MOEOUT = WSP(bf16_t, R_MOEOUT); bf16_t* ACT = WSP(bf16_t, R_ACT); \
    bf16_t* W13 = WSP(bf16_t, R_W13); bf16_t* W2T = WSP(bf16_t, R_W2T); bf16_t* PBF = WSP(bf16_t, R_PBF); bf16_t* PE = WSP(bf16_t, R_PE); \
    const bf16_t* wl = (const bf16_t*)(wsq + WS_WSM + (size_t)l * WSM_STRIDE); \
    (void)H; (void)TAB; (void)AFF; (void)SLOT; (void)IDXR; (void)VALR; (void)KPE; (void)PROJA; (void)GATES; (void)VT; (void)Qb; (void)KVb; (void)ATT; (void)MERGED; (void)XG; (void)MOEOUT; (void)ACT; (void)W13; (void)W2T; (void)PBF; (void)PE; (void)wl; (void)X

    PT_BEGIN(100);
    if (IN(0)) {
        const int l = 0; PHASE_PTRS(); const float* x_in = ARGP(0);
        LAS float* scr = (LAS float*)(lds + wave * 16384);
        for (int it = gw; it < 2 * 4064; it += NGW) {
            const int l = it / 4064; int r = it % 4064;
            bf16_t* wl = (bf16_t*)(wsq + WS_WSM + (size_t)l * WSM_STRIDE);
            if (r < 2128) { const int kb = r / 133, nb = r % 133, n0 = nb * 32; bf16_t* dst; int dr;
                if (n0 < 1024) { dst = wl + OFF_WIN; dr = n0; } else if (n0 < 1536) { dst = wl + OFF_WV; dr = n0 - 1024; } else if (n0 < 2208) { dst = wl + OFF_WIN; dr = n0 - 512; } else { dst = wl + OFF_WIN; dr = n0 - 416; }
                tr_item(ARGP(3) + (size_t)l * 1024 * IN_COLS, IN_COLS, kb * 64, n0, dst, 1024, dr, scr, lane, ARGP(2) + l * 1024); continue; } r -= 2128;
            if (r < 144) { tr_item(ARGP(6) + (size_t)l * 384 * 768, 768, (r / 24) * 64, (r % 24) * 32, wl + OFF_WQ, 384, (r % 24) * 32, scr, lane, ARGP(5) + l * 384); continue; } r -= 144;
            if (r < 128) { tr_item(ARGP(8) + (size_t)l * 256 * 1024, 1024, (r / 32) * 64, (r % 32) * 32, wl + OFF_WKV, 256, (r % 32) * 32, scr, lane, ARGP(7) + l * 256); continue; } r -= 128;
            if (r < 256) { tr_item(ARGP(9) + (size_t)l * 512 * 1024, 1024, (r / 32) * 64, (r % 32) * 32, wl + OFF_WNAO, 1024, (r % 32) * 32, scr, lane); continue; } r -= 256;
            if (r < 256) { tr_item(ARGP(10) + (size_t)l * 512 * 1024, 1024, (r / 32) * 64, (r % 32) * 32, wl + OFF_WNAO + 512, 1024, (r % 32) * 32, scr, lane); continue; } r -= 256;
            if (r < 512) { tr_item(ARGP(11) + (size_t)l * 1024 * 1024, 1024, (r / 32) * 64, (r % 32) * 32, wl + OFF_WOUT, 1024, (r % 32) * 32, scr, lane); continue; } r -= 512;
            if (r < 512) { tr_item(ARGP(18) + (size_t)l * 1024 * 1024, 1024, (r / 32) * 64, (r % 32) * 32, wl + OFF_WPG, 1024, (r % 32) * 32, scr, lane, ARGP(17) + l * 1024); continue; } r -= 512;
            tr_item(ARGP(19) + (size_t)l * 256 * 1024, 1024, (r / 32) * 64, (r % 32) * 32, wl + OFF_WPW, 256, (r % 32) * 32, scr, lane);
        }
        for (int i = bx * 512 + tid; i < 2 * 96 * 128; i += G * 512) { const int l = i / (96 * 128), r = i % (96 * 128);
            bf16_t* wl = (bf16_t*)(wsq + WS_WSM + (size_t)l * WSM_STRIDE) + OFF_WIN + (size_t)1696 * 1024; *(u32x4*)(wl + (size_t)r * 8) = (u32x4){0u, 0u, 0u, 0u}; }
        if (bx == 0) { const int pos = tid >> 3, j = tid & 7; const float f = exp2f(-(float)j * 1.6609640474436813f); const float rev = (float)pos * f * 0.15915494309189535f; const float fr = rev - floorf(rev);
            TAB[tid * 2] = __builtin_amdgcn_cosf(fr); TAB[tid * 2 + 1] = __builtin_amdgcn_sinf(fr); }
        row_pass<0>(x_in, H, RS1, nullptr, nullptr, gw, NGW, lane);
    }
    SEAM(0);
    PT_END(100);

    for (int l = 0; l < NLAYER; ++l) {
        const int pb = 1 + l * NPH; int pf_ns0 = -1, pf_ns1 = -1;
        PT_BEGIN(0);
        if (IN(pb + 0)) { PHASE_PTRS();
            int Gq = G; asm volatile("" : "+s"(Gq));
            if (Gq == 256) {
              const float tb0 = TAB[tid], tb1 = TAB[tid + 512];
              { pg8::Gemm g{H, wl + OFF_WIN, 1024, 1024, 1024}; pg8::Gemm g2{wl + OFF_WV, H, 1024, 1024, 1024}; pg8::G1vTOrder S; S.A.c = bx; S.V.init(512, M, G, bx);
                pg8::EpiInProj E{PROJA, GATES, RS1}; pg8::EpiPlain E2{VT, M, 1 << 20, RS1};
                pg8::gemm_phase<pg8::EpiInProj, pg8::G1vTOrder, false, false, true, pg8::EpiPlain>(lds, g, S, E, nullptr, g2, E2); }
              int bxq = bx; asm volatile("" : "+s"(bxq));
              if (pg8::G1Order::type_a(bxq)) { const int p = pg8::G1Order::idx(bxq);
                LAS float* ltab = (LAS float*)(lds + LDSCTL_OFF + 9216);
                ltab[tid] = tb0; ltab[tid + 512] = tb1;
                __builtin_amdgcn_fence(__ATOMIC_RELEASE, "workgroup"); __syncthreads(); __builtin_amdgcn_fence(__ATOMIC_ACQUIRE, "workgroup");
                LAS float* rq = (LAS float*)(lds + LDSCTL_OFF + 1024); LAS float* rk = (LAS float*)(lds + LDSCTL_OFF + 5120);
                pg8::panel_rstd2_lds<384, 256>(PROJA, NPA, PROJ_QLAT, PROJ_KVLAT, p, rq, rk, tid);
                __syncthreads();
                { pg8::SliceOrder S{p, 0, 3}; pg8::Gemm g{PROJA + PROJ_QLAT, wl + OFF_WQ, NPA, 384, 384}; pg8::EpiQRope E{Qb, ltab, pg8::RsTab{rq, p, -1, -1, -1}};
                  pg8::gemm_phase(lds, g, S, E); }
                { pg8::SliceOrder S{p, 0, 4}; pg8::Gemm g{PROJA + PROJ_KVLAT, wl + OFF_WKV, NPA, 256, 256}; pg8::EpiKV E{KVb, PROJA, KPE, ltab, pg8::RsTab{rk, p, -1, -1, -1}};
                  pg8::gemm_phase(lds, g, S, E); } }
            } else {
              int bxf = bx; asm volatile("" : "+s"(bxf));
              { pg8::Gemm g{H, wl + OFF_WIN, 1024, 1024, 1024}; pg8::StaticOrder S; S.init(M, NINP, G, bxf); pg8::EpiInProj E{PROJA, GATES, RS1};
                pg8::gemm_phase(lds, g, S, E); }
              { pg8::Gemm g{wl + OFF_WV, H, 1024, 1024, 1024}; pg8::StaticOrder S; S.init(512, M, G, bxf); pg8::EpiPlain E{VT, M, 1 << 20, RS1};
                pg8::gemm_phase(lds, g, S, E); }
            }
        }
        SEAM(pb + 0);
        PT_END(0);
        PT_BEGIN(2);
        int Gq2 = G; asm volatile("" : "+s"(Gq2));
        if (IN(pb + 2) && Gq2 != 256) { PHASE_PTRS();
            LAS float* ltab = (LAS float*)(lds + LDSCTL_OFF + 9216);
            for (int i = tid; i < 1024; i += 512) ltab[i] = TAB[i];
#pragma unroll 1
            for (int vv = vcu; vv < 2 * (M / 256); vv += G) {
              const int v = __builtin_amdgcn_readfirstlane(vv), p = v >> 1, hlf = v & 1;
              LAS float* rq = (LAS float*)(lds + LDSCTL_OFF + 1024); LAS float* rk = (LAS float*)(lds + LDSCTL_OFF + 5120);
              pg8::panel_rstd2_lds<384, 256>(PROJA, NPA, PROJ_QLAT, PROJ_KVLAT, p, rq, rk, tid);
              __syncthreads();
              { pg8::SliceOrder S{p, hlf ? 2 : 0, hlf ? 1 : 2}; pg8::Gemm g{PROJA + PROJ_QLAT, wl + OFF_WQ, NPA, 384, 384}; pg8::EpiQRope E{Qb, ltab, pg8::RsTab{rq, p, -1, -1, -1}};
                pg8::gemm_phase(lds, g, S, E); }
              { pg8::SliceOrder S{p, hlf ? 1 : 0, hlf ? 3 : 1}; pg8::Gemm g{PROJA + PROJ_KVLAT, wl + OFF_WKV, NPA, 256, 256}; pg8::EpiKV E{KVb, PROJA, KPE, ltab, pg8::RsTab{rk, p, -1, -1, -1}};
                pg8::gemm_phase(lds, g, S, E); }
              __syncthreads();
            }
        }
        if (Gq2 != 256) SEAM(pb + 2);
        PT_END(2);
        PT_BEGIN(3);
        if (IN(pb + 3)) { PHASE_PTRS();
            REP(100)
            { const int upb = (1024 + G - 1) / G;
              for (int i = 0; i < upb; ++i) { const int grp = vcu >> 4, ngrp = (G + 15) >> 4; const int bh = grp + i * ngrp, qb = vcu & 15; if (bh >= 64) break; mla::unit(bh >> 3, bh & 7, qb, Qb, KVb, KPE, ATT, lds); } }
            { LAS float* rb = (LAS float*)(lds + LDSCTL_OFF + 1024); const float* rpb_g = ARGP(4) + l * 8 * 465;
              REP(101)
              for (int u = vcu; u < 256; u += G) na::unit(u >> 5, (u >> 2) & 7, u & 3, PROJA, VT, ATT, rpb_g, lds, rb); }
        }
        SEAM(pb + 3);
        PT_END(3);
        PT_BEGIN(4);
        if (IN(pb + 4)) { PHASE_PTRS();
            REP(4) {
            { pg8::Gemm g{ATT, wl + OFF_WNAO, 1024, 1024, 1024}; pg8::StaticOrder S; S.init(M, 1024, G, bx); pg8::EpiGate2 E{GATES, MERGED};
              pg8::gemm_phase<pg8::EpiGate2, pg8::StaticOrder, false, true>(lds, g, S, E); }
            }
        }
        SEAM(pb + 4);
        PT_END(4);
        PT_BEGIN(5);
        if (IN(pb + 5)) { PHASE_PTRS();
            pg8::Gemm g{MERGED, wl + OFF_WOUT, 1024, 1024, 1024}; pg8::StaticOrder S; S.init(M, 1024, G, bx); pg8::EpiResid E{H};
            pg8::gemm_phase(lds, g, S, E);
        }
        SEAM(pb + 5);
        PT_END(5);
        PT_BEGIN(6);
        if (IN(pb + 6)) { PHASE_PTRS();
            REP(6) {
            LAS bf16_t* WH = (LAS bf16_t*)lds; LAS bf16_t* WL = (LAS bf16_t*)(lds + 16 * 2064);
            { const float* wrg = ARGP(13) + (size_t)l * 1024 * 16 + tid * 32; const float* gain = ARGP(12) + l * 1024 + tid * 2;
              f32x4 rw[8];
#pragma unroll
              for (int j = 0; j < 8; ++j) rw[j] = *(const f32x4*)(wrg + 4 * j);
              const float rg0 = gain[0], rg1 = gain[1];
#pragma unroll
              for (int j = 0; j < 8; ++j)
#pragma unroll
                for (int q = 0; q < 4; ++q) { const int k = tid * 2 + (j >> 2), e = (4 * j + q) & 15; const float w = rw[j][q] * ((j < 4) ? rg0 : rg1);
                    const unsigned hb = pkbf(w, 0.f) & 0xffffu; const float rem = w - __uint_as_float(hb << 16);
                    WH[e * 1032 + k] = (bf16_t)hb; WL[e * 1032 + k] = (bf16_t)(pkbf(rem, 0.f) & 0xffffu); } }
            __syncthreads();
            const int l15 = lane & 15, g = lane >> 4;
            for (int rb = gw; rb < M / 16; rb += NGW) {
                const bf16_t* xp = H + (size_t)(rb * 16 + l15) * DM + 8 * g;
                const LAS unsigned char* whp = (const LAS unsigned char*)WH + l15 * 2064 + 16 * g; const LAS unsigned char* wlp = (const LAS unsigned char*)WL + l15 * 2064 + 16 * g;
                f32x4 ah = {0.f, 0.f, 0.f, 0.f}, al = {0.f, 0.f, 0.f, 0.f}; float ss = 0.f;
#pragma unroll 1
                for (int s0 = 0; s0 < 32; s0 += 8) {
                    u32x4 xa[8];
#pragma unroll
                    for (int q = 0; q < 8; ++q) xa[q] = *(const u32x4*)(xp + (s0 + q) * 32);
#pragma unroll
                    for (int q = 0; q < 8; ++q) { const u32x4 w = xa[q];
                        ss += bf_lo(w.x) * bf_lo(w.x) + bf_hi(w.x) * bf_hi(w.x) + bf_lo(w.y) * bf_lo(w.y) + bf_hi(w.y) * bf_hi(w.y) + bf_lo(w.z) * bf_lo(w.z) + bf_hi(w.z) * bf_hi(w.z) + bf_lo(w.w) * bf_lo(w.w) + bf_hi(w.w) * bf_hi(w.w);
                        const bf16x8 bh = *(const LAS bf16x8*)(whp + (s0 + q) * 64), bl = *(const LAS bf16x8*)(wlp + (s0 + q) * 64);
                        ah = __builtin_amdgcn_mfma_f32_16x16x32_bf16(__builtin_bit_cast(bf16x8, w), bh, ah, 0, 0, 0);
                        al = __builtin_amdgcn_mfma_f32_16x16x32_bf16(__builtin_bit_cast(bf16x8, w), bl, al, 0, 0, 0); } }
                ss += __shfl_xor(ss, 16); ss += __shfl_xor(ss, 32);
                const float rstd = 1.f / sqrtf(ss * (1.f / DM) + RMS_EPS);
                if (g == 0) RS2[rb * 16 + l15] = rstd;
#pragma unroll
                for (int i = 0; i < 4; ++i) { const float rr = __shfl(rstd, 4 * g + i); const float lg = (ah[i] + al[i]) * rr;
                    float mx = lg;
#pragma unroll
                    for (int o = 1; o < 16; o <<= 1) mx = fmaxf(mx, __shfl_xor(mx, o));
                    const float ex = __expf(lg - mx); float se = ex;
#pragma unroll
                    for (int o = 1; o < 16; o <<= 1) se += __shfl_xor(se, o);
                    AFF[(size_t)(rb * 16 + 4 * g + i) * 16 + l15] = ex / se; }
            }
            __syncthreads();
            }
        }
        SEAM(pb + 6);
        PT_END(6);
        PT_BEGIN(7);
        if (IN(pb + 7)) { PHASE_PTRS();
            REP(7) {
            LAS unsigned* sh = (LAS unsigned*)(lds + 9216);
            for (int it = bx; it < NB * NE; it += G) topk_item(it >> 4, it & 15, AFF, IDXR, VALR, SLOT, RS2, RSR, sh, tid, lane, wave);
            LAS float* scr = (LAS float*)(lds + wave * 16384);
            { const float* w1g = ARGP(14); const float* w3g = ARGP(15); const float* w2g = ARGP(16); const float* gmoe = ARGP(12) + l * 1024;
#define MOE_SRC(it_) ((((it_) >> 13) == 0 ? w1g : ((it_) >> 13) == 1 ? w3g : w2g) + (size_t)(l * 16 + (((it_) & 8191) >> 9)) * 1024 * 1024)
#define MOE_LOAD(T_, it_) tr_load(MOE_SRC(it_), 1024, (((it_) >> 5) & 15) * 64, ((it_) & 31) * 32, lane, T_, ((it_) >> 13) == 2 ? (const float*)nullptr : gmoe)
#define MOE_STORE(T_, it_) do { const int which_ = (it_) >> 13, e_ = ((it_) & 8191) >> 9, k0_ = (((it_) >> 5) & 15) * 64, n0_ = ((it_) & 31) * 32; \
                  if (which_ == 2) tr_store(T_, k0_, W2T + (size_t)e_ * 1024 * 1024, 1024, n0_, scr, lane); \
                  else tr_store(T_, k0_, W13 + (size_t)e_ * 2048 * 1024, 1024, (n0_ >> 7) * 256 + which_ * 128 + (n0_ & 127), scr, lane); } while (0)
              if (G == 256) { const bool tk = bx < 128; const int wv = (bx & 127) * 8 + wave, lo_ = tk ? 0 : 10240, hi_ = tk ? 10240 : 3 * 8192;
                  for (int it = lo_ + wv; it < hi_; it += 1024) { TrTile ta; MOE_LOAD(ta, it); MOE_STORE(ta, it); } }
              else for (int it = gw; it < 3 * 8192; it += NGW) { TrTile ta; MOE_LOAD(ta, it); MOE_STORE(ta, it); }
#undef MOE_LOAD
#undef MOE_STORE
#undef MOE_SRC
            }
            const float* pl = ARGP(1) + (size_t)l * M * 256;
            for (size_t i = (size_t)bx * 512 + tid; i < (size_t)M * 256 / 8; i += (size_t)G * 512) { const f32x4 a0 = *(const f32x4*)(pl + i * 8), a1 = *(const f32x4*)(pl + i * 8 + 4);
                u32x4 w; w.x = pkbf(a0[0], a0[1]); w.y = pkbf(a0[2], a0[3]); w.z = pkbf(a1[0], a1[1]); w.w = pkbf(a1[2], a1[3]); *(u32x4*)(PBF + i * 8) = w; }
            }
        }
        SEAM(pb + 7);
        PT_END(7);
        PT_BEGIN(9);
        if (IN(pb + 9)) { PHASE_PTRS();
            float tr0 = 0.f, tr1 = 0.f;
            if (tid < 256 && vcu < MR / 256) { tr0 = RSR[vcu * 256 + tid]; tr1 = VALR[vcu * 256 + tid]; }
            if ((vcu & 1) == 0) { pg8::Gemm g{PBF, wl + OFF_WPW, 256, 256, 256}; pg8::StaticOrder S; S.init(M, 1024, G, bx); pg8::EpiPlain E{PE, 1024, 1 << 20, nullptr};
              pg8::gemm_phase(lds, g, S, E); }
            REP(9) {
            LAS float* tabr = (LAS float*)(lds + LDSCTL_OFF + 1024);
            if (tid < 256 && vcu < MR / 256) { tabr[tid] = tr0; tabr[256 + tid] = tr1; }
            __syncthreads();
            { pg8::Gemm g{H, W13, 1024, 1024, 1024, IDXR}; pg8::PanelOrder S; S.init(3, G, vcu, MR / 256); pg8::EpiSwiGLU E{ACT, RSR, tabr};
#if PROBE_T == 200 || PROBE_T == 201
              unsigned long long ptv[2] = {pt_acc, __builtin_amdgcn_s_memrealtime()};
              pg8::gemm_phase<pg8::EpiSwiGLU, pg8::PanelOrder, true>(lds, g, S, E, ptv); pt_acc = ptv[0]; }
#else
              pg8::gemm_phase<pg8::EpiSwiGLU, pg8::PanelOrder, true>(lds, g, S, E); }
#endif
            __builtin_amdgcn_fence(__ATOMIC_RELEASE, "workgroup"); __syncthreads(); __builtin_amdgcn_fence(__ATOMIC_ACQUIRE, "workgroup");
            { pg8::Gemm g{ACT, W2T, 1024, 1024, 1024}; pg8::PanelOrder S; S.init(2, G, vcu, MR / 256); pg8::EpiMoeDown E{MOEOUT, VALR, tabr + 256};
              pg8::gemm_phase(lds, g, S, E); }
            }
            if ((vcu & 1) == 1) { pg8::Gemm g{PBF, wl + OFF_WPW, 256, 256, 256}; pg8::StaticOrder S; S.init(M, 1024, G, bx); pg8::EpiPlain E{PE, 1024, 1 << 20, nullptr};
              pg8::gemm_phase(lds, g, S, E); }
            pf_ns0 = (gw < M) ? SLOT[(size_t)gw * 16 + (lane & 15)] : -1; pf_ns1 = (gw + NGW < M) ? SLOT[(size_t)(gw + NGW) * 16 + (lane & 15)] : -1;
        }
        SEAM(pb + 9);
        PT_END(9);
        PT_BEGIN(11);
        if (IN(pb + 11)) { PHASE_PTRS();
            int ns0, ns1;
            if (IN(pb + 9)) { ns0 = pf_ns0; ns1 = pf_ns1; }
            else { ns0 = (gw < M) ? SLOT[(size_t)gw * 16 + (lane & 15)] : -1; ns1 = (gw + NGW < M) ? SLOT[(size_t)(gw + NGW) * 16 + (lane & 15)] : -1; }
            for (int m = gw; m < M; m += 2 * NGW) {
                const int sl0 = ns0, sl1 = ns1; const bool has1 = (m + NGW < M); const int m1 = has1 ? m + NGW : m;
                if (m + 2 * NGW < M) ns0 = SLOT[(size_t)(m + 2 * NGW) * 16 + (lane & 15)];
                if (m + 3 * NGW < M) ns1 = SLOT[(size_t)(m + 3 * NGW) * 16 + (lane & 15)];
                u32x2* xr0 = (u32x2*)(H + (size_t)m * DM) + lane; u32x2* xr1 = (u32x2*)(H + (size_t)m1 * DM) + lane;
                u32x2 xw0[4], xw1[4];
#pragma unroll
                for (int j = 0; j < 4; ++j) { xw0[j] = xr0[64 * j]; xw1[j] = xr1[64 * j]; }
                unsigned bal0 = (unsigned)(__ballot(sl0 >= 0) & 0xffffull), bal1 = has1 ? (unsigned)(__ballot(sl1 >= 0) & 0xffffull) : 0u;
                const int b0 = m >> 12, b1 = m1 >> 12;
                const u32x2* rp0[4]; const u32x2* rp1[4]; float wg0[4], wg1[4];
#pragma unroll
                for (int k = 0; k < 4; ++k) { int e = 0, c = 0; wg0[k] = 0.f;
                    if (bal0) { e = __builtin_ctz(bal0); bal0 &= bal0 - 1u; c = __builtin_amdgcn_readlane(sl0, e); wg0[k] = 1.f; }
                    rp0[k] = (const u32x2*)(MOEOUT + (size_t)((e * NB + b0) * CAP + c) * DM) + lane;
                    e = 0; c = 0; wg1[k] = 0.f;
                    if (bal1) { e = __builtin_ctz(bal1); bal1 &= bal1 - 1u; c = __builtin_amdgcn_readlane(sl1, e); wg1[k] = 1.f; }
                    rp1[k] = (const u32x2*)(MOEOUT + (size_t)((e * NB + b1) * CAP + c) * DM) + lane; }
                u32x2 w0[4][4], w1[4][4];
#pragma unroll
                for (int k = 0; k < 4; ++k)
#pragma unroll
                    for (int j = 0; j < 4; ++j) { w0[k][j] = rp0[k][64 * j]; w1[k][j] = rp1[k][64 * j]; }
                f32x4 v0[4], v1[4];
#pragma unroll
                for (int j = 0; j < 4; ++j) { v0[j] = (f32x4){bf_lo(xw0[j].x), bf_hi(xw0[j].x), bf_lo(xw0[j].y), bf_hi(xw0[j].y)}; v1[j] = (f32x4){bf_lo(xw1[j].x), bf_hi(xw1[j].x), bf_lo(xw1[j].y), bf_hi(xw1[j].y)}; }
#pragma unroll
                for (int k = 0; k < 4; ++k)
#pragma unroll
                    for (int j = 0; j < 4; ++j) {
                        v0[j][0] += wg0[k] * bf_lo(w0[k][j].x); v0[j][1] += wg0[k] * bf_hi(w0[k][j].x); v0[j][2] += wg0[k] * bf_lo(w0[k][j].y); v0[j][3] += wg0[k] * bf_hi(w0[k][j].y);
                        v1[j][0] += wg1[k] * bf_lo(w1[k][j].x); v1[j][1] += wg1[k] * bf_hi(w1[k][j].x); v1[j][2] += wg1[k] * bf_lo(w1[k][j].y); v1[j][3] += wg1[k] * bf_hi(w1[k][j].y); }
#pragma unroll 1
                while (bal0) { const int e = __builtin_ctz(bal0); bal0 &= bal0 - 1u; const int c = __builtin_amdgcn_readlane(sl0, e);
                    const u32x2* mr = (const u32x2*)(MOEOUT + (size_t)((e * NB + b0) * CAP + c) * DM) + lane;
#pragma unroll
                    for (int j = 0; j < 4; ++j) { const u32x2 w = mr[64 * j]; v0[j][0] += bf_lo(w.x); v0[j][1] += bf_hi(w.x); v0[j][2] += bf_lo(w.y); v0[j][3] += bf_hi(w.y); } }
#pragma unroll 1
                while (bal1) { const int e = __builtin_ctz(bal1); bal1 &= bal1 - 1u; const int c = __builtin_amdgcn_readlane(sl1, e);
                    const u32x2* mr = (const u32x2*)(MOEOUT + (size_t)((e * NB + b1) * CAP + c) * DM) + lane;
#pragma unroll
                    for (int j = 0; j < 4; ++j) { const u32x2 w = mr[64 * j]; v1[j][0] += bf_lo(w.x); v1[j][1] += bf_hi(w.x); v1[j][2] += bf_lo(w.y); v1[j][3] += bf_hi(w.y); } }
                float s0 = 0.f, s1 = 0.f;
#pragma unroll
                for (int j = 0; j < 4; ++j) { u32x2 w; w.x = pkbf(v0[j][0], v0[j][1]); w.y = pkbf(v0[j][2], v0[j][3]); xr0[64 * j] = w;
                    const f32x4 r = (f32x4){bf_lo(w.x), bf_hi(w.x), bf_lo(w.y), bf_hi(w.y)}; s0 += (r[0] * r[0] + r[1] * r[1]) + (r[2] * r[2] + r[3] * r[3]); }
                if (has1) {
#pragma unroll
                    for (int j = 0; j < 4; ++j) { u32x2 w; w.x = pkbf(v1[j][0], v1[j][1]); w.y = pkbf(v1[j][2], v1[j][3]); xr1[64 * j] = w;
                        const f32x4 r = (f32x4){bf_lo(w.x), bf_hi(w.x), bf_lo(w.y), bf_hi(w.y)}; s1 += (r[0] * r[0] + r[1] * r[1]) + (r[2] * r[2] + r[3] * r[3]); } }
                const float rs0 = 1.f / sqrtf(wave_sum(s0) * (1.f / DM) + RMS_EPS), rs1 = 1.f / sqrtf(wave_sum(s1) * (1.f / DM) + RMS_EPS);
                if (lane == 0) { RS3[m] = rs0; if (has1) RS3[m1] = rs1; }
            }
        }
        SEAM(pb + 11);
        PT_END(11);
        PT_BEGIN(12);
        if (IN(pb + 12)) { PHASE_PTRS();
            pg8::Gemm g{H, wl + OFF_WPG, 1024, 1024, 1024}; pg8::StaticOrder S; S.init(M, 1024, G, bx); pg8::EpiPle E{H, Hn, PE, RS3};
            pg8::gemm_phase(lds, g, S, E);
        }
        SEAM(pb + 12);
        PT_END(12);
        PT_BEGIN(13);
        if (IN(pb + 13)) { PHASE_PTRS();
            if (l + 1 < NLAYER) row_pass<1>(nullptr, Hn, RS1, nullptr, nullptr, gw, NGW, lane);
            else row_pass<2>(nullptr, Hn, nullptr, ARGP(20), X, gw, NGW, lane);
        }
        if (l + 1 < NLAYER) SEAM(pb + 13);
        PT_END(13);
    }
    if (PROBE_T >= 0 && blockIdx.x == 0) { const unsigned long long t1 = __builtin_amdgcn_s_memrealtime() + (unsigned long long)PROBE_MULT * pt_acc; while (__builtin_amdgcn_s_memrealtime() < t1) __builtin_amdgcn_s_sleep(32); }
#undef IN
#undef SEAM
}

extern "C" void kernel_launch(void* const* d_in, const int* in_sizes, int n_in, void* d_out, int out_size, void* d_ws, size_t ws_size, hipStream_t stream) {
    static int grid = 0;
    if (grid == 0) {
        if (n_in != 21 || out_size != M * DM || ws_size < WS_END) { fprintf(stderr, "kernel_launch: unexpected shapes (n_in %d out %d ws %zu, need ws >= %zu)\n", n_in, out_size, ws_size, (size_t)WS_END); grid = -1; return; }
        int dev = 0, cus = 0, per_cu = 0;
        if (hipGetDevice(&dev) != hipSuccess || hipDeviceGetAttribute(&cus, hipDeviceAttributeMultiprocessorCount, dev) != hipSuccess) { grid = -1; return; }
        if (hipFuncSetAttribute((const void*)fwd, hipFuncAttributeMaxDynamicSharedMemorySize, LDS_BYTES) != hipSuccess) { fprintf(stderr, "kernel_launch: hipFuncSetAttribute failed\n"); grid = -1; return; }
        if (hipOccupancyMaxActiveBlocksPerMultiprocessor(&per_cu, (const void*)fwd, 512, LDS_BYTES) != hipSuccess || per_cu < 1) { fprintf(stderr, "kernel_launch: occupancy query reports %d blocks per CU\n", per_cu); }
        (void)hipGetLastError();
        grid = cus;
    }
    if (grid < 0) return;
    (void)hipMemsetAsync((char*)d_ws + WS_CTL, 0, CTL_ZERO_BYTES, stream);
    Args a{};
    for (int i = 0; i < 21; ++i) a.in[i] = (const float*)d_in[i];
    a.in[21] = (const float*)d_out; a.in[22] = (const float*)d_ws; a.in[23] = nullptr;
#if MK_ONE_LAUNCH
    a.ph_lo = 0; a.ph_hi = NPHASES;
    hipLaunchKernelGGL(fwd, dim3(grid), dim3(512), LDS_BYTES, stream, a);
#else
    for (int p = 0; p < NPHASES; ++p) { a.ph_lo = p; a.ph_hi = p + 1; hipLaunchKernelGGL(fwd, dim3(grid), dim3(512), LDS_BYTES, stream, a); }
#endif
}
```
